# Optimizing an MI355X kernel written in HIP

```python
import jax, jax.numpy as jnp
from jax import lax
import numpy as np

D_MODEL = 1024
BATCH = 2
SEQ = 16384
DEPTH = 2

GRID_W = 64
CTX_LEN = 256
N_EVEN = (DEPTH + 1) // 2
N_ODD = DEPTH // 2
NORM_EPS = 1e-6
POOL_WINDOWS = (2, 4, 8, 16)
POOL_GROUP = D_MODEL // 16
POOL_WIDTH = len(POOL_WINDOWS) * POOL_GROUP
RWKV_HEAD = 64
RWKV_WIDTH = D_MODEL - POOL_WIDTH
RWKV_HEADS = RWKV_WIDTH // RWKV_HEAD
LORA_W = 64
LORA_A = 64
LORA_G = 128
GN_EPS = 64e-5
RWKV_IN = 3 * RWKV_WIDTH + LORA_G + 2 * LORA_W + 2 * LORA_A
AB_IN = POOL_WIDTH + RWKV_IN
GDN_HEAD = 128
GDN_HEADS = D_MODEL // GDN_HEAD
GDN_CONV = 4
GDN_CHUNK = 64
GDN_IN = 4 * D_MODEL + 4 * GDN_HEADS
N_EXPERTS = 32
TOP_K = 4
D_FF = D_MODEL
SWIGLU_LIMIT = 7.0
SWIGLU_ALPHA = 1.702
MOE_BLOCK = 128

kernel_name = "hybrid_pool_rwkv7_gdn_moe_diffusion"


def _rmsnorm(x, g):
    xf = x.astype(jnp.float32)
    y = xf * lax.rsqrt(jnp.mean(xf * xf, -1, keepdims=True) + NORM_EPS)
    return y.astype(x.dtype) * g


def _modulate(h, shift, scale):
    return h * (1.0 + scale) + shift


def _l2norm(t):
    return t * lax.rsqrt(jnp.sum(t * t, -1, keepdims=True) + NORM_EPS)


def _shift_prev(z):
    return jnp.pad(z, ((0, 0), (1, 0), (0, 0)))[:, :-1]


def _shift_next(z):
    return jnp.pad(z, ((0, 0), (0, 1), (0, 0)))[:, 1:]


def _window_bounds(n, w):
    t = jnp.arange(n)
    return jnp.clip(t - w // 2, 0, n), jnp.clip(t + w - w // 2, 0, n)


def _box_mean_grid(p, w):
    _, R, W, _ = p.shape
    sat = jnp.pad(jnp.cumsum(jnp.cumsum(p, 1), 2), ((0, 0), (1, 0), (1, 0), (0, 0)))
    r_lo, r_hi = _window_bounds(R, w)
    c_lo, c_hi = _window_bounds(W, w)
    corner = lambda ri, ci: jnp.take(jnp.take(sat, ri, axis=1), ci, axis=2)
    s = corner(r_hi, c_hi) - corner(r_lo, c_hi) - corner(r_hi, c_lo) + corner(r_lo, c_lo)
    cnt = ((r_hi - r_lo)[:, None] * (c_hi - c_lo)[None, :]).astype(jnp.float32)
    return s / cnt[None, :, :, None]


def _box_mean_seq(p, w):
    L = p.shape[1]
    cs = jnp.pad(jnp.cumsum(p, 1), ((0, 0), (1, 0), (0, 0)))
    lo, hi = _window_bounds(L, w)
    return (jnp.take(cs, hi, axis=1) - jnp.take(cs, lo, axis=1)) / (hi - lo).astype(jnp.float32)[None, :, None]


def _pool_mix(p, pool_w, pool_scale, grid):
    B_, L, _ = p.shape
    pf = p.astype(jnp.float32)
    outs = []
    for gi, w in enumerate(POOL_WINDOWS):
        pg = pf[..., gi * POOL_GROUP:(gi + 1) * POOL_GROUP]
        if grid:
            rows = L // GRID_W
            m = _box_mean_grid(pg.reshape(B_, rows, GRID_W, POOL_GROUP), w).reshape(B_, L, POOL_GROUP)
        else:
            m = _box_mean_seq(pg, w)
        outs.append((m - pg).astype(p.dtype) @ pool_w[gi])
    return jnp.concatenate(outs, -1) * pool_scale


def _rwkv_inputs(z, mu, w0, w_up, a0, a_up, g_up, k_k, k_a):
    z = z + mu[0] * (_shift_prev(z) - z) + mu[1] * (_shift_next(z) - z)
    B_, L, _ = z.shape
    heads = lambda t: t.reshape(B_, L, RWKV_HEADS, RWKV_HEAD).astype(jnp.float32)
    RW = RWKV_WIDTH
    r = z[..., :RW]
    k = z[..., RW:2 * RW]
    v = z[..., 2 * RW:3 * RW]
    o = 3 * RW
    gd = z[..., o:o + LORA_G]
    o += LORA_G
    wd = (z[..., o:o + LORA_W], z[..., o + LORA_W:o + 2 * LORA_W])
    o += 2 * LORA_W
    ad = (z[..., o:o + LORA_A], z[..., o + LORA_A:o + 2 * LORA_A])
    g = jax.nn.sigmoid(gd) @ g_up
    kk = _l2norm(heads(k * k_k))
    dirs = []
    for d in range(2):
        w_log = -jax.nn.softplus(-(w0[d] + jnp.tanh(wd[d]) @ w_up[d])) - 0.5
        decay = jnp.exp(-jnp.exp(w_log.astype(jnp.float32)))
        a = jax.nn.sigmoid(a0[d] + ad[d] @ a_up[d])
        kt = k * (1.0 + (a - 1.0) * k_a)
        dirs.append((heads(decay), heads(kt), heads(a)))
    return heads(r), heads(k), heads(v), kk, g, dirs


def _rwkv7_scan(r, w, k, v, kk, a, s0, reverse):
    def step(s, inp):
        r_t, w_t, k_t, v_t, kk_t, a_t = inp
        sk = jnp.einsum('bhvk,bhk->bhv', s, kk_t)
        s = (s * w_t[:, :, None, :] - sk[..., None] * (kk_t * a_t)[:, :, None, :]
             + v_t[..., None] * k_t[:, :, None, :])
        return s, jnp.einsum('bhvk,bhk->bhv', s, r_t)
    xs = tuple(jnp.moveaxis(t, 1, 0) for t in (r, w, k, v, kk, a))
    s, y = lax.scan(step, s0, xs, reverse=reverse)
    return jnp.moveaxis(y, 0, 1), s


def _rwkv_out(y, r, k, v, g, r_k, gn_w, gn_b):
    B_, L = y.shape[:2]
    mean = jnp.mean(y, -1, keepdims=True)
    var = jnp.mean(jnp.square(y - mean), -1, keepdims=True)
    yn = ((y - mean) * lax.rsqrt(var + GN_EPS)).reshape(B_, L, RWKV_WIDTH)
    bonus = (jnp.sum(r * k * r_k, -1, keepdims=True) * v).reshape(B_, L, RWKV_WIDTH)
    return (yn * gn_w + gn_b + bonus) * g


def _pool_rwkv_mixer(h_c, h_l, w_in, mu, pool_w, pool_scale, w0, w_up, a0, a_up, g_up,
                     k_k, k_a, r_k, gn_w, gn_b, need_ctx):
    z_c = h_c @ w_in
    z_l = h_l @ w_in
    lora = (mu, w0, w_up, a0, a_up, g_up, k_k, k_a)
    r_c, k_c, v_c, kk_c, g_c, dir_c = _rwkv_inputs(z_c[..., POOL_WIDTH:], *lora)
    r_l, k_l, v_l, kk_l, g_l, dir_l = _rwkv_inputs(z_l[..., POOL_WIDTH:], *lora)
    s0 = jnp.zeros((h_l.shape[0], RWKV_HEADS, RWKV_HEAD, RWKV_HEAD), jnp.float32)
    yc_f, sc_f = _rwkv7_scan(r_c, dir_c[0][0], dir_c[0][1], v_c, kk_c, dir_c[0][2], s0, False)
    yl_f, _ = _rwkv7_scan(r_l, dir_l[0][0], dir_l[0][1], v_l, kk_l, dir_l[0][2], sc_f, False)
    yc_b, sc_b = _rwkv7_scan(r_c, dir_c[1][0], dir_c[1][1], v_c, kk_c, dir_c[1][2], s0, True)
    yl_b, _ = _rwkv7_scan(r_l, dir_l[1][0], dir_l[1][1], v_l, kk_l, dir_l[1][2], sc_b, True)
    out_l = jnp.concatenate([
        _pool_mix(z_l[..., :POOL_WIDTH], pool_w, pool_scale, True),
        _rwkv_out(yl_f + yl_b, r_l, k_l, v_l, g_l, r_k, gn_w, gn_b).astype(h_l.dtype)], -1)
    out_c = None
    if need_ctx:
        out_c = jnp.concatenate([
            _pool_mix(z_c[..., :POOL_WIDTH], pool_w, pool_scale, False),
            _rwkv_out(yc_f + yc_b, r_c, k_c, v_c, g_c, r_k, gn_w, gn_b).astype(h_c.dtype)], -1)
    return out_c, out_l


def _short_conv(x, w):
    L = x.shape[1]
    lpad = GDN_CONV // 2
    xp = jnp.pad(x, ((0, 0), (lpad, GDN_CONV - 1 - lpad), (0, 0)))
    return sum(xp[:, j:j + L] * w[j] for j in range(GDN_CONV))


def _gdn_chunked(q, k, v, g, beta, s0):
    B_, L, H, K = q.shape
    V = v.shape[-1]
    C = GDN_CHUNK
    n = L // C
    blocks = lambda t: jnp.swapaxes(t.reshape((B_, n, C, H) + t.shape[3:]), 2, 3)
    q, k, v, g, beta = (blocks(t) for t in (q, k, v, g, beta))
    gc = jnp.cumsum(g, axis=-1)
    incl = jnp.tril(jnp.ones((C, C), dtype=bool))
    strict = jnp.tril(jnp.ones((C, C), dtype=bool), -1)
    decay = jnp.exp(jnp.where(incl, gc[..., :, None] - gc[..., None, :], -jnp.inf))
    kb = k * beta[..., None]
    m = jnp.eye(C, dtype=q.dtype) + jnp.where(
        strict, jnp.einsum('bnhik,bnhjk->bnhij', kb, k) * decay, 0.0)
    rhs = jnp.concatenate([kb * jnp.exp(gc)[..., None], v * beta[..., None]], -1)
    sol = lax.linalg.triangular_solve(m, rhs, left_side=True, lower=True)
    w_, u = sol[..., :K], sol[..., K:]
    attn = jnp.einsum('bnhik,bnhjk->bnhij', q, k) * decay
    q_dec = q * jnp.exp(gc)[..., None]
    k_dec = k * jnp.exp(gc[..., -1:] - gc)[..., None]
    g_last = jnp.exp(gc[..., -1])

    def step(s, inp):
        w_i, u_i, qd_i, kd_i, a_i, gl_i = inp
        v_new = u_i - jnp.einsum('bhck,bhkv->bhcv', w_i, s)
        o = jnp.einsum('bhck,bhkv->bhcv', qd_i, s) + jnp.einsum('bhij,bhjv->bhiv', a_i, v_new)
        s = s * gl_i[..., None, None] + jnp.einsum('bhck,bhcv->bhkv', kd_i, v_new)
        return s, o

    xs = tuple(jnp.moveaxis(t, 1, 0) for t in (w_, u, q_dec, k_dec, attn, g_last))
    s, o = lax.scan(step, s0, xs)
    o = jnp.transpose(o, (1, 0, 3, 2, 4)).reshape(B_, L, H, V)
    return o, s


def _gdn_prep(h, w_in, conv_w, a_log, dt_bias):
    z = h @ w_in
    B_, L, _ = z.shape
    D = D_MODEL
    H = GDN_HEADS
    qkv = jax.nn.silu(_short_conv(z[..., :3 * D], conv_w))
    hd = lambda t: t.reshape(B_, L, H, GDN_HEAD).astype(jnp.float32)
    q = _l2norm(hd(qkv[..., :D])) * (GDN_HEAD ** -0.5)
    k = _l2norm(hd(qkv[..., D:2 * D]))
    v = hd(qkv[..., 2 * D:])
    gate = z[..., 3 * D:4 * D]
    o = 4 * D
    dirs = []
    for d in range(2):
        beta = jax.nn.sigmoid(z[..., o + d * H:o + (d + 1) * H].astype(jnp.float32))
        a = z[..., o + (2 + d) * H:o + (3 + d) * H].astype(jnp.float32)
        g = -jnp.exp(a_log[d]) * jax.nn.softplus(a + dt_bias[d])
        dirs.append((g, beta))
    return q, k, v, gate, dirs


def _gdn_out(o, gate, norm_g):
    B_, L = o.shape[:2]
    on = o * lax.rsqrt(jnp.mean(o * o, -1, keepdims=True) + NORM_EPS) * norm_g
    return (on.reshape(B_, L, D_MODEL) * jax.nn.silu(gate)).astype(gate.dtype)


def _gdn_mixer(h_c, h_l, w_in, conv_w, a_log, dt_bias, norm_g, need_ctx):
    q_c, k_c, v_c, z_c, d_c = _gdn_prep(h_c, w_in, conv_w, a_log, dt_bias)
    q_l, k_l, v_l, z_l, d_l = _gdn_prep(h_l, w_in, conv_w, a_log, dt_bias)
    s0 = jnp.zeros((h_l.shape[0], GDN_HEADS, GDN_HEAD, GDN_HEAD), jnp.float32)
    fl = lambda t: jnp.flip(t, 1)
    oc_f, sc_f = _gdn_chunked(q_c, k_c, v_c, d_c[0][0], d_c[0][1], s0)
    ol_f, _ = _gdn_chunked(q_l, k_l, v_l, d_l[0][0], d_l[0][1], sc_f)
    oc_b, sc_b = _gdn_chunked(fl(q_c), fl(k_c), fl(v_c), fl(d_c[1][0]), fl(d_c[1][1]), s0)
    ol_b, _ = _gdn_chunked(fl(q_l), fl(k_l), fl(v_l), fl(d_l[1][0]), fl(d_l[1][1]), sc_b)
    out_l = _gdn_out(ol_f + fl(ol_b), z_l, norm_g)
    out_c = _gdn_out(oc_f + fl(oc_b), z_c, norm_g) if need_ctx else None
    return out_c, out_l


def _moe(h, router_w, router_b, w_in, b_in, w_out, b_out):
    shp = h.shape
    D = shp[-1]
    t = h.reshape(-1, D)
    T = t.shape[0]
    logits = (t @ router_w + router_b).astype(jnp.float32)
    top_val, top_idx = lax.top_k(logits, TOP_K)
    gates = jax.nn.softmax(top_val, axis=-1).astype(h.dtype)
    A = T * TOP_K
    e = top_idx.reshape(-1)
    tok = jnp.repeat(jnp.arange(T, dtype=jnp.int32), TOP_K)
    gw = gates.reshape(-1)
    order = jnp.argsort(e)
    e_s, tok_s, gw_s = e[order], tok[order], gw[order]
    counts = jax.ops.segment_sum(jnp.ones_like(e_s), e_s, num_segments=N_EXPERTS)
    padded = (counts + MOE_BLOCK - 1) // MOE_BLOCK * MOE_BLOCK
    start = jnp.cumsum(counts) - counts
    pend = jnp.cumsum(padded)
    pstart = pend - padded
    dest = pstart[e_s] + jnp.arange(A, dtype=jnp.int32) - start[e_s]
    n_blocks = -(-A // MOE_BLOCK) + N_EXPERTS
    P = n_blocks * MOE_BLOCK
    tok_buf = jnp.zeros((P,), jnp.int32).at[dest].set(tok_s)
    gw_buf = jnp.zeros((P,), h.dtype).at[dest].set(gw_s)
    block_e = jnp.minimum(
        jnp.searchsorted(pend, jnp.arange(n_blocks, dtype=jnp.int32) * MOE_BLOCK, side='right'),
        N_EXPERTS - 1)

    def expert_block(args):
        idx, ex = args
        hh = t[idx] @ w_in[ex] + b_in[ex]
        glu = jnp.minimum(hh[:, :D_FF], SWIGLU_LIMIT)
        lin = jnp.clip(hh[:, D_FF:], -SWIGLU_LIMIT, SWIGLU_LIMIT)
        return (glu * jax.nn.sigmoid(SWIGLU_ALPHA * glu) * (lin + 1.0)) @ w_out[ex] + b_out[ex]

    yb = lax.map(expert_block, (tok_buf.reshape(n_blocks, MOE_BLOCK), block_e))
    y = jax.ops.segment_sum(yb.reshape(P, D) * gw_buf[:, None], tok_buf, num_segments=T)
    return y.reshape(shp)


def setup_inputs(seed: int = 0) -> dict:
    key = jax.random.key(seed)
    ks = iter(jax.random.split(key, 40))
    nrm = lambda shape, s: jax.random.normal(next(ks), shape, jnp.float32) * s
    D = D_MODEL
    NE, NO = N_EVEN, N_ODD
    RW = RWKV_WIDTH
    H = GDN_HEADS
    dt = jnp.exp(jax.random.uniform(next(ks), (NO, 2, H), jnp.float32, np.log(1e-3), np.log(1e-1)))
    return {
        "x": nrm((BATCH, SEQ, D), 1.0),
        "c": nrm((BATCH, D), 1.0),
        "ctx": nrm((BATCH, CTX_LEN, D), 1.0),
        "c_ctx": nrm((D,), 1.0),
        "ada_w": nrm((DEPTH, D, 6 * D), 0.5 * D ** -0.5),
        "ada_b": nrm((DEPTH, 6 * D), 0.02),
        "norm_g": 1.0 + nrm((DEPTH, 4, D), 0.05),
        "w_out": nrm((DEPTH, D, D), D ** -0.5),
        "ab_w_in": nrm((NE, D, AB_IN), D ** -0.5),
        "ab_mu": jax.random.uniform(next(ks), (NE, 2, RWKV_IN), jnp.float32, 0.0, 0.5),
        "pool_w": nrm((NE, len(POOL_WINDOWS), POOL_GROUP, POOL_GROUP), POOL_GROUP ** -0.5),
        "pool_scale": 1.0 + nrm((NE, POOL_WIDTH), 0.05),
        "rwkv_w0": nrm((NE, 2, RW), 0.5),
        "rwkv_w_up": nrm((NE, 2, LORA_W, RW), 0.1),
        "rwkv_a0": nrm((NE, 2, RW), 0.5),
        "rwkv_a_up": nrm((NE, 2, LORA_A, RW), 0.1),
        "rwkv_g_up": nrm((NE, LORA_G, RW), LORA_G ** -0.5),
        "rwkv_k_k": 0.85 + nrm((NE, RW), 0.05),
        "rwkv_k_a": 1.0 + nrm((NE, RW), 0.05),
        "rwkv_r_k": nrm((NE, RWKV_HEADS, RWKV_HEAD), 0.1),
        "rwkv_gn_w": 1.0 + nrm((NE, RW), 0.05),
        "rwkv_gn_b": nrm((NE, RW), 0.02),
        "gdn_w_in": nrm((NO, D, GDN_IN), D ** -0.5),
        "gdn_conv": nrm((NO, GDN_CONV, 3 * D), 0.5),
        "gdn_a_log": jnp.log(jax.random.uniform(next(ks), (NO, 2, H), jnp.float32, 1.0, 16.0)),
        "gdn_dt_bias": dt + jnp.log(-jnp.expm1(-dt)),
        "gdn_norm_g": 1.0 + nrm((NO, GDN_HEAD), 0.05),
        "router_w": nrm((DEPTH, D, N_EXPERTS), D ** -0.5),
        "router_b": nrm((DEPTH, N_EXPERTS), 0.01),
        "moe_w_in": nrm((DEPTH, N_EXPERTS, D, 2 * D_FF), D ** -0.5),
        "moe_b_in": nrm((DEPTH, N_EXPERTS, 2 * D_FF), 0.02),
        "moe_w_out": nrm((DEPTH, N_EXPERTS, D_FF, D), D_FF ** -0.5),
        "moe_b_out": nrm((DEPTH, N_EXPERTS, D), 0.02),
    }


def reference(x, c, ctx, c_ctx, ada_w, ada_b, norm_g, w_out, ab_w_in, ab_mu, pool_w, pool_scale,
              rwkv_w0, rwkv_w_up, rwkv_a0, rwkv_a_up, rwkv_g_up, rwkv_k_k, rwkv_k_a, rwkv_r_k,
              rwkv_gn_w, rwkv_gn_b, gdn_w_in, gdn_conv, gdn_a_log, gdn_dt_bias, gdn_norm_g,
              router_w, router_b, moe_w_in, moe_b_in, moe_w_out, moe_b_out):
    lat, cx = x, ctx
    n_ctx = ctx.shape[1]
    for i in range(DEPTH):
        last = i == DEPTH - 1
        j = i // 2
        mod_l = jnp.split((jax.nn.silu(c) @ ada_w[i] + ada_b[i])[:, None, :], 6, axis=-1)
        mod_c = jnp.split((jax.nn.silu(c_ctx) @ ada_w[i] + ada_b[i])[None, None, :], 6, axis=-1)
        h_l = _modulate(_rmsnorm(lat, norm_g[i, 0]), mod_l[0], mod_l[1])
        h_c = _modulate(_rmsnorm(cx, norm_g[i, 0]), mod_c[0], mod_c[1])
        if i % 2 == 0:
            m_c, m_l = _pool_rwkv_mixer(
                h_c, h_l, ab_w_in[j], ab_mu[j], pool_w[j], pool_scale[j], rwkv_w0[j], rwkv_w_up[j],
                rwkv_a0[j], rwkv_a_up[j], rwkv_g_up[j], rwkv_k_k[j], rwkv_k_a[j], rwkv_r_k[j],
                rwkv_gn_w[j], rwkv_gn_b[j], not last)
        else:
            m_c, m_l = _gdn_mixer(h_c, h_l, gdn_w_in[j], gdn_conv[j], gdn_a_log[j], gdn_dt_bias[j],
                                  gdn_norm_g[j], not last)
        lat = lat + mod_l[2] * _rmsnorm(m_l @ w_out[i], norm_g[i, 1])
        moe_p = (router_w[i], router_b[i], moe_w_in[i], moe_b_in[i], moe_w_out[i], moe_b_out[i])
        f_l = _modulate(_rmsnorm(lat, norm_g[i, 2]), mod_l[3], mod_l[4])
        if last:
            lat = lat + mod_l[5] * _rmsnorm(_moe(f_l, *moe_p), norm_g[i, 3])
        else:
            cx = cx + mod_c[2] * _rmsnorm(m_c @ w_out[i], norm_g[i, 1])
            f_c = _modulate(_rmsnorm(cx, norm_g[i, 2]), mod_c[3], mod_c[4])
            y = _moe(jnp.concatenate([f_c, f_l], axis=1), *moe_p)
            lat = lat + mod_l[5] * _rmsnorm(y[:, n_ctx:], norm_g[i, 3])
            cx = cx + mod_c[5] * _rmsnorm(y[:, :n_ctx], norm_g[i, 3])
    return lat
```

```cpp
#include <hip/hip_runtime.h>
#include <hip/hip_cooperative_groups.h>
#include <cstdio>
#include <cstdint>
#include <cstring>
namespace cg = cooperative_groups;

typedef unsigned short u16;
using bf16x8 = __attribute__((ext_vector_type(8))) short;
using f32x4 = __attribute__((ext_vector_type(4))) float;
using u16x4 = __attribute__((ext_vector_type(4))) unsigned short;
#define MFMA16(a, b, c) __builtin_amdgcn_mfma_f32_16x16x32_bf16(a, b, c, 0, 0, 0)

constexpr int D = 1024, NB = 2, SEQ = 16384, CTXL = 256, PB = SEQ + CTXL, T = NB * PB, NCH = PB / 64;
constexpr int AB_IN = 2944, AB_PAD = 3072, GDN_IN = 4128, GDN_PAD = 4352, RWKV_IN = 2688;
constexpr int NE = 32, TOPK = 4;
constexpr int NTH = 256;
constexpr int LDS_HALF = 75776;
constexpr size_t LDS_BYTES = 2 * LDS_HALF;
constexpr int MB = 9216;
constexpr int RW_ITEM = 16384;
constexpr int GD_ITEM = 49152;

#define CNTI(layer, which, e) ((((layer) * 2 + (which)) * 32 + (e)) * 64)

struct TFam { const float* src; u16* dst; long sstride, dstride; int nmat, K, N, Npad, tiles_per_mat, tile_start; };

struct Params {
  const float *x, *c, *ctx, *c_ctx, *ada_w, *ada_b, *norm_g, *w_out, *ab_w_in, *ab_mu, *pool_w, *pool_scale,
      *rwkv_w0, *rwkv_w_up, *rwkv_a0, *rwkv_a_up, *rwkv_g_up, *rwkv_k_k, *rwkv_k_a, *rwkv_r_k, *rwkv_gn_w, *rwkv_gn_b,
      *gdn_w_in, *gdn_conv, *gdn_a_log, *gdn_dt_bias, *gdn_norm_g, *router_w, *router_b, *moe_w_in, *moe_b_in,
      *moe_w_out, *moe_b_out;
  float* out;
  int* cnt;
  unsigned* bar;
  float* modpart;
  float* mods;
  u16 *WabT, *WoutT, *WgdnT, *MoeInT, *MoeOutT, *WupT, *AupT, *GupT, *PoolT;
  u16* xs;
  u16* abuf;
  u16* zbuf;
  u16* tmp;
  u16* prep;
  u16 *yf, *yb;
  u16* act;
  u16* oslot;
  int* tok_e;
  float* tok_gw;
  int* tok_slot;
  int* slot_tok;
  float* slot_gw;
  u16* trash;
  TFam fam[11];
  int total_tiles;
  int early_tiles;
  int mid_tiles;
  int pad1;
};

typedef __bf16 bf2_t __attribute__((ext_vector_type(2)));
typedef float fl2_t __attribute__((ext_vector_type(2)));
__device__ __forceinline__ unsigned pack2(float a, float b) {
  fl2_t f = {a, b};
  bf2_t h = __builtin_convertvector(f, bf2_t);
  return __builtin_bit_cast(unsigned, h);
}
__device__ __forceinline__ u16 f2bf(float f) { return (u16)(pack2(f, 0.f) & 0xffffu); }
__device__ __forceinline__ float bf2f(u16 h) { return __uint_as_float(((unsigned)h) << 16); }
__device__ __forceinline__ float sigmoidf_(float x) { return __builtin_amdgcn_rcpf(1.0f + __expf(-x)); }
__device__ __forceinline__ float siluf_(float x) { return x * __builtin_amdgcn_rcpf(1.0f + __expf(-x)); }
__device__ __forceinline__ float softplusf_(float y) { return fmaxf(y, 0.0f) + __logf(1.0f + __expf(-fabsf(y))); }
__device__ __forceinline__ float tanhf_(float x) { return 2.0f * __builtin_amdgcn_rcpf(1.0f + __expf(-2.0f * x)) - 1.0f; }
typedef __bf16 bf2v_t __attribute__((ext_vector_type(2)));
__device__ __forceinline__ float dot2bf(unsigned a, unsigned b, float c) {
  return __builtin_amdgcn_fdot2_f32_bf16(__builtin_bit_cast(bf2v_t, a), __builtin_bit_cast(bf2v_t, b), c, false);
}
__device__ __forceinline__ float wave_sum(float v) {
#pragma unroll
  for (int o = 32; o > 0; o >>= 1) v += __shfl_xor(v, o);
  return v;
}
__device__ __forceinline__ float4 ld4bf(const u16* p) {
  uint2 a = *reinterpret_cast<const uint2*>(p);
  return make_float4(__uint_as_float(a.x << 16), __uint_as_float(a.x & 0xffff0000u), __uint_as_float(a.y << 16), __uint_as_float(a.y & 0xffff0000u));
}
__device__ __forceinline__ void st4bf(u16* p, float4 v) { uint2 o; o.x = pack2(v.x, v.y); o.y = pack2(v.z, v.w); *reinterpret_cast<uint2*>(p) = o; }
__device__ __forceinline__ void ld8(const u16* p, float* o) {
  uint4 v = *reinterpret_cast<const uint4*>(p);
  o[0] = __uint_as_float(v.x << 16); o[1] = __uint_as_float(v.x & 0xffff0000u);
  o[2] = __uint_as_float(v.y << 16); o[3] = __uint_as_float(v.y & 0xffff0000u);
  o[4] = __uint_as_float(v.z << 16); o[5] = __uint_as_float(v.z & 0xffff0000u);
  o[6] = __uint_as_float(v.w << 16); o[7] = __uint_as_float(v.w & 0xffff0000u);
}
__device__ __forceinline__ void st8(u16* p, const float* v) {
  uint4 o;
  o.x = pack2(v[0], v[1]); o.y = pack2(v[2], v[3]); o.z = pack2(v[4], v[5]); o.w = pack2(v[6], v[7]);
  *reinterpret_cast<uint4*>(p) = o;
}

extern __shared__ __attribute__((aligned(16))) unsigned char smem_raw[];
__device__ __forceinline__ int half_id() { return __builtin_amdgcn_readfirstlane((int)(threadIdx.x >> 8)); }
#define smem (smem_raw + half_id() * LDS_HALF)
#define VBID ((int)(blockIdx.x * 2 + half_id()))
#define NVB ((int)(gridDim.x * 2))
__device__ __forceinline__ int opaque_tid() { int t = threadIdx.x; asm volatile("" : "+v"(t)); return t & 255; }


#define XB_TMO      128
#define XB_XCNT(j)  (256  + 64 * (j))
#define XB_XSUB(j)  (1280 + 64 * (j))
#define XB_XGEN(j)  (2304 + 64 * (j))
#define XB_TOP      3328
#define XB_TOPGEN   3392
#define XCD_BAR_WORDS 3456
#define XB_SPIN_CAP (1u << 22)
#ifndef REP_BAR
#define REP_BAR 1
#endif
#define LAS __attribute__((address_space(3)))
__device__ __forceinline__ unsigned xb_ld(unsigned* p) { return __hip_atomic_load(p, __ATOMIC_RELAXED, __HIP_MEMORY_SCOPE_AGENT); }
__device__ __forceinline__ unsigned xb_add(unsigned* p, unsigned v) { return __hip_atomic_fetch_add(p, v, __ATOMIC_RELAXED, __HIP_MEMORY_SCOPE_AGENT); }
__device__ __forceinline__ unsigned xb_xcc_id() { return (unsigned)__builtin_amdgcn_s_getreg((3 << 11) | 20) & 0xFu; }
#define XB_SPIN(cond, bar) do { unsigned _sp = 0; while (cond) { __builtin_amdgcn_s_sleep(1); \
    if ((++_sp & 255u) == 0u) { if (xb_ld(&(bar)[XB_TMO])) break; if (_sp > XB_SPIN_CAP) { atomicAdd(&(bar)[XB_TMO], 1u); break; } } } } while (0)
struct XcdBarrier { unsigned* bar; unsigned x; volatile LAS unsigned* st; };
__device__ __forceinline__ XcdBarrier xcd_barrier_post(unsigned* bar, volatile LAS unsigned* st) {
  XcdBarrier b; b.bar = bar; b.x = xb_xcc_id(); b.st = st;
  if (threadIdx.x == 0) (void)xb_add(&bar[XB_XCNT(b.x)], 1u);
  return b;
}
__device__ __forceinline__ void xcd_barrier_complete(unsigned* bar, unsigned x, unsigned& nloc, unsigned& nx) {
  const unsigned G = gridDim.x * gridDim.y * gridDim.z;
  unsigned sum, cnt, mine, sp = 0u;
  for (;;) {
    sum = 0u; cnt = 0u; mine = 0u;
#pragma unroll
    for (unsigned j = 0; j < 16; ++j) { const unsigned c = xb_ld(&bar[XB_XCNT(j)]); sum += c; cnt += (c > 0u) ? 1u : 0u; mine = (j == x) ? c : mine; }
    if (sum == G) break;
    __builtin_amdgcn_s_sleep(1);
    if ((++sp & 255u) == 0u) { if (xb_ld(&bar[XB_TMO])) break; if (sp > XB_SPIN_CAP) { atomicAdd(&bar[XB_TMO], 1u); break; } }
  }
  nloc = mine > 0u ? mine : 1u; nx = cnt > 0u ? cnt : 1u;
}
__device__ __forceinline__ void xcd_barrier1(const XcdBarrier& b) {
  asm volatile("s_waitcnt vmcnt(0)" ::: "memory");
  __syncthreads();
  if (threadIdx.x == 0) {
    unsigned* bar = b.bar;
    const unsigned bx = xb_xcc_id();
    __builtin_amdgcn_s_waitcnt(0);
    unsigned nloc = b.st[0], nx = b.st[1];
    if (nloc == 0u) { xcd_barrier_complete(bar, bx, nloc, nx); b.st[0] = nloc; b.st[1] = nx; }
    const unsigned old = xb_add(&bar[XB_XSUB(bx)], 1u);
    const unsigned gen = old / nloc;
    if (old + 1u == (gen + 1u) * nloc) {
      __builtin_amdgcn_fence(__ATOMIC_RELEASE, "agent");
      asm volatile("s_waitcnt vmcnt(0)" ::: "memory");
      const unsigned og = xb_add(&bar[XB_TOP], 1u);
      const unsigned tg = og / nx;
      if (og + 1u == (tg + 1u) * nx) xb_add(&bar[XB_TOPGEN], 1u);
      else XB_SPIN(xb_ld(&bar[XB_TOPGEN]) == tg, bar);
      __builtin_amdgcn_fence(__ATOMIC_ACQUIRE, "agent");
      xb_add(&bar[XB_XGEN(bx)], 1u);
      asm volatile("s_waitcnt vmcnt(0)" ::: "memory");
    } else {
      XB_SPIN(xb_ld(&bar[XB_XGEN(bx)]) == gen, bar);
      __builtin_amdgcn_fence(__ATOMIC_ACQUIRE, "agent");
      asm volatile("s_waitcnt vmcnt(0)" ::: "memory");
    }
  }
  __syncthreads();
}

__device__ __forceinline__ void xcd_barrier(const XcdBarrier& b) { for (int r = 0; r < REP_BAR; ++r) xcd_barrier1(b); }

template <int SLP = 0>
__device__ __forceinline__ void phase_weights(const Params& p, int t_begin, int t_end, int blk, int nblk) {
  float* tl = (float*)smem;
  const int tid = opaque_tid();
  for (int w = t_begin + blk; w < t_end; w += nblk) {
    int f = 0;
#pragma unroll
    for (int i = 1; i < 11; ++i) if (w >= p.fam[i].tile_start) f = i;
    const TFam& F = p.fam[f];
    int loc = w - F.tile_start;
    int mat = loc / F.tiles_per_mat, tt = loc % F.tiles_per_mat;
    int ntn = F.Npad / 64;
    int k0 = (tt / ntn) * 64, n0 = (tt % ntn) * 64;
    const float* src = F.src + (long)mat * F.sstride;
    u16* dst = F.dst + (long)mat * F.dstride;
#pragma unroll
    for (int i = 0; i < 4; ++i) {
      int k = (tid >> 4) + 16 * i, n4 = (tid & 15) * 4;
      float4 v = make_float4(0.f, 0.f, 0.f, 0.f);
      if (n0 + n4 < F.N) v = *reinterpret_cast<const float4*>(src + (long)(k0 + k) * F.N + n0 + n4);
      tl[k * 65 + n4 + 0] = v.x; tl[k * 65 + n4 + 1] = v.y; tl[k * 65 + n4 + 2] = v.z; tl[k * 65 + n4 + 3] = v.w;
    }
    __syncthreads();
    {
      int n = tid >> 2, kq = (tid & 3) * 16;
      float v[16];
#pragma unroll
      for (int i = 0; i < 16; ++i) v[i] = tl[(kq + i) * 65 + n];
      u16* d = dst + (long)(n0 + n) * F.K + k0 + kq;
      st8(d, v); st8(d + 8, v + 8);
    }
    if (SLP) __builtin_amdgcn_s_sleep(SLP);
    __syncthreads();
  }
}

__device__ __forceinline__ void phase_mods_partial(const Params& p) {
  float* sl = (float*)smem;
  const int tid = opaque_tid();
  for (int it = VBID; it < 384; it += NVB) {
    int ks = it / 48, cb = it % 48;
    int o = cb * 256 + tid;
    int layer = o / 6144, col = o % 6144;
    __syncthreads();
    if (tid < 128) {
      int k = ks * 128 + tid;
      sl[tid] = siluf_(p.c[k]); sl[128 + tid] = siluf_(p.c[1024 + k]); sl[256 + tid] = siluf_(p.c_ctx[k]);
    }
    __syncthreads();
    const float* w = p.ada_w + (long)layer * 1024 * 6144 + (long)(ks * 128) * 6144 + col;
    float s0 = 0.f, s1 = 0.f, s2 = 0.f;
#pragma unroll 8
    for (int k = 0; k < 128; ++k) {
      float wv = w[(long)k * 6144];
      s0 += sl[k] * wv; s1 += sl[128 + k] * wv; s2 += sl[256 + k] * wv;
    }
    float* dst = p.modpart + ((long)(ks * 2 + layer) * 3) * 6144 + col;
    dst[0] = s0; dst[6144] = s1; dst[2 * 6144] = s2;
  }
  __syncthreads();
}

__device__ __forceinline__ void phase_mods_reduce(const Params& p) {
  for (int o = VBID * NTH + (int)(threadIdx.x & 255); o < 2 * 3 * 6144; o += NVB * NTH) {
    int layer = o / (3 * 6144), rem = o % (3 * 6144), col = rem % 6144;
    float s = p.ada_b[layer * 6144 + col];
#pragma unroll
    for (int ks = 0; ks < 8; ++ks) s += p.modpart[(long)(ks * 2 + layer) * 3 * 6144 + rem];
    p.mods[o] = s;
  }
}

__device__ __forceinline__ const float* modp(const Params& p, int layer, int mrow, int which) {
  return p.mods + ((long)(layer * 3 + mrow) * 6 + which) * 1024;
}

__device__ __forceinline__ void phase_norm_in(const Params& p, int layer, bool first) {
  const int tid_ = opaque_tid(); const int lane = tid_ & 63, wid = tid_ >> 6;
  const float* g = p.norm_g + (long)(layer * 4 + 0) * 1024;
  for (int row = VBID * 4 + wid; row < T; row += NVB * 4) {
    int b = row / PB, pp = row % PB, mrow = pp < CTXL ? 2 : b;
    const float* src;
    if (first) src = pp < CTXL ? p.ctx + ((long)b * CTXL + pp) * D : p.x + ((long)b * SEQ + (pp - CTXL)) * D;
    else src = (const float*)p.xs + (long)row * D;
    float4 v[4];
    float ss = 0.f;
#pragma unroll
    for (int i = 0; i < 4; ++i) {
      v[i] = reinterpret_cast<const float4*>(src)[i * 64 + lane];
      ss += v[i].x * v[i].x + v[i].y * v[i].y + v[i].z * v[i].z + v[i].w * v[i].w;
    }
    ss = wave_sum(ss);
    float rstd = rsqrtf(ss * (1.0f / 1024.0f) + 1e-6f);
    const float* sh = modp(p, layer, mrow, 0);
    const float* sc = modp(p, layer, mrow, 1);
#pragma unroll
    for (int i = 0; i < 4; ++i) {
      int col = (i * 64 + lane) * 4;
      float4 gg = *reinterpret_cast<const float4*>(g + col);
      float4 s4 = *reinterpret_cast<const float4*>(sh + col);
      float4 c4 = *reinterpret_cast<const float4*>(sc + col);
      float h0 = v[i].x * rstd * gg.x * (1.f + c4.x) + s4.x;
      float h1 = v[i].y * rstd * gg.y * (1.f + c4.y) + s4.y;
      float h2 = v[i].z * rstd * gg.z * (1.f + c4.z) + s4.z;
      float h3 = v[i].w * rstd * gg.w * (1.f + c4.w) + s4.w;
      uint2 o; o.x = pack2(h0, h1); o.y = pack2(h2, h3);
      *reinterpret_cast<uint2*>(p.abuf + (long)row * D + col) = o;
    }
  }
}

#ifndef GP_DS
#define GP_DS 0
#endif
#ifndef GP_MFMA
#define GP_MFMA 0
#endif
__device__ __forceinline__ int swz4(int row) { return (0x78 >> (((row >> 2) & 3) * 2)) & 3; }
template <typename AMap, typename BMap>
__device__ __forceinline__ void gemm_tile(const u16* __restrict__ A, long lda, const u16* __restrict__ Bt, long ldb, int K,
                                          AMap amap, BMap bmap, f32x4 (&acc)[4][8]) {
  char* S = (char*)smem;
  const int tid = opaque_tid(), lane = tid & 63, fr = lane & 15, fq = lane >> 4;
  const int wid = __builtin_amdgcn_readfirstlane(tid >> 6), wr = wid >> 1, wc = wid & 1;
  const u16* pa[2];
  const u16* pb[4];
#pragma unroll
  for (int i = 0; i < 2; ++i) {
    const int q = i * 256 + tid, r = q >> 2, kc = (q & 3) ^ swz4(r);
    pa[i] = A + (long)amap(r) * lda + kc * 8;
  }
#pragma unroll
  for (int i = 0; i < 4; ++i) {
    const int q = i * 256 + tid, r = q >> 2, kc = (q & 3) ^ swz4(r);
    pb[i] = Bt + (long)bmap(r) * ldb + kc * 8;
  }
#pragma unroll
  for (int m = 0; m < 4; ++m)
#pragma unroll
    for (int n = 0; n < 8; ++n) acc[m][n] = f32x4{0.f, 0.f, 0.f, 0.f};
  const int nk = K / 32;
  int offA[4], offB[8];
#pragma unroll
  for (int m = 0; m < 4; ++m) { const int ra = wr * 64 + m * 16 + fr; offA[m] = ra * 64 + ((fq ^ swz4(ra)) << 4); }
#pragma unroll
  for (int n = 0; n < 8; ++n) { const int rb = wc * 128 + n * 16 + fr; offB[n] = 8192 + rb * 64 + ((fq ^ swz4(rb)) << 4); }
  __syncthreads();
#pragma unroll
  for (int t = 0; t < 2; ++t) {
    char* st = S + t * 24576;
#pragma unroll
    for (int i = 0; i < 2; ++i) __builtin_amdgcn_global_load_lds((const unsigned*)(pa[i] + t * 32), (LAS unsigned*)(st + (i * 256 + tid) * 16), 16, 0, 0);
#pragma unroll
    for (int i = 0; i < 4; ++i) __builtin_amdgcn_global_load_lds((const unsigned*)(pb[i] + t * 32), (LAS unsigned*)(st + 8192 + (i * 256 + tid) * 16), 16, 0, 0);
  }
  int cs = 0;
  for (int kt = 0; kt < nk; ++kt) {
    if (kt + 1 < nk) asm volatile("s_waitcnt vmcnt(6)" ::: "memory");
    else asm volatile("s_waitcnt vmcnt(0)" ::: "memory");
    __builtin_amdgcn_s_barrier();
    asm volatile("" ::: "memory");
    char* cur = S + cs * 24576;
    if (kt + 2 < nk) {
      int ns = cs + 2; if (ns >= 3) ns -= 3;
      char* nx = S + ns * 24576;
#pragma unroll
      for (int i = 0; i < 2; ++i) __builtin_amdgcn_global_load_lds((const unsigned*)(pa[i] + (kt + 2) * 32), (LAS unsigned*)(nx + (i * 256 + tid) * 16), 16, 0, 0);
#pragma unroll
      for (int i = 0; i < 4; ++i) __builtin_amdgcn_global_load_lds((const unsigned*)(pb[i] + (kt + 2) * 32), (LAS unsigned*)(nx + 8192 + (i * 256 + tid) * 16), 16, 0, 0);
    }
#if GP_NOBAR2
#endif
    bf16x8 af[4], bfr[8];
#pragma unroll
    for (int m = 0; m < 4; ++m) af[m] = *reinterpret_cast<const bf16x8*>(cur + offA[m]);
#pragma unroll
    for (int n = 0; n < 8; ++n) bfr[n] = *reinterpret_cast<const bf16x8*>(cur + offB[n]);
#if GP_DS
    {
      bf16x8 t2[4];
#pragma unroll
      for (int rr = 0; rr < 3; ++rr) {
#pragma unroll
        for (int m = 0; m < 4; ++m) t2[m] = *reinterpret_cast<const volatile bf16x8*>(cur + offB[m + (rr & 1) * 4]);
#pragma unroll
        for (int m = 0; m < 4; ++m) asm volatile("" :: "v"(t2[m]));
      }
    }
#endif
#pragma unroll
    for (int m = 0; m < 4; ++m)
#pragma unroll
      for (int n = 0; n < 8; ++n) acc[m][n] = MFMA16(bfr[n], af[m], acc[m][n]);
#if GP_MFMA
    {
      f32x4 d2[8];
#pragma unroll
      for (int n = 0; n < 8; ++n) d2[n] = f32x4{0.f, 0.f, 0.f, 0.f};
#pragma unroll
      for (int m = 0; m < 4; ++m)
#pragma unroll
        for (int n = 0; n < 8; ++n) d2[n] = MFMA16(bfr[n], af[m], d2[n]);
#pragma unroll
      for (int n = 0; n < 8; ++n) asm volatile("" :: "v"(d2[n]));
    }
#endif
    cs = cs + 1; if (cs >= 3) cs = 0;
  }
  __syncthreads();
}
#ifndef RP_A
#define RP_A 1
#endif
#ifndef RP_B
#define RP_B 1
#endif
#ifndef RP_C
#define RP_C 1
#endif
#ifndef RP_D
#define RP_D 1
#endif
template <int KK, int NT>
__device__ __forceinline__ void mm_strip(const u16* A, int lda, int arow0, const u16* Bt, int ldb, int brow0, f32x4* acc, int lane) {
  const int fr = lane & 15, fq = lane >> 4;
#pragma unroll
  for (int ks = 0; ks < KK / 32; ++ks) {
    bf16x8 a = *reinterpret_cast<const bf16x8*>(A + (arow0 + fr) * lda + ks * 32 + fq * 8);
#pragma unroll
    for (int nt = 0; nt < NT; ++nt) {
      bf16x8 b = *reinterpret_cast<const bf16x8*>(Bt + (brow0 + nt * 16 + fr) * ldb + ks * 32 + fq * 8);
      acc[nt] = MFMA16(a, b, acc[nt]);
    }
  }
}

template <int t>
__device__ __forceinline__ void solve_load_row(uint4 (&r)[8], const u16* Ls) {
  constexpr int nb = ((t + 1) / 2 + 3) / 4;
#pragma unroll
  for (int q = 0; q < nb; ++q) r[q] = *reinterpret_cast<const uint4*>(Ls + t * 72 + q * 8);
}
template <int t, bool IDENT>
__device__ __forceinline__ void solve_rows(float (&x)[64], unsigned (&xp)[32], const u16* Ls, int lane, uint4 (&r0)[8], uint4 (&r1)[8], uint4 (&r2)[8]) {
  if constexpr (t + 2 < 64) solve_load_row<t + 2>(r2, Ls);
  __builtin_amdgcn_sched_barrier(0);
  constexpr int npair = (t + 1) / 2, nb = (npair + 3) / 4;
  float sa[2] = {0.f, 0.f};
#pragma unroll
  for (int q = 0; q < nb; ++q) {
    const unsigned w[4] = {r0[q].x, r0[q].y, r0[q].z, r0[q].w};
#pragma unroll
    for (int e = 0; e < 4; ++e)
      if (q * 4 + e < npair) sa[e & 1] = dot2bf(w[e], xp[q * 4 + e], sa[e & 1]);
  }
  const float xt = (IDENT ? (lane == t ? 1.f : 0.f) : x[t]) - (sa[0] + sa[1]);
  x[t] = xt;
  if constexpr (t & 1) xp[t >> 1] = pack2(x[t - 1], xt);
  else xp[t >> 1] = pack2(xt, 0.f);
  if constexpr (t + 1 < 64) solve_rows<t + 1, IDENT>(x, xp, Ls, lane, r1, r2, r0);
}
template <bool IDENT = false>
__device__ __forceinline__ void fwd_solve64(float (&x)[64], const u16* Ls, u16* dst, int lane = 0) {
  unsigned xp[32];
  uint4 r0[8], r1[8], r2[8];
  solve_load_row<1>(r0, Ls);
  solve_load_row<2>(r1, Ls);
  if (IDENT) x[0] = (lane == 0) ? 1.f : 0.f;
  xp[0] = pack2(x[0], 0.f);
  solve_rows<1, IDENT>(x, xp, Ls, lane, r0, r1, r2);
#pragma unroll
  for (int q = 0; q < 8; ++q) {
    uint4 o;
    o.x = xp[4 * q + 0] ^ 0x80008000u; o.y = xp[4 * q + 1] ^ 0x80008000u;
    o.z = xp[4 * q + 2] ^ 0x80008000u; o.w = xp[4 * q + 3] ^ 0x80008000u;
    *reinterpret_cast<uint4*>(dst + 8 * q) = o;
  }
}

__device__ __forceinline__ void load_mixed8(const u16* pz, bool hp, bool hn, const float* m0, float* out) {
  float c[8], pv[8], nx[8];
  ld8(pz, c);
  if (hp) ld8(pz - AB_IN, pv);
  else {
#pragma unroll
    for (int e = 0; e < 8; ++e) pv[e] = 0.f;
  }
  if (hn) ld8(pz + AB_IN, nx);
  else {
#pragma unroll
    for (int e = 0; e < 8; ++e) nx[e] = 0.f;
  }
  const float4 a0 = *reinterpret_cast<const float4*>(m0), a1 = *reinterpret_cast<const float4*>(m0 + 4);
  const float4 b0 = *reinterpret_cast<const float4*>(m0 + RWKV_IN), b1 = *reinterpret_cast<const float4*>(m0 + RWKV_IN + 4);
  const float ma[8] = {a0.x, a0.y, a0.z, a0.w, a1.x, a1.y, a1.z, a1.w};
  const float mb[8] = {b0.x, b0.y, b0.z, b0.w, b1.x, b1.y, b1.z, b1.w};
#pragma unroll
  for (int e = 0; e < 8; ++e) out[e] = c[e] + ma[e] * (pv[e] - c[e]) + mb[e] * (nx[e] - c[e]);
}
__device__ __forceinline__ void load_mixed16(const u16* zb, long row, int pp, int col, const float* mu, float* out) {
  const u16* pz = zb + row * AB_IN + col;
  const bool hp = !(pp == 0 || pp == CTXL), hn = !(pp == CTXL - 1 || pp == PB - 1);
  load_mixed8(pz, hp, hn, mu + (col - 256), out);
  __builtin_amdgcn_sched_barrier(0);
  load_mixed8(pz + 8, hp, hn, mu + (col - 256) + 8, out + 8);
  __builtin_amdgcn_sched_barrier(0);
}

template <int DIR>
__device__ __forceinline__ void load_mixed_2x8(const u16* zb, int b, int c, int rp, int col, const float* mu, float (&out)[2][8]) {
  const int tmin = DIR ? 62 - 2 * rp : 2 * rp;
  const int pp0 = c * 64 + tmin;
  const int seg_lo = (c < 4) ? 0 : CTXL, seg_hi = (c < 4) ? CTXL : PB;
  const u16* pz = zb + ((long)b * PB + pp0) * AB_IN + col;
  float zr[4][8];
#pragma unroll
  for (int j = 0; j < 4; ++j) {
    const int pt = pp0 - 1 + j;
    if (pt >= seg_lo && pt < seg_hi) ld8(pz + (long)(j - 1) * AB_IN, zr[j]);
    else {
#pragma unroll
      for (int e = 0; e < 8; ++e) zr[j][e] = 0.f;
    }
  }
  const float* m0 = mu + (col - 256);
  const float4 a0 = *reinterpret_cast<const float4*>(m0), a1 = *reinterpret_cast<const float4*>(m0 + 4);
  const float4 b0 = *reinterpret_cast<const float4*>(m0 + RWKV_IN), b1 = *reinterpret_cast<const float4*>(m0 + RWKV_IN + 4);
  const float ma[8] = {a0.x, a0.y, a0.z, a0.w, a1.x, a1.y, a1.z, a1.w};
  const float mb[8] = {b0.x, b0.y, b0.z, b0.w, b1.x, b1.y, b1.z, b1.w};
#pragma unroll
  for (int r = 0; r < 2; ++r) {
    const int to = DIR ? 1 - r : r;
#pragma unroll
    for (int e = 0; e < 8; ++e) {
      const float cc = zr[to + 1][e];
      out[r][e] = cc + ma[e] * (zr[to][e] - cc) + mb[e] * (zr[to + 2][e] - cc);
    }
  }
}

using u32x4 = __attribute__((ext_vector_type(4))) unsigned;
__device__ __forceinline__ void load_raw4(const char* ub, unsigned loff, int c, int tmin, u32x4 (&raw)[4]) {
  const int pp0 = c * 64 + tmin;
  const int seg_lo = (c < 4) ? 0 : CTXL, seg_hi = (c < 4) ? CTXL : PB;
#pragma unroll
  for (int j = 0; j < 4; ++j) {
    const int pt = pp0 - 1 + j;
    if (pt >= seg_lo && pt < seg_hi) raw[j] = *reinterpret_cast<const u32x4*>(ub + (long)(j - 1) * (AB_IN * 2) + loff);
    else raw[j] = u32x4{0u, 0u, 0u, 0u};
  }
}
template <int DIR>
__device__ __forceinline__ void mix_raw_2x8(const u32x4 (&raw)[4], int col, const float* mu, float (&out)[2][8]) {
  float zr[4][8];
#pragma unroll
  for (int j = 0; j < 4; ++j) {
#pragma unroll
    for (int q = 0; q < 4; ++q) { zr[j][2 * q] = __uint_as_float(raw[j][q] << 16); zr[j][2 * q + 1] = __uint_as_float(raw[j][q] & 0xffff0000u); }
  }
  const float* m0 = mu + (col - 256);
  const float4 a0 = *reinterpret_cast<const float4*>(m0), a1 = *reinterpret_cast<const float4*>(m0 + 4);
  const float4 b0 = *reinterpret_cast<const float4*>(m0 + RWKV_IN), b1 = *reinterpret_cast<const float4*>(m0 + RWKV_IN + 4);
  const float ma[8] = {a0.x, a0.y, a0.z, a0.w, a1.x, a1.y, a1.z, a1.w};
  const float mb[8] = {b0.x, b0.y, b0.z, b0.w, b1.x, b1.y, b1.z, b1.w};
#pragma unroll
  for (int r = 0; r < 2; ++r) {
    const int to = DIR ? 1 - r : r;
#pragma unroll
    for (int e = 0; e < 8; ++e) {
      const float cc = zr[to + 1][e];
      out[r][e] = cc + ma[e] * (zr[to][e] - cc) + mb[e] * (zr[to + 2][e] - cc);
    }
  }
}

#ifndef RW_LATE
#define RW_LATE 1
#endif
#ifndef RW_R0
#define RW_R0 22
#endif
#ifndef RW_CUT
#define RW_CUT 230
#endif
constexpr int RW_N0_ = RW_LATE ? RW_R0 * 512 : NB * NCH * 12 * 2;
template <int DIR, bool LATEPART>
__device__ __forceinline__ void rwkv_prep_all(const Params& p) {
  constexpr int RWN_ = NB * NCH * 12 * 2;
  const int it_first = LATEPART ? RW_N0_ + VBID - 96 : VBID, it_end = LATEPART ? RWN_ : RW_N0_, it_stride = LATEPART ? NVB - 96 : NVB;
  const u16* z = p.zbuf;
  const float* mu = p.ab_mu;
  u32x4 rwd[4], rad[4], rk[4], rr[4], rv[4], swv[2], sav[2];
#define RWKV_ZB(B_, C_, COL) ((const char*)(z + ((long)(B_) * PB + (C_) * 64) * AB_IN + (COL)))
#define RWKV_ISSUE(IT, TID) do { int r_ = (IT) >> 1; const int h_ = r_ % 12; r_ /= 12; const int b_ = r_ % NB, o_ = r_ / NB; \
    const int c_ = DIR ? (o_ < 4 ? 3 - o_ : 263 - o_) : o_; \
    const int rp_ = (TID) >> 3, tmin_ = DIR ? 62 - 2 * rp_ : 2 * rp_; \
    const unsigned zoff_ = (unsigned)(tmin_ * AB_IN + ((TID) & 7) * 8) * 2u, woff_ = (unsigned)(((TID) >> 2) * 64 + ((TID) & 3) * 16) * 2u; \
    load_raw4(RWKV_ZB(b_, c_, 2688 + DIR * 64), zoff_, c_, tmin_, rwd); \
    load_raw4(RWKV_ZB(b_, c_, 2816 + DIR * 64), zoff_, c_, tmin_, rad); \
    const char* sw_ = (const char*)(p.WupT + ((long)DIR * 768 + 64 * h_) * 64); \
    const char* sa_ = (const char*)(p.AupT + ((long)DIR * 768 + 64 * h_) * 64); \
    swv[0] = *reinterpret_cast<const u32x4*>(sw_ + woff_); swv[1] = *reinterpret_cast<const u32x4*>(sw_ + 16 + woff_); \
    sav[0] = *reinterpret_cast<const u32x4*>(sa_ + woff_); sav[1] = *reinterpret_cast<const u32x4*>(sa_ + 16 + woff_); } while (0)
  { const int tid0 = opaque_tid(); RWKV_ISSUE(min(it_first, it_end - 2), tid0); }
#pragma unroll 1
  for (int it = it_first; it < it_end; it += it_stride) {
  u16* buf[8];
#pragma unroll
  for (int i = 0; i < 8; ++i) buf[i] = (u16*)(smem + i * MB);
  float* LW = (float*)(smem + 5 * MB);
  u16* AA = buf[7];
  float* gC = (float*)(smem + 8 * MB);
  const int tid = opaque_tid(), lane = tid & 63, wid = tid >> 6, fr = lane & 15, fq = lane >> 4;
  const int i = tid >> 2, sub = tid & 3, cj = sub * 16;
  const int cg8 = (tid & 7) * 8, rp = tid >> 3;
  const int tmin = DIR ? 62 - 2 * rp : 2 * rp;
  const unsigned zoff = (unsigned)(tmin * AB_IN + cg8) * 2u;
  int b, c, h;
  { int r_ = it >> 1; h = r_ % 12; r_ /= 12; b = r_ % NB; const int o_ = r_ / NB; c = DIR ? (o_ < 4 ? 3 - o_ : 263 - o_) : o_; }
  load_raw4(RWKV_ZB(b, c, 1024 + 64 * h), zoff, c, tmin, rk);
  load_raw4(RWKV_ZB(b, c, 256 + 64 * h), zoff, c, tmin, rr);
  load_raw4(RWKV_ZB(b, c, 1792 + 64 * h), zoff, c, tmin, rv);
  {
    {
      const int cg = cg8;
      float wd[2][8], ad[2][8];
      mix_raw_2x8<DIR>(rwd, 2688 + DIR * 64 + cg, mu, wd);
      mix_raw_2x8<DIR>(rad, 2816 + DIR * 64 + cg, mu, ad);
#pragma unroll
      for (int r = 0; r < 2; ++r) {
#pragma unroll
        for (int e = 0; e < 8; ++e) wd[r][e] = tanhf_(wd[r][e]);
        st8(buf[0] + (2 * rp + r) * 72 + cg, wd[r]);
        st8(buf[1] + (2 * rp + r) * 72 + cg, ad[r]);
      }
    }
    *reinterpret_cast<u32x4*>(buf[2] + i * 72 + cj) = swv[0];
    *reinterpret_cast<u32x4*>(buf[2] + i * 72 + cj + 8) = swv[1];
    *reinterpret_cast<u32x4*>(buf[3] + i * 72 + cj) = sav[0];
    *reinterpret_cast<u32x4*>(buf[3] + i * 72 + cj + 8) = sav[1];
  }
  __syncthreads();
  {
    f32x4 aw[4], aa[4];
#pragma unroll
    for (int n = 0; n < 4; ++n) { aw[n] = f32x4{0.f, 0.f, 0.f, 0.f}; aa[n] = f32x4{0.f, 0.f, 0.f, 0.f}; }
    mm_strip<64, 4>(buf[0], 72, 16 * wid, buf[2], 72, 0, aw, lane);
    mm_strip<64, 4>(buf[1], 72, 16 * wid, buf[3], 72, 0, aa, lane);
    float* stot = gC + 64;
    float cum[4][4];
#pragma unroll
    for (int nt = 0; nt < 4; ++nt) {
      const int col = 16 * nt + fr, ch = 64 * h + col;
      const float w0v = p.rwkv_w0[DIR * 768 + ch], a0v = p.rwkv_a0[DIR * 768 + ch];
      float run = 0.f;
#pragma unroll
      for (int j = 0; j < 4; ++j) {
        const int t = 16 * wid + 4 * fq + j;
        const float xw = w0v + aw[nt][j];
        const float wlog = -softplusf_(-xw) - 0.5f;
        run += -__expf(wlog);
        cum[nt][j] = run;
        AA[t * 72 + col] = f2bf(sigmoidf_(a0v + aa[nt][j]));
      }
      const float s1 = __shfl_up(run, 16), s2 = __shfl_up(run, 32), s3 = __shfl_up(run, 48);
      const float excl = (fq >= 1 ? s1 : 0.f) + (fq >= 2 ? s2 : 0.f) + (fq >= 3 ? s3 : 0.f);
#pragma unroll
      for (int j = 0; j < 4; ++j) cum[nt][j] += excl;
      if (fq == 3) stot[wid * 64 + col] = cum[nt][3];
    }
    __syncthreads();
#pragma unroll
    for (int nt = 0; nt < 4; ++nt) {
      const int col = 16 * nt + fr;
      float off = 0.f;
#pragma unroll
      for (int w2 = 0; w2 < 3; ++w2) off += (w2 < wid) ? stot[w2 * 64 + col] : 0.f;
#pragma unroll
      for (int j = 0; j < 4; ++j) LW[(16 * wid + 4 * fq + j) * 65 + col] = cum[nt][j] + off;
      if (wid == 3 && fq == 3) gC[col] = __expf(cum[nt][3] + off);
    }
  }
  __syncthreads();
  {
    const int cg = cg8;
    float k8[2][8], Lg[2][8];
    mix_raw_2x8<DIR>(rk, 1024 + 64 * h + cg, mu, k8);
#pragma unroll
    for (int r = 0; r < 2; ++r) {
      const int ii = 2 * rp + r;
      float kk[8], ss = 0.f;
#pragma unroll
      for (int e = 0; e < 8; ++e) { kk[e] = k8[r][e] * p.rwkv_k_k[64 * h + cg + e]; ss += kk[e] * kk[e]; }
      ss += __shfl_xor(ss, 1); ss += __shfl_xor(ss, 2); ss += __shfl_xor(ss, 4);
      const float inv = rsqrtf(ss + 1e-6f);
      float Ah[8], Bh[8], Kh[8];
#pragma unroll
      for (int e = 0; e < 8; ++e) {
        const int col = cg + e;
        Lg[r][e] = LW[ii * 65 + col];
        const float Lgm1 = ii > 0 ? LW[(ii - 1) * 65 + col] : 0.f;
        const float a = bf2f(AA[ii * 72 + col]);
        const float kkn = kk[e] * inv;
        const float einv = __expf(-Lg[r][e]);
        const float kt = k8[r][e] * (1.f + (a - 1.f) * p.rwkv_k_a[64 * h + col]);
        Ah[e] = __expf(Lgm1) * kkn;
        Bh[e] = kkn * a * einv;
        Kh[e] = kt * einv;
      }
      st8(buf[0] + ii * 72 + cg, Ah);
      st8(buf[1] + ii * 72 + cg, Bh);
      st8(buf[2] + ii * 72 + cg, Kh);
    }
    __builtin_amdgcn_sched_barrier(0);
    {
      float r8[2][8];
      mix_raw_2x8<DIR>(rr, 256 + 64 * h + cg, mu, r8);
#pragma unroll
      for (int r = 0; r < 2; ++r) {
#pragma unroll
        for (int e = 0; e < 8; ++e) r8[r][e] *= __expf(Lg[r][e]);
        st8(buf[3] + (2 * rp + r) * 72 + cg, r8[r]);
      }
    }
    __builtin_amdgcn_sched_barrier(0);
    {
      float v8[2][8];
      mix_raw_2x8<DIR>(rv, 1792 + 64 * h + cg, mu, v8);
#pragma unroll
      for (int r = 0; r < 2; ++r)
#pragma unroll
        for (int e = 0; e < 8; ++e) buf[4][(cg + e) * 72 + 2 * rp + r] = f2bf(v8[r][e]);
    }
  }
  __syncthreads();
  {
    f32x4 a1[4], a2[4];
#pragma unroll
    for (int n = 0; n < 4; ++n) { a1[n] = f32x4{0.f, 0.f, 0.f, 0.f}; a2[n] = f32x4{0.f, 0.f, 0.f, 0.f}; }
    mm_strip<64, 4>(buf[0], 72, 16 * wid, buf[1], 72, 0, a1, lane);
    mm_strip<64, 4>(buf[0], 72, 16 * wid, buf[2], 72, 0, a2, lane);
#pragma unroll
    for (int nt = 0; nt < 4; ++nt)
#pragma unroll
      for (int j = 0; j < 4; ++j) {
        int t = 16 * wid + 4 * fq + j, s = 16 * nt + fr;
        buf[5][t * 72 + s] = f2bf(s < t ? a1[nt][j] : 0.f);
        buf[6][t * 72 + s] = f2bf(s < t ? a2[nt][j] : 0.f);
      }
  }
  __syncthreads();
  {
    f32x4 a1[4];
#pragma unroll
    for (int n = 0; n < 4; ++n) a1[n] = f32x4{0.f, 0.f, 0.f, 0.f};
    mm_strip<64, 4>(buf[6], 72, 16 * wid, buf[4], 72, 0, a1, lane);
#pragma unroll
    for (int nt = 0; nt < 4; ++nt)
#pragma unroll
      for (int j = 0; j < 4; ++j) {
        int t = 16 * wid + 4 * fq + j, v = 16 * nt + fr;
        buf[7][v * 72 + t] = f2bf(a1[nt][j]);
      }
  }
  __syncthreads();
  {
    float xr[64];
    const int st = tid ^ (half_id() << 7);
    if (st < 64) {
#pragma unroll
      for (int t = 0; t < 64; ++t) xr[t] = bf2f(buf[0][t * 72 + st]);
    } else if (st < 128) {
#pragma unroll
      for (int t = 0; t < 64; t += 8) ld8(buf[7] + (st - 64) * 72 + t, xr + t);
    }
    __syncthreads();
    if (st < 128) {
      u16* dst = st < 64 ? buf[0] + st * 72 : buf[7] + (st - 64) * 72;
      fwd_solve64(xr, buf[5], dst);
    }
  }
  { const int tidn = opaque_tid(); RWKV_ISSUE((it + it_stride < it_end ? it + it_stride : it), tidn); }
  __syncthreads();
  {
    unsigned bgp[8], kgp[8];
    {
      float bs[16], ks_[16];
      ld8(buf[1] + i * 72 + cj, bs); ld8(buf[1] + i * 72 + cj + 8, bs + 8);
      ld8(buf[2] + i * 72 + cj, ks_); ld8(buf[2] + i * 72 + cj + 8, ks_ + 8);
#pragma unroll
      for (int e = 0; e < 8; ++e) {
        float g0 = gC[cj + 2 * e], g1 = gC[cj + 2 * e + 1];
        bgp[e] = pack2(bs[2 * e] * g0, bs[2 * e + 1] * g1);
        kgp[e] = pack2(ks_[2 * e] * g0, ks_[2 * e + 1] * g1);
      }
    }
    f32x4 a1[4], a2[4];
#pragma unroll
    for (int n = 0; n < 4; ++n) { a1[n] = f32x4{0.f, 0.f, 0.f, 0.f}; a2[n] = f32x4{0.f, 0.f, 0.f, 0.f}; }
    mm_strip<64, 4>(buf[3], 72, 16 * wid, buf[2], 72, 0, a1, lane);
    mm_strip<64, 4>(buf[3], 72, 16 * wid, buf[1], 72, 0, a2, lane);
    __syncthreads();
#pragma unroll
    for (int nt = 0; nt < 4; ++nt)
#pragma unroll
      for (int j = 0; j < 4; ++j) {
        int t = 16 * wid + 4 * fq + j, s = 16 * nt + fr;
        buf[5][t * 72 + s] = f2bf(s <= t ? a1[nt][j] : 0.f);
        buf[6][t * 72 + s] = f2bf(s <= t ? a2[nt][j] : 0.f);
      }
#pragma unroll
    for (int e = 0; e < 8; ++e) {
      buf[1][(cj + 2 * e) * 72 + i] = (u16)(bgp[e] & 0xffffu);
      buf[1][(cj + 2 * e + 1) * 72 + i] = (u16)(bgp[e] >> 16);
      buf[2][(cj + 2 * e) * 72 + i] = (u16)(kgp[e] & 0xffffu);
      buf[2][(cj + 2 * e + 1) * 72 + i] = (u16)(kgp[e] >> 16);
    }
  }
  __syncthreads();
  {
    u16* outp = p.prep + ((long)((b * 12 + h) * 2 + DIR) * NCH + c) * RW_ITEM;
    const int pq = wid & 1, ntp = (wid >> 1) * 2;
#pragma unroll
    for (int nn = 0; nn < 2; ++nn) {
      const int nt = ntp + nn;
      f32x4 m0 = f32x4{0.f, 0.f, 0.f, 0.f}, m1 = m0, q0 = m0, q1 = m0;
      mm_strip<64, 1>(buf[0], 72, 16 * (2 * pq), buf[1], 72, 16 * nt, &m0, lane);
      mm_strip<64, 1>(buf[0], 72, 16 * (2 * pq + 1), buf[1], 72, 16 * nt, &m1, lane);
      mm_strip<64, 1>(buf[0], 72, 16 * (2 * pq), buf[6], 72, 16 * nt, &q0, lane);
      mm_strip<64, 1>(buf[0], 72, 16 * (2 * pq + 1), buf[6], 72, 16 * nt, &q1, lane);
      float o[8], oq[8];
#pragma unroll
      for (int j = 0; j < 4; ++j) {
        int k0 = 16 * (2 * pq) + 4 * fq + j, k1 = k0 + 16, kp = 16 * nt + fr;
        o[j] = m0[j] + (k0 == kp ? gC[kp] : 0.f);
        o[4 + j] = m1[j] + (k1 == kp ? gC[kp] : 0.f);
        oq[j] = q0[j] + bf2f(buf[3][kp * 72 + k0]);
        oq[4 + j] = q1[j] + bf2f(buf[3][kp * 72 + k1]);
      }
      st8(outp + ((nt * 2 + pq) * 64 + lane) * 8, o);
      st8(outp + (((4 + nt) * 2 + pq) * 64 + lane) * 8, oq);
    }
    f32x4 an[4], ay[4];
#pragma unroll
    for (int n = 0; n < 4; ++n) { an[n] = f32x4{0.f, 0.f, 0.f, 0.f}; ay[n] = f32x4{0.f, 0.f, 0.f, 0.f}; }
    mm_strip<64, 4>(buf[2], 72, 16 * wid, buf[4], 72, 0, an, lane);
    mm_strip<64, 4>(buf[1], 72, 16 * wid, buf[7], 72, 0, an, lane);
    mm_strip<64, 4>(buf[5], 72, 16 * wid, buf[4], 72, 0, ay, lane);
    mm_strip<64, 4>(buf[6], 72, 16 * wid, buf[7], 72, 0, ay, lane);
#pragma unroll
    for (int nt = 0; nt < 4; ++nt) {
      uint2 o1, o2;
      o1.x = pack2(an[nt][0], an[nt][1]); o1.y = pack2(an[nt][2], an[nt][3]);
      o2.x = pack2(ay[nt][0], ay[nt][1]); o2.y = pack2(ay[nt][2], ay[nt][3]);
      *reinterpret_cast<uint2*>(outp + 8192 + ((wid * 4 + nt) * 64 + lane) * 4) = o1;
      *reinterpret_cast<uint2*>(outp + 8192 + (((4 + wid) * 4 + nt) * 64 + lane) * 4) = o2;
    }
  }
  __syncthreads();
  }
#undef RWKV_ISSUE
#undef RWKV_ZB
}

__device__ __forceinline__ void pool_item(const Params& p, int b, int rb, int g) {
  float* vs = (float*)smem;
  u16* As = (u16*)(smem + 16640);
  u16* Bs = (u16*)(smem + 16640 + MB);
  const int tid = opaque_tid(), lane = tid & 63, wid = tid >> 6, fr = lane & 15, fq = lane >> 4;
  const int w = 2 << g, hw = w >> 1;
  const u16* z = p.zbuf;
  const bool isctx = rb >= 256;
  {
    int n = tid >> 2, part = (tid & 3) * 16;
    const u16* s = p.PoolT + ((long)g * 64 + n) * 64 + part;
    *reinterpret_cast<uint4*>(Bs + n * 72 + part) = *reinterpret_cast<const uint4*>(s);
    *reinterpret_cast<uint4*>(Bs + n * 72 + part + 8) = *reinterpret_cast<const uint4*>(s + 8);
  }
  const int cg = (tid & 7) * 8, cl = tid >> 3;
  if (!isctx) {
    const int r_lo = max(rb - hw, 0), r_hi = min(rb + hw, 256);
#pragma unroll
    for (int k = 0; k < 2; ++k) {
      const int col = cl + 32 * k;
      float a8[8];
#pragma unroll
      for (int e = 0; e < 8; ++e) a8[e] = 0.f;
      for (int rr = r_lo; rr < r_hi; ++rr) {
        float v8[8];
        ld8(z + ((long)b * PB + CTXL + rr * 64 + col) * AB_IN + g * 64 + cg, v8);
#pragma unroll
        for (int e = 0; e < 8; ++e) a8[e] += v8[e];
      }
#pragma unroll
      for (int e = 0; e < 8; ++e) vs[col * 65 + cg + e] = a8[e];
    }
    __syncthreads();
#pragma unroll
    for (int k = 0; k < 2; ++k) {
      const int col = cl + 32 * k;
      const int c_lo = max(col - hw, 0), c_hi = min(col + hw, 64);
      float a8[8], pg[8], o8[8];
#pragma unroll
      for (int e = 0; e < 8; ++e) a8[e] = 0.f;
      for (int cc = c_lo; cc < c_hi; ++cc) {
#pragma unroll
        for (int e = 0; e < 8; ++e) a8[e] += vs[cc * 65 + cg + e];
      }
      const float rc = __builtin_amdgcn_rcpf((float)((r_hi - r_lo) * (c_hi - c_lo)));
      ld8(z + ((long)b * PB + CTXL + rb * 64 + col) * AB_IN + g * 64 + cg, pg);
#pragma unroll
      for (int e = 0; e < 8; ++e) o8[e] = a8[e] * rc - pg[e];
      st8(As + col * 72 + cg, o8);
    }
  } else {
    const int t0 = (rb - 256) * 64;
#pragma unroll
    for (int k = 0; k < 2; ++k) {
      const int col = cl + 32 * k, t = t0 + col;
      const int lo = max(t - hw, 0), hi = min(t + hw, CTXL);
      float a8[8], pg[8], o8[8];
#pragma unroll
      for (int e = 0; e < 8; ++e) a8[e] = 0.f;
      for (int tt = lo; tt < hi; ++tt) {
        float v8[8];
        ld8(z + ((long)b * PB + tt) * AB_IN + g * 64 + cg, v8);
#pragma unroll
        for (int e = 0; e < 8; ++e) a8[e] += v8[e];
      }
      const float rc = __builtin_amdgcn_rcpf((float)(hi - lo));
      ld8(z + ((long)b * PB + t) * AB_IN + g * 64 + cg, pg);
#pragma unroll
      for (int e = 0; e < 8; ++e) o8[e] = a8[e] * rc - pg[e];
      st8(As + col * 72 + cg, o8);
    }
  }
  __syncthreads();
  {
    f32x4 acc[4];
#pragma unroll
    for (int n = 0; n < 4; ++n) acc[n] = f32x4{0.f, 0.f, 0.f, 0.f};
    mm_strip<64, 4>(As, 72, 16 * wid, Bs, 72, 0, acc, lane);
    long row0 = isctx ? (long)b * PB + (rb - 256) * 64 : (long)b * PB + CTXL + rb * 64;
#pragma unroll
    for (int nt = 0; nt < 4; ++nt)
#pragma unroll
      for (int j = 0; j < 4; ++j) {
        int t = 16 * wid + 4 * fq + j, n = 16 * nt + fr;
        p.abuf[(row0 + t) * D + g * 64 + n] = f2bf(acc[nt][j] * p.pool_scale[g * 64 + n]);
      }
  }
  __syncthreads();
}

__device__ __forceinline__ void rwkv_scan_block(const Params& p, int sid, int s_begin, int s_end) {
  const int tid = opaque_tid(), lane = tid & 63, fr = lane & 15, fq = lane >> 4;
  const int wv = __builtin_amdgcn_readfirstlane(tid >> 6);
  const int d = sid & 1, bh = sid >> 1, b = bh / 12, h = bh % 12;
  const char* base = (const char*)(p.prep + (long)sid * NCH * RW_ITEM);
  char* L = (char*)smem;
  const unsigned lo16 = lane * 16u, lo8 = lane * 8u;
  f32x4* stsave = (f32x4*)(smem_raw + 98304) + tid * 4;
  f32x4 st[4];
#pragma unroll
  for (int i = 0; i < 4; ++i) st[i] = s_begin > 0 ? stsave[i] : f32x4{0.f, 0.f, 0.f, 0.f};
  auto chunk_of = [&](int step) { step = min(step, NCH - 1); return d == 0 ? step : (step < 4 ? 3 - step : 263 - step); };
  bf16x8 Ar[5][4];
  uint2 Cr[5][8];
#pragma unroll
  for (int u = 0; u < 4; ++u) {
    const char* it = base + (long)chunk_of(s_begin + u) * (RW_ITEM * 2);
    const char* pa = it + (wv * 4) * 1024;
    const char* pc = it + 16384 + wv * 512;
#pragma unroll
    for (int i = 0; i < 4; ++i) Ar[u][i] = *reinterpret_cast<const bf16x8*>(pa + i * 1024 + lo16);
#pragma unroll
    for (int rt = 0; rt < 8; ++rt) Cr[u][rt] = *reinterpret_cast<const uint2*>(pc + rt * 2048 + lo8);
  }
  __syncthreads();
#pragma unroll 1
  for (int s0 = s_begin; s0 < s_end; s0 += 5) {
#pragma unroll
    for (int u = 0; u < 5; ++u) {
      const int step = s0 + u;
      {
        const char* it = base + (long)chunk_of(step + 4) * (RW_ITEM * 2);
        const char* pa = it + (wv * 4) * 1024;
        const char* pc = it + 16384 + wv * 512;
#pragma unroll
        for (int i = 0; i < 4; ++i) Ar[(u + 4) % 5][i] = *reinterpret_cast<const bf16x8*>(pa + i * 1024 + lo16);
#pragma unroll
        for (int rt = 0; rt < 8; ++rt) Cr[(u + 4) % 5][rt] = *reinterpret_cast<const uint2*>(pc + rt * 2048 + lo8);
      }
      char* Lb = L + (step & 1) * 16384;
#pragma unroll
      for (int i = 0; i < 4; ++i) *reinterpret_cast<bf16x8*>(Lb + (wv * 4 + i) * 1024 + lo16) = Ar[u][i];
      asm volatile("s_waitcnt lgkmcnt(0)" ::: "memory");
      __builtin_amdgcn_s_barrier();
      asm volatile("" ::: "memory");
      bf16x8 bfr[2];
#pragma unroll
      for (int ks = 0; ks < 2; ++ks) {
        union { bf16x8 v; unsigned w[4]; } cv;
        cv.w[0] = pack2(st[2 * ks][0], st[2 * ks][1]); cv.w[1] = pack2(st[2 * ks][2], st[2 * ks][3]);
        cv.w[2] = pack2(st[2 * ks + 1][0], st[2 * ks + 1][1]); cv.w[3] = pack2(st[2 * ks + 1][2], st[2 * ks + 1][3]);
        bfr[ks] = cv.v;
      }
      const int c = chunk_of(step);
      u16* Yb = (u16*)(smem_raw + 32768) + (step & 1) * 4608;
#pragma unroll
      for (int rt = 0; rt < 8; ++rt) {
        f32x4 acc;
        acc[0] = __uint_as_float(Cr[u][rt].x << 16); acc[1] = __uint_as_float(Cr[u][rt].x & 0xffff0000u);
        acc[2] = __uint_as_float(Cr[u][rt].y << 16); acc[3] = __uint_as_float(Cr[u][rt].y & 0xffff0000u);
        bf16x8 a0 = *reinterpret_cast<const bf16x8*>(Lb + (rt * 2 + 0) * 1024 + lo16);
        bf16x8 a1 = *reinterpret_cast<const bf16x8*>(Lb + (rt * 2 + 1) * 1024 + lo16);
        acc = MFMA16(a0, bfr[0], acc);
        acc = MFMA16(a1, bfr[1], acc);
        if (rt < 4) st[rt] = acc;
        else {
#pragma unroll
          for (int j = 0; j < 4; ++j) {
            int t = 16 * (rt - 4) + 4 * fq + j;
            Yb[t * 72 + wv * 16 + fr] = f2bf(acc[j]);
          }
        }
      }
      __builtin_amdgcn_sched_barrier(0);
    }
  }
  if (s_end < NCH) {
#pragma unroll
    for (int i = 0; i < 4; ++i) stsave[i] = st[i];
  }
  __syncthreads();
}

__device__ __forceinline__ void rwkv_scan_copy(const Params& p, int sid, int s_begin, int s_end) {
  const int tid = opaque_tid();
  const int d = sid & 1, bh = sid >> 1, b = bh / 12, h = bh % 12;
  u16* ybuf = d ? p.yb : p.yf;
  const int t = tid >> 2, seg = tid & 3;
  const int tau = d ? 63 - t : t;
  auto chunk_of = [&](int step) { return d == 0 ? step : (step < 4 ? 3 - step : 263 - step); };
  auto copy = [&](int step) {
    const u16* Yb = (const u16*)(smem_raw + 32768) + (step & 1) * 4608 + t * 72 + seg * 16;
    const uint4 v0 = *reinterpret_cast<const uint4*>(Yb), v1 = *reinterpret_cast<const uint4*>(Yb + 8);
    u16* dst = ybuf + ((long)b * PB + chunk_of(step) * 64 + tau) * D + h * 64 + seg * 16;
    *reinterpret_cast<uint4*>(dst) = v0; *reinterpret_cast<uint4*>(dst + 8) = v1;
  };
  __syncthreads();
#pragma unroll 1
  for (int s_ = s_begin; s_ < s_end; ++s_) {
    __builtin_amdgcn_s_barrier();
    asm volatile("" ::: "memory");
    if (s_ > s_begin) copy(s_ - 1);
  }
  __syncthreads();
  copy(s_end - 1);
}

__device__ __forceinline__ void rwkv_out_item(const Params& p, int b, int c, int h) {
  u16* Ag = (u16*)smem;
  u16* Bg = (u16*)(smem + 17408);
  float* G = (float*)(smem + 2 * 17408);
  const int tid = opaque_tid(), lane = tid & 63, wid = tid >> 6, fr = lane & 15, fq = lane >> 4;
  const u16* z = p.zbuf;
  const float* mu = p.ab_mu;
  {
    const int cg = (tid & 15) * 8;
#pragma unroll 1
    for (int q = 0; q < 2; ++q) {
      const int rp = (tid >> 4) + 16 * q;
      float gd[2][8];
      load_mixed_2x8<0>(z, b, c, rp, 2560 + cg, mu, gd);
#pragma unroll
      for (int r = 0; r < 2; ++r) {
#pragma unroll
        for (int e = 0; e < 8; ++e) gd[r][e] = sigmoidf_(gd[r][e]);
        st8(Ag + (2 * rp + r) * 136 + cg, gd[r]);
      }
    }
    const int i = tid >> 2, sub = tid & 3;
    const u16* s = p.GupT + ((long)(64 * h + i)) * 128 + sub * 32;
#pragma unroll
    for (int e = 0; e < 32; e += 8) *reinterpret_cast<uint4*>(Bg + i * 136 + sub * 32 + e) = *reinterpret_cast<const uint4*>(s + e);
  }
  __syncthreads();
  {
    f32x4 acc[4];
#pragma unroll
    for (int n = 0; n < 4; ++n) acc[n] = f32x4{0.f, 0.f, 0.f, 0.f};
    mm_strip<128, 4>(Ag, 136, 16 * wid, Bg, 136, 0, acc, lane);
#pragma unroll
    for (int nt = 0; nt < 4; ++nt)
#pragma unroll
      for (int j = 0; j < 4; ++j) G[(16 * wid + 4 * fq + j) * 65 + 16 * nt + fr] = acc[nt][j];
  }
  __syncthreads();
  {
    const int cg = (tid & 7) * 8, rp = tid >> 3;
    const int ch = 64 * h + cg;
    float r8[2][8], k8[2][8], v8[2][8];
    load_mixed_2x8<0>(z, b, c, rp, 256 + ch, mu, r8);
    load_mixed_2x8<0>(z, b, c, rp, 1024 + ch, mu, k8);
    load_mixed_2x8<0>(z, b, c, rp, 1792 + ch, mu, v8);
    float rkw[8], gw8[8], gb8[8];
#pragma unroll
    for (int e = 0; e < 8; ++e) { rkw[e] = p.rwkv_r_k[ch + e]; gw8[e] = p.rwkv_gn_w[ch + e]; gb8[e] = p.rwkv_gn_b[ch + e]; }
#pragma unroll
    for (int r = 0; r < 2; ++r) {
      const int ii = 2 * rp + r;
      const long row = (long)b * PB + c * 64 + ii;
      float yf[8], yb[8];
      ld8(p.yf + row * D + ch, yf);
      ld8(p.yb + row * D + ch, yb);
      float s1 = 0.f, s2 = 0.f, bs = 0.f;
#pragma unroll
      for (int e = 0; e < 8; ++e) { yf[e] += yb[e]; s1 += yf[e]; s2 += yf[e] * yf[e]; bs += r8[r][e] * k8[r][e] * rkw[e]; }
      s1 += __shfl_xor(s1, 1); s1 += __shfl_xor(s1, 2); s1 += __shfl_xor(s1, 4);
      s2 += __shfl_xor(s2, 1); s2 += __shfl_xor(s2, 2); s2 += __shfl_xor(s2, 4);
      bs += __shfl_xor(bs, 1); bs += __shfl_xor(bs, 2); bs += __shfl_xor(bs, 4);
      const float mean = s1 * (1.f / 64.f);
      const float var = fmaxf(s2 * (1.f / 64.f) - mean * mean, 0.f);
      const float rstd = rsqrtf(var + 64e-5f);
      float o[8];
#pragma unroll
      for (int e = 0; e < 8; ++e) {
        const float yn = (yf[e] - mean) * rstd;
        o[e] = (yn * gw8[e] + gb8[e] + bs * v8[r][e]) * G[ii * 65 + cg + e];
      }
      st8(p.abuf + row * D + 256 + ch, o);
    }
  }
  __syncthreads();
}
#ifndef GDN_LATE
#define GDN_LATE 100
#endif
constexpr int GDN_S0_ = NCH - GDN_LATE, GDN_N0_ = GDN_S0_ * NB * 8 * 2, GDN_N_ = NCH * NB * 8 * 2;
template <int DIR, bool LATEPART>
__device__ __forceinline__ void gdn_prep_all(const Params& p) {
  const int it_first = LATEPART ? GDN_N0_ + VBID - 128 : VBID, it_end = LATEPART ? GDN_N_ : GDN_N0_, it_stride = LATEPART ? NVB - 128 : NVB;
  u32x4 rawq[7];
#define GDN_ISSUEQ(IT, TID) do { int r_ = (IT) >> 1; const int h_ = r_ % 8; r_ /= 8; const int b_ = r_ % NB, o_ = r_ / NB; \
    const int c_ = DIR ? (o_ < 4 ? 3 - o_ : 263 - o_) : o_; \
    const int rg_ = (TID) >> 4, tmin_ = DIR ? 60 - 4 * rg_ : 4 * rg_, pp0_ = c_ * 64 + tmin_; \
    const int lo_ = (c_ < 4) ? 0 : CTXL, hi_ = (c_ < 4) ? CTXL : PB; \
    const unsigned zoff_ = (unsigned)(tmin_ * GDN_IN + ((TID) & 15) * 8) * 2u; \
    const char* ub_ = (const char*)(p.zbuf + ((long)b_ * PB + c_ * 64) * GDN_IN + 128 * h_); \
    _Pragma("unroll") for (int j = 0; j < 7; ++j) { const int pt_ = pp0_ - 2 + j; \
      if (pt_ >= lo_ && pt_ < hi_) rawq[j] = *reinterpret_cast<const u32x4*>(ub_ + (long)(j - 2) * (GDN_IN * 2) + zoff_); \
      else rawq[j] = u32x4{0u, 0u, 0u, 0u}; } } while (0)
  { const int tid0 = opaque_tid(); GDN_ISSUEQ(min(it_first, it_end - 2), tid0); }
#pragma unroll 1
  for (int it = it_first; it < it_end; it += it_stride) {
  int b, c, h;
  { int r_ = it >> 1; h = r_ % 8; r_ /= 8; b = r_ % NB; const int o_ = r_ / NB; c = DIR ? (o_ < 4 ? 3 - o_ : 263 - o_) : o_; }
  u16* R1 = (u16*)smem;
  u16* R2 = (u16*)(smem + 18432);
  u16* Ls = (u16*)(smem + 36864);
  u16* As = (u16*)(smem + 46080);
  u16* Ut = (u16*)(smem + 55296);
  float* gc = (float*)(smem + 73728);
  float* bb = gc + 64;
  float* fac = gc + 128;
  const int tid = opaque_tid(), lane = tid & 63, wid = tid >> 6, fr = lane & 15, fq = lane >> 4;
  const int i = tid >> 2, sub = tid & 3;
  const int seg_lo = (c < 4) ? 0 : CTXL, seg_hi = (c < 4) ? CTXL : PB;
  const u16* z = p.zbuf;
  const float* cw = p.gdn_conv;
  {
    const int cg = (tid & 15) * 8, rg = tid >> 4;
    const int tmin = DIR ? 60 - 4 * rg : 4 * rg;
    const int pp0 = c * 64 + tmin;
    const unsigned zoff = (unsigned)(tmin * GDN_IN + cg) * 2u, woff = (unsigned)cg * 4u, soff = (unsigned)(tmin * GDN_IN) * 2u;
    const char* zrow = (const char*)(z + ((long)b * PB + c * 64) * GDN_IN);
    u32x4 raw[3][7];
#pragma unroll
    for (int j = 0; j < 7; ++j) raw[0][j] = rawq[j];
#pragma unroll
    for (int which = 1; which < 3; ++which) {
      const char* ub = zrow + (which * 1024 + 128 * h) * 2;
#pragma unroll
      for (int j = 0; j < 7; ++j) {
        const int pt = pp0 - 2 + j;
        if (pt >= seg_lo && pt < seg_hi) raw[which][j] = *reinterpret_cast<const u32x4*>(ub + (long)(j - 2) * (GDN_IN * 2) + zoff);
        else raw[which][j] = u32x4{0u, 0u, 0u, 0u};
      }
    }
    u16 braw[4], zraw[4];
#pragma unroll
    for (int r = 0; r < 4; ++r) {
      const int to = DIR ? 3 - r : r;
      braw[r] = *reinterpret_cast<const u16*>(zrow + (long)to * (GDN_IN * 2) + (4096 + DIR * 8 + h) * 2 + soff);
      zraw[r] = *reinterpret_cast<const u16*>(zrow + (long)to * (GDN_IN * 2) + (4096 + (2 + DIR) * 8 + h) * 2 + soff);
    }
    f32x4 wv[3][8];
#define GDN_LDW(W) do { const char* wb_ = (const char*)(cw + (W) * 1024 + 128 * h); _Pragma("unroll") for (int tap = 0; tap < 4; ++tap) { \
      wv[W][2 * tap] = *reinterpret_cast<const f32x4*>(wb_ + tap * 12288 + woff); \
      wv[W][2 * tap + 1] = *reinterpret_cast<const f32x4*>(wb_ + tap * 12288 + 16 + woff); } } while (0)
    GDN_LDW(0); GDN_LDW(1);
    __builtin_amdgcn_sched_barrier(0);
    float beta4[4];
#pragma unroll
    for (int r = 0; r < 4; ++r) beta4[r] = sigmoidf_(bf2f(braw[r]));
#pragma unroll
    for (int which = 0; which < 3; ++which) {
      fl2_t zr[7][4];
#pragma unroll
      for (int j = 0; j < 7; ++j) {
#pragma unroll
        for (int q = 0; q < 4; ++q) zr[j][q] = fl2_t{__uint_as_float(raw[which][j][q] << 16), __uint_as_float(raw[which][j][q] & 0xffff0000u)};
      }
      fl2_t w2[4][4];
#pragma unroll
      for (int tap = 0; tap < 4; ++tap) {
        w2[tap][0] = fl2_t{wv[which][2 * tap][0], wv[which][2 * tap][1]}; w2[tap][1] = fl2_t{wv[which][2 * tap][2], wv[which][2 * tap][3]};
        w2[tap][2] = fl2_t{wv[which][2 * tap + 1][0], wv[which][2 * tap + 1][1]}; w2[tap][3] = fl2_t{wv[which][2 * tap + 1][2], wv[which][2 * tap + 1][3]};
      }
      const fl2_t one2 = {1.0f, 1.0f}, nl2 = {-1.4426950408889634f, -1.4426950408889634f};
#pragma unroll
      for (int r = 0; r < 4; ++r) {
        const int to = DIR ? 3 - r : r;
        const int i = 4 * rg + r;
        fl2_t o2[4], ss2 = {0.f, 0.f};
#pragma unroll
        for (int q = 0; q < 4; ++q) {
          const fl2_t a = zr[to][q] * w2[0][q] + zr[to + 1][q] * w2[1][q] + zr[to + 2][q] * w2[2][q] + zr[to + 3][q] * w2[3][q];
          fl2_t e = a * nl2;
          e.x = __builtin_amdgcn_exp2f(e.x); e.y = __builtin_amdgcn_exp2f(e.y);
          e = e + one2;
          const fl2_t rc = {__builtin_amdgcn_rcpf(e.x), __builtin_amdgcn_rcpf(e.y)};
          o2[q] = a * rc;
          ss2 = ss2 + o2[q] * o2[q];
        }
        if (which < 2) {
          float ss = ss2.x + ss2.y;
          ss += __shfl_xor(ss, 1); ss += __shfl_xor(ss, 2); ss += __shfl_xor(ss, 4); ss += __shfl_xor(ss, 8);
          const float sc = rsqrtf(ss + 1e-6f) * (which == 0 ? 0.08838834764831845f : 1.0f);
          const fl2_t sc2 = {sc, sc};
          uint4 ov;
          ov.x = __builtin_bit_cast(unsigned, __builtin_convertvector(o2[0] * sc2, bf2_t)); ov.y = __builtin_bit_cast(unsigned, __builtin_convertvector(o2[1] * sc2, bf2_t));
          ov.z = __builtin_bit_cast(unsigned, __builtin_convertvector(o2[2] * sc2, bf2_t)); ov.w = __builtin_bit_cast(unsigned, __builtin_convertvector(o2[3] * sc2, bf2_t));
          *reinterpret_cast<uint4*>((which == 0 ? R2 : R1) + i * 136 + cg) = ov;
        } else {
          const fl2_t b2 = {beta4[r], beta4[r]};
#pragma unroll
          for (int q = 0; q < 4; ++q) {
            const unsigned pk = __builtin_bit_cast(unsigned, __builtin_convertvector(o2[q] * b2, bf2_t));
            Ut[(cg + 2 * q) * 72 + 63 - i] = (u16)(pk & 0xffffu);
            Ut[(cg + 2 * q + 1) * 72 + 63 - i] = (u16)(pk >> 16);
          }
        }
      }
      __builtin_amdgcn_sched_barrier(0);
      if (which == 0) { GDN_LDW(2); }
    }
#undef GDN_LDW
    if ((tid & 15) == 0) {
#pragma unroll
      for (int r = 0; r < 4; ++r) {
        const int i = 4 * rg + r;
        float za = bf2f(zraw[r]);
        bb[i] = beta4[r];
        gc[i] = -__expf(p.gdn_a_log[DIR * 8 + h]) * softplusf_(za + p.gdn_dt_bias[DIR * 8 + h]);
      }
    }
  }
  __syncthreads();
  if (wid == 0) {
    float v = gc[lane];
#pragma unroll
    for (int o = 1; o < 64; o <<= 1) { float u = __shfl_up(v, o); if (lane >= o) v += u; }
    gc[lane] = v;
    fac[lane] = bb[lane] * __expf(v);
  }
  __syncthreads();
  u16* const outp = p.prep + ((long)((b * 8 + h) * 2 + DIR) * NCH + c) * GD_ITEM;
  {
    f32x4 a1[4], a2[4];
#pragma unroll
    for (int n = 0; n < 4; ++n) { a1[n] = f32x4{0.f, 0.f, 0.f, 0.f}; a2[n] = f32x4{0.f, 0.f, 0.f, 0.f}; }
    mm_strip<128, 4>(R1, 136, 16 * wid, R1, 136, 0, a1, lane);
    mm_strip<128, 4>(R2, 136, 16 * wid, R1, 136, 0, a2, lane);
#pragma unroll
    for (int nt = 0; nt < 4; ++nt) {
      const int s = 16 * nt + fr, t0 = 16 * wid + 4 * fq;
      float lv[4];
#pragma unroll
      for (int j = 0; j < 4; ++j) {
        const int t = t0 + j;
        float dec = s <= t ? __expf(gc[t] - gc[s]) : 0.f;
        lv[j] = s < t ? bb[t] * a1[nt][j] * dec : 0.f;
        As[t * 72 + s] = f2bf(a2[nt][j] * dec);
      }
      uint2 o; o.x = pack2(lv[3], lv[2]); o.y = pack2(lv[1], lv[0]);
      *reinterpret_cast<uint2*>(Ls + (63 - s) * 72 + 60 - t0) = o;
    }
#pragma unroll
    for (int nt = 0; nt < 4; ++nt) {
      int t = 16 * nt + fr;
      float eg = __expf(gc[t]);
      float o[8];
#pragma unroll
      for (int s2 = 0; s2 < 2; ++s2)
#pragma unroll
        for (int j = 0; j < 4; ++j) o[s2 * 4 + j] = bf2f(R2[t * 136 + 16 * (2 * wid + s2) + 4 * fq + j]) * eg;
      st8(outp + (((8 + nt) * 4 + wid) * 64 + lane) * 8, o);
    }
  }
  {
    bf16x8 bw[2][2], bu[2][2];
#pragma unroll
    for (int ks = 0; ks < 2; ++ks) {
      float f8[8];
#pragma unroll
      for (int j = 0; j < 8; ++j) f8[j] = fac[63 - (32 * ks + 8 * fq + j)];
#pragma unroll
      for (int ct = 0; ct < 2; ++ct) {
        const int ch = 16 * (2 * wid + ct) + fr;
        union { bf16x8 v; unsigned w[4]; } cv;
#pragma unroll
        for (int j2 = 0; j2 < 4; ++j2) {
          const int s0 = 63 - (32 * ks + 8 * fq + 2 * j2);
          cv.w[j2] = pack2(bf2f(R1[s0 * 136 + ch]) * f8[2 * j2], bf2f(R1[(s0 - 1) * 136 + ch]) * f8[2 * j2 + 1]);
        }
        bw[ct][ks] = cv.v;
        bu[ct][ks] = *reinterpret_cast<const bf16x8*>(Ut + ch * 72 + 32 * ks + 8 * fq);
      }
    }
    unsigned kreg[16];
    {
      const float eg = __expf(gc[63] - gc[i]);
#pragma unroll
      for (int e = 0; e < 16; ++e)
        kreg[e] = pack2(bf2f(R1[i * 136 + 32 * sub + 2 * e]) * eg, bf2f(R1[i * 136 + 32 * sub + 2 * e + 1]) * eg);
    }
    __syncthreads();
    if (wid == (half_id() ? 2 : 0)) {
      float xr[64];
      fwd_solve64<true>(xr, Ls, Ls + lane * 72, lane);
    }
    __syncthreads();
    {
      bf16x8 ta[4][2];
#pragma unroll
      for (int tt = 0; tt < 4; ++tt)
#pragma unroll
        for (int ks = 0; ks < 2; ++ks) ta[tt][ks] = *reinterpret_cast<const bf16x8*>(Ls + (16 * tt + fr) * 72 + 32 * ks + 8 * fq);
#pragma unroll
      for (int ct = 0; ct < 2; ++ct) {
        const int ch = 16 * (2 * wid + ct) + fr;
#pragma unroll
        for (int tt = 0; tt < 4; ++tt) {
          f32x4 aw = f32x4{0.f, 0.f, 0.f, 0.f}, au = aw;
          aw = MFMA16(ta[tt][0], bw[ct][0], aw); aw = MFMA16(ta[tt][1], bw[ct][1], aw);
          au = MFMA16(ta[tt][0], bu[ct][0], au); au = MFMA16(ta[tt][1], bu[ct][1], au);
          uint2 ow, ou;
          ow.x = pack2(aw[3], aw[2]); ow.y = pack2(aw[1], aw[0]);
          ou.x = pack2(au[3], au[2]); ou.y = pack2(au[1], au[0]);
          *reinterpret_cast<uint2*>(R2 + ch * 72 + 60 - 16 * tt - 4 * fq) = ow;
          *reinterpret_cast<uint2*>(Ut + ch * 72 + 60 - 16 * tt - 4 * fq) = ou;
        }
      }
    }
#pragma unroll
    for (int e = 0; e < 16; ++e) {
      R1[(32 * sub + 2 * e) * 72 + i] = (u16)(kreg[e] & 0xffffu);
      R1[(32 * sub + 2 * e + 1) * 72 + i] = (u16)(kreg[e] >> 16);
    }
  }
  __syncthreads();
  { const int tidn = opaque_tid(); GDN_ISSUEQ((it + it_stride < it_end ? it + it_stride : it), tidn); }
  {
    const float glast = __expf(gc[63]);
    {
      f32x4 m0[8], m1[8];
#pragma unroll
      for (int n = 0; n < 8; ++n) { m0[n] = f32x4{0.f, 0.f, 0.f, 0.f}; m1[n] = f32x4{0.f, 0.f, 0.f, 0.f}; }
      mm_strip<64, 8>(R2, 72, 16 * (2 * wid), R1, 72, 0, m0, lane);
      mm_strip<64, 8>(R2, 72, 16 * (2 * wid + 1), R1, 72, 0, m1, lane);
#pragma unroll
      for (int nt = 0; nt < 8; ++nt) {
        float o[8];
#pragma unroll
        for (int j = 0; j < 4; ++j) {
          int k0 = 16 * (2 * wid) + 4 * fq + j, k1 = k0 + 16, kp = 16 * nt + fr;
          o[j] = m0[nt][j] + (k0 == kp ? glast : 0.f);
          o[4 + j] = m1[nt][j] + (k1 == kp ? glast : 0.f);
        }
        st8(outp + ((nt * 4 + wid) * 64 + lane) * 8, o);
      }
    }
    {
      f32x4 q0[4], q1[4];
#pragma unroll
      for (int n = 0; n < 4; ++n) { q0[n] = f32x4{0.f, 0.f, 0.f, 0.f}; q1[n] = f32x4{0.f, 0.f, 0.f, 0.f}; }
      mm_strip<64, 4>(R2, 72, 16 * (2 * wid), As, 72, 0, q0, lane);
      mm_strip<64, 4>(R2, 72, 16 * (2 * wid + 1), As, 72, 0, q1, lane);
#pragma unroll
      for (int nt = 0; nt < 4; ++nt) {
        float o[8];
        ld8(outp + (((8 + nt) * 4 + wid) * 64 + lane) * 8, o);
#pragma unroll
        for (int j = 0; j < 4; ++j) { o[j] += q0[nt][j]; o[4 + j] += q1[nt][j]; }
        st8(outp + (((8 + nt) * 4 + wid) * 64 + lane) * 8, o);
      }
    }
    u16* cp = outp + 24576;
#pragma unroll
    for (int s2 = 0; s2 < 2; ++s2) {
      f32x4 an[8];
#pragma unroll
      for (int n = 0; n < 8; ++n) an[n] = f32x4{0.f, 0.f, 0.f, 0.f};
      mm_strip<64, 8>(R1, 72, 16 * (2 * wid + s2), Ut, 72, 0, an, lane);
#pragma unroll
      for (int nt = 0; nt < 8; ++nt) {
        uint2 o; o.x = pack2(-an[nt][0], -an[nt][1]); o.y = pack2(-an[nt][2], -an[nt][3]);
        *reinterpret_cast<uint2*>(cp + (((2 * wid + s2) * 8 + nt) * 64 + lane) * 4) = o;
      }
    }
    {
      f32x4 ao[8];
#pragma unroll
      for (int n = 0; n < 8; ++n) ao[n] = f32x4{0.f, 0.f, 0.f, 0.f};
      mm_strip<64, 8>(As, 72, 16 * wid, Ut, 72, 0, ao, lane);
#pragma unroll
      for (int nt = 0; nt < 8; ++nt) {
        uint2 o; o.x = pack2(-ao[nt][0], -ao[nt][1]); o.y = pack2(-ao[nt][2], -ao[nt][3]);
        *reinterpret_cast<uint2*>(cp + (((8 + wid) * 8 + nt) * 64 + lane) * 4) = o;
      }
    }
  }
  __syncthreads();
  }
#undef GDN_ISSUEQ
}

__device__ __forceinline__ void gdn_scan_block(const Params& p, int sid2) {
  const int tid = opaque_tid(), lane = tid & 63, fr = lane & 15, fq = lane >> 4;
  const int wid = __builtin_amdgcn_readfirstlane(tid >> 6);
  const int vhalf = sid2 & 1, sid = sid2 >> 1;
  const int d = sid & 1, bh = sid >> 1, b = bh / 8, h = bh % 8;
  const int wv = vhalf * 4 + wid;
  const char* base = (const char*)(p.prep + (long)sid * NCH * GD_ITEM);
  u16* obuf = d ? p.yb : p.yf;
  char* L = (char*)smem;
  const unsigned lo16 = lane * 16u, lo8 = lane * 8u;
  f32x4 st[8];
#pragma unroll
  for (int i = 0; i < 8; ++i) st[i] = f32x4{0.f, 0.f, 0.f, 0.f};
  auto chunk_of = [&](int step) { step = min(step, NCH - 1); return d == 0 ? step : (step < 4 ? 3 - step : 263 - step); };
  bf16x8 Ar[4][6];
  uint2 Cr[4][6];
#pragma unroll
  for (int u = 0; u < 3; ++u) {
    const char* it = base + (long)chunk_of(u >> 1) * (GD_ITEM * 2);
    const int half = u & 1;
    const char* pa = it + (half * 24 + wid * 6) * 1024;
    const char* pc = it + 49152 + ((half * 6) * 8 + wv) * 512;
#pragma unroll
    for (int e = 0; e < 6; ++e) Ar[u][e] = *reinterpret_cast<const bf16x8*>(pa + e * 1024 + lo16);
#pragma unroll
    for (int r = 0; r < 6; ++r) Cr[u][r] = *reinterpret_cast<const uint2*>(pc + r * 4096 + lo8);
  }
  __syncthreads();
  bf16x8 bfr[4];
#pragma unroll 1
  for (int P0 = 0; P0 < 2 * NCH; P0 += 8) {
#pragma unroll
    for (int u = 0; u < 8; ++u) {
      const int step = (P0 >> 1) + (u >> 1);
      const int half = u & 1;
      {
        const int Pn = P0 + u + 3;
        const char* it = base + (long)chunk_of(Pn >> 1) * (GD_ITEM * 2);
        const int hn = (u + 1) & 1;
        const char* pa = it + (hn * 24 + wid * 6) * 1024;
        const char* pc = it + 49152 + ((hn * 6) * 8 + wv) * 512;
#pragma unroll
        for (int e = 0; e < 6; ++e) Ar[(u + 3) % 4][e] = *reinterpret_cast<const bf16x8*>(pa + e * 1024 + lo16);
#pragma unroll
        for (int r = 0; r < 6; ++r) Cr[(u + 3) % 4][r] = *reinterpret_cast<const uint2*>(pc + r * 4096 + lo8);
      }
      char* Lb = L + half * 24576;
#pragma unroll
      for (int e = 0; e < 6; ++e) *reinterpret_cast<bf16x8*>(Lb + (wid * 6 + e) * 1024 + lo16) = Ar[u % 4][e];
      asm volatile("s_waitcnt lgkmcnt(0)" ::: "memory");
      __builtin_amdgcn_s_barrier();
      asm volatile("" ::: "memory");
      if (half == 0) {
#pragma unroll
        for (int ks = 0; ks < 4; ++ks) {
          union { bf16x8 v; unsigned w[4]; } cv;
          cv.w[0] = pack2(st[2 * ks][0], st[2 * ks][1]); cv.w[1] = pack2(st[2 * ks][2], st[2 * ks][3]);
          cv.w[2] = pack2(st[2 * ks + 1][0], st[2 * ks + 1][1]); cv.w[3] = pack2(st[2 * ks + 1][2], st[2 * ks + 1][3]);
          bfr[ks] = cv.v;
        }
      }
      const int c = chunk_of(step);
      u16* orow = obuf + ((long)b * PB + c * 64) * D + h * 128 + wv * 16 + fr;
#pragma unroll
      for (int r = 0; r < 6; ++r) {
        const int rt = half * 6 + r;
        f32x4 acc;
        acc[0] = __uint_as_float(Cr[u % 4][r].x << 16); acc[1] = __uint_as_float(Cr[u % 4][r].x & 0xffff0000u);
        acc[2] = __uint_as_float(Cr[u % 4][r].y << 16); acc[3] = __uint_as_float(Cr[u % 4][r].y & 0xffff0000u);
#pragma unroll
        for (int ks = 0; ks < 4; ++ks) {
          bf16x8 a = *reinterpret_cast<const bf16x8*>(Lb + (r * 4 + ks) * 1024 + lo16);
          acc = MFMA16(a, bfr[ks], acc);
        }
        if (rt < 8) st[rt] = acc;
        else {
#pragma unroll
          for (int j = 0; j < 4; ++j) {
            int t = 16 * (rt - 8) + 4 * fq + j;
            int tau = d ? 63 - t : t;
            orow[(long)tau * D] = f2bf(acc[j]);
          }
        }
        if (r & 1) __builtin_amdgcn_sched_barrier(0);
      }
    }
  }
  __syncthreads();
}

__device__ __forceinline__ void gdn_scan_loader(const Params& p, int sid2, int s_begin, int s_end) {
  const int tid = opaque_tid(), lane = tid & 63;
  const int wid = __builtin_amdgcn_readfirstlane(tid >> 6);
  const int vhalf = sid2 & 1, sid = sid2 >> 1, d = sid & 1, bh = sid >> 1, b = bh / 8, h = bh % 8;
  u16* obuf = d ? p.yb : p.yf;
  const int t = tid >> 2, seg = tid & 3;
  const int tau = d ? 63 - t : t;
  const char* base = (const char*)(p.prep + (long)sid * NCH * GD_ITEM);
  char* L = (char*)smem_raw;
  const unsigned lo16 = lane * 16u;
  auto chunk_of = [&](int step) { step = min(step, NCH - 1); return d == 0 ? step : (step < 4 ? 3 - step : 263 - step); };
  auto copy = [&](int step) {
    const u16* Yb = (const u16*)(smem_raw + 49152) + (step & 1) * 4608 + t * 72 + seg * 16;
    const uint4 v0 = *reinterpret_cast<const uint4*>(Yb), v1 = *reinterpret_cast<const uint4*>(Yb + 8);
    const int cc = d == 0 ? step : (step < 4 ? 3 - step : 263 - step);
    u16* dst = obuf + ((long)b * PB + cc * 64 + tau) * D + h * 128 + vhalf * 64 + seg * 16;
    *reinterpret_cast<uint4*>(dst) = v0; *reinterpret_cast<uint4*>(dst + 8) = v1;
  };
  const int PB0 = 2 * s_begin, PE = 2 * s_end;
  bf16x8 Ar[8][6];
#pragma unroll
  for (int u = 0; u < 8; ++u) {
    const char* pa = base + (long)chunk_of(s_begin + (u >> 1)) * (GD_ITEM * 2) + ((u & 1) * 24 + wid * 6) * 1024;
#pragma unroll
    for (int e = 0; e < 6; ++e) Ar[u][e] = *reinterpret_cast<const bf16x8*>(pa + e * 1024 + lo16);
  }
  __syncthreads();
#pragma unroll
  for (int e = 0; e < 6; ++e) *reinterpret_cast<bf16x8*>(L + (wid * 6 + e) * 1024 + lo16) = Ar[0][e];
  {
    const char* pa = base + (long)chunk_of(s_begin + 4) * (GD_ITEM * 2) + (0 * 24 + wid * 6) * 1024;
#pragma unroll
    for (int e = 0; e < 6; ++e) Ar[0][e] = *reinterpret_cast<const bf16x8*>(pa + e * 1024 + lo16);
  }
  asm volatile("s_waitcnt lgkmcnt(0)" ::: "memory");
  __builtin_amdgcn_s_barrier();
#pragma unroll 1
  for (int P0 = PB0; P0 < PE; P0 += 8) {
#pragma unroll
    for (int u = 0; u < 8; ++u) {
      const int Pw = P0 + u + 1;
      if (Pw < PE) {
        char* Lb = L + ((u + 1) & 1) * 24576;
#pragma unroll
        for (int e = 0; e < 6; ++e) *reinterpret_cast<bf16x8*>(Lb + (wid * 6 + e) * 1024 + lo16) = Ar[(u + 1) % 8][e];
      }
      {
        const int Pn = P0 + u + 9;
        const char* pa = base + (long)chunk_of(Pn >> 1) * (GD_ITEM * 2) + (((u + 1) & 1) * 24 + wid * 6) * 1024;
#pragma unroll
        for (int e = 0; e < 6; ++e) Ar[(u + 1) % 8][e] = *reinterpret_cast<const bf16x8*>(pa + e * 1024 + lo16);
      }
      if ((u & 1) == 0 && P0 + u >= PB0 + 2) copy(((P0 + u) >> 1) - 1);
      asm volatile("s_waitcnt lgkmcnt(0)" ::: "memory");
      __builtin_amdgcn_s_barrier();
      asm volatile("" ::: "memory");
    }
  }
  copy(s_end - 1);
  __syncthreads();
}

__device__ __forceinline__ void gdn_scan_compute(const Params& p, int sid2, int s_begin, int s_end) {
  const int tid = opaque_tid(), lane = tid & 63, fr = lane & 15, fq = lane >> 4;
  const int wid = __builtin_amdgcn_readfirstlane(tid >> 6);
  const int vhalf = sid2 & 1, sid = sid2 >> 1;
  const int d = sid & 1, bh = sid >> 1, b = bh / 8, h = bh % 8;
  const int wv = vhalf * 4 + wid;
  const char* base = (const char*)(p.prep + (long)sid * NCH * GD_ITEM);
  u16* obuf = d ? p.yb : p.yf;
  const char* L = (const char*)smem_raw;
  const unsigned lo16 = lane * 16u, lo8 = lane * 8u;
  const int PB0 = 2 * s_begin, PE = 2 * s_end;
  f32x4* stsave = (f32x4*)(smem_raw + 98304) + tid * 8;
  f32x4 st[8];
#pragma unroll
  for (int i = 0; i < 8; ++i) st[i] = s_begin > 0 ? stsave[i] : f32x4{0.f, 0.f, 0.f, 0.f};
  auto chunk_of = [&](int step) { step = min(step, NCH - 1); return d == 0 ? step : (step < 4 ? 3 - step : 263 - step); };
  uint2 Cr[4][6];
#pragma unroll
  for (int u = 0; u < 3; ++u) {
    const char* pc = base + (long)chunk_of(s_begin + (u >> 1)) * (GD_ITEM * 2) + 49152 + (((u & 1) * 6) * 8 + wv) * 512;
#pragma unroll
    for (int r = 0; r < 6; ++r) Cr[u][r] = *reinterpret_cast<const uint2*>(pc + r * 4096 + lo8);
  }
  __syncthreads();
  __builtin_amdgcn_s_barrier();
  asm volatile("" ::: "memory");
  bf16x8 bfr[4];
#pragma unroll 1
  for (int P0 = PB0; P0 < PE; P0 += 8) {
#pragma unroll
    for (int u = 0; u < 8; ++u) {
      const int step = (P0 >> 1) + (u >> 1);
      const int half = u & 1;
      {
        const int Pn = P0 + u + 3;
        const char* pc = base + (long)chunk_of(Pn >> 1) * (GD_ITEM * 2) + 49152 + ((((u + 1) & 1) * 6) * 8 + wv) * 512;
#pragma unroll
        for (int r = 0; r < 6; ++r) Cr[(u + 3) % 4][r] = *reinterpret_cast<const uint2*>(pc + r * 4096 + lo8);
      }
      const char* Lb = L + half * 24576;
      if (half == 0) {
#pragma unroll
        for (int ks = 0; ks < 4; ++ks) {
          union { bf16x8 v; unsigned w[4]; } cv;
          cv.w[0] = pack2(st[2 * ks][0], st[2 * ks][1]); cv.w[1] = pack2(st[2 * ks][2], st[2 * ks][3]);
          cv.w[2] = pack2(st[2 * ks + 1][0], st[2 * ks + 1][1]); cv.w[3] = pack2(st[2 * ks + 1][2], st[2 * ks + 1][3]);
          bfr[ks] = cv.v;
        }
      }
      const int c = chunk_of(step);
      u16* Yb = (u16*)(smem_raw + 49152) + (step & 1) * 4608;
      (void)c;
      bf16x8 fa[8], fb[8];
#pragma unroll
      for (int q = 0; q < 8; ++q) fa[q] = *reinterpret_cast<const bf16x8*>(Lb + q * 1024 + lo16);
#pragma unroll
      for (int k = 0; k < 3; ++k) {
        if (k == 0) {
#pragma unroll
          for (int q = 0; q < 8; ++q) fb[q] = *reinterpret_cast<const bf16x8*>(Lb + (8 + q) * 1024 + lo16);
        } else if (k == 1) {
#pragma unroll
          for (int q = 0; q < 8; ++q) fa[q] = *reinterpret_cast<const bf16x8*>(Lb + (16 + q) * 1024 + lo16);
        }
#pragma unroll
        for (int rr = 0; rr < 2; ++rr) {
          const int r = 2 * k + rr, rt = half * 6 + r;
          f32x4 acc;
          acc[0] = __uint_as_float(Cr[u % 4][r].x << 16); acc[1] = __uint_as_float(Cr[u % 4][r].x & 0xffff0000u);
          acc[2] = __uint_as_float(Cr[u % 4][r].y << 16); acc[3] = __uint_as_float(Cr[u % 4][r].y & 0xffff0000u);
#pragma unroll
          for (int ks = 0; ks < 4; ++ks) acc = MFMA16((k == 1 ? fb : fa)[rr * 4 + ks], bfr[ks], acc);
          if (rt < 8) st[rt] = acc;
          else {
#pragma unroll
            for (int j = 0; j < 4; ++j) {
              int t = 16 * (rt - 8) + 4 * fq + j;
              Yb[t * 72 + wid * 16 + fr] = f2bf(acc[j]);
            }
          }
        }
        __builtin_amdgcn_sched_barrier(0);
      }
      asm volatile("s_waitcnt lgkmcnt(0)" ::: "memory");
      __builtin_amdgcn_s_barrier();
      asm volatile("" ::: "memory");
    }
  }
  if (s_end < NCH) {
#pragma unroll
    for (int i = 0; i < 8; ++i) stsave[i] = st[i];
  }
  __syncthreads();
}

__device__ __forceinline__ void phase_gdn_out(const Params& p) {
  const int tid_ = opaque_tid(); const int lane = tid_ & 63, wid = tid_ >> 6;
  for (int row = VBID * 4 + wid; row < T; row += NVB * 4) {
#pragma unroll
    for (int i = 0; i < 4; ++i) {
      int col = (i * 64 + lane) * 4;
      uint2 a = *reinterpret_cast<const uint2*>(p.yf + (long)row * D + col);
      uint2 bq = *reinterpret_cast<const uint2*>(p.yb + (long)row * D + col);
      uint2 gz = *reinterpret_cast<const uint2*>(p.zbuf + (long)row * GDN_IN + 3072 + col);
      float o[4], gt[4];
      o[0] = __uint_as_float(a.x << 16) + __uint_as_float(bq.x << 16);
      o[1] = __uint_as_float(a.x & 0xffff0000u) + __uint_as_float(bq.x & 0xffff0000u);
      o[2] = __uint_as_float(a.y << 16) + __uint_as_float(bq.y << 16);
      o[3] = __uint_as_float(a.y & 0xffff0000u) + __uint_as_float(bq.y & 0xffff0000u);
      gt[0] = __uint_as_float(gz.x << 16); gt[1] = __uint_as_float(gz.x & 0xffff0000u);
      gt[2] = __uint_as_float(gz.y << 16); gt[3] = __uint_as_float(gz.y & 0xffff0000u);
      float ss = o[0] * o[0] + o[1] * o[1] + o[2] * o[2] + o[3] * o[3];
#pragma unroll
      for (int of = 16; of > 0; of >>= 1) ss += __shfl_xor(ss, of);
      float rstd = rsqrtf(ss * (1.f / 128.f) + 1e-6f);
      float r[4];
#pragma unroll
      for (int e = 0; e < 4; ++e) r[e] = o[e] * rstd * p.gdn_norm_g[(col & 127) + e] * siluf_(gt[e]);
      uint2 w; w.x = pack2(r[0], r[1]); w.y = pack2(r[2], r[3]);
      *reinterpret_cast<uint2*>(p.abuf + (long)row * D + col) = w;
    }
  }
}

__device__ __forceinline__ void phase_post_mixer(const Params& p, int layer, bool dry = false) {
  constexpr int FS = 1026;
  u16* const xdst = dry ? p.yf : p.xs;
  float* frow = (float*)smem;
  float* part = frow + 16 * FS;
  int* hist = (int*)(part + 4 * 16 * 32);
  const int tid = opaque_tid(), lane = tid & 63, fr = lane & 15, fq = lane >> 4;
  const int wid = __builtin_amdgcn_readfirstlane(tid >> 6);
  if (tid < 32) hist[tid] = 0;
  __syncthreads();
  const float* rw = p.router_w + (long)layer * 1024 * 32;
  const float* g1 = p.norm_g + (long)(layer * 4 + 1) * 1024;
  const float* g2 = p.norm_g + (long)(layer * 4 + 2) * 1024;
  float wreg0[64], wreg1[64];
  {
    const float* wb = rw + (long)(wid * 256 + fq) * 32 + fr;
#pragma unroll
    for (int s_ = 0; s_ < 64; ++s_) { wreg0[s_] = wb[(long)(4 * s_) * 32]; wreg1[s_] = wb[(long)(4 * s_) * 32 + 16]; }
  }
  for (int trip = 0; trip < (layer == 0 ? 5 : 4); ++trip) {
    int row0, nvalid = 16;
    if (layer == 0) {
      if (trip < 4) row0 = (VBID + trip * NVB) * 16; else { row0 = 4 * NVB * 16 + VBID; nvalid = 1; }
    } else {
      const int g = VBID + trip * NVB;
      row0 = (g >> 10) * PB + CTXL + (g & 1023) * 16;
    }
    const int b = row0 / PB, pp0 = row0 % PB;
    const bool isctx = pp0 < CTXL;
    const int mrow = isctx ? 2 : b;
    const float* gate = modp(p, layer, mrow, 2);
    const float* sh = modp(p, layer, mrow, 3);
    const float* sc = modp(p, layer, mrow, 4);
#pragma unroll 1
    for (int rr = 0; rr < 4; ++rr) {
      const int lr = wid * 4 + rr, row = row0 + lr, pp = pp0 + lr;
      if (lr >= nvalid) continue;
      float ss = 0.f;
      float4 tv[4];
#pragma unroll
      for (int i = 0; i < 4; ++i) {
        tv[i] = ld4bf(p.tmp + (long)row * D + (i * 64 + lane) * 4);
        ss += tv[i].x * tv[i].x + tv[i].y * tv[i].y + tv[i].z * tv[i].z + tv[i].w * tv[i].w;
      }
      float4 lv[4];
#pragma unroll
      for (int i = 0; i < 4; ++i) {
        const int col = (i * 64 + lane) * 4;
        if (layer == 0) {
          const float* src0 = isctx ? p.ctx + ((long)b * CTXL + pp) * D : p.x + ((long)b * SEQ + (pp - CTXL)) * D;
          lv[i] = *reinterpret_cast<const float4*>(src0 + col);
        } else lv[i] = ld4bf(p.xs + (long)row * D + col);
      }
      ss = wave_sum(ss);
      const float rstd = rsqrtf(ss * (1.f / 1024.f) + 1e-6f);
      float ss2 = 0.f;
#pragma unroll
      for (int i = 0; i < 4; ++i) {
        const int col = (i * 64 + lane) * 4;
        const float4 gg = *reinterpret_cast<const float4*>(g1 + col);
        const float4 gt = *reinterpret_cast<const float4*>(gate + col);
        lv[i].x += gt.x * (tv[i].x * rstd * gg.x); lv[i].y += gt.y * (tv[i].y * rstd * gg.y);
        lv[i].z += gt.z * (tv[i].z * rstd * gg.z); lv[i].w += gt.w * (tv[i].w * rstd * gg.w);
        st4bf(xdst + (long)row * D + col, lv[i]);
        ss2 += lv[i].x * lv[i].x + lv[i].y * lv[i].y + lv[i].z * lv[i].z + lv[i].w * lv[i].w;
      }
      ss2 = wave_sum(ss2);
      const float rstd2 = rsqrtf(ss2 * (1.f / 1024.f) + 1e-6f);
#pragma unroll
      for (int i = 0; i < 4; ++i) {
        const int col = (i * 64 + lane) * 4;
        const float4 g2v = *reinterpret_cast<const float4*>(g2 + col);
        const float4 s4 = *reinterpret_cast<const float4*>(sh + col);
        const float4 c4 = *reinterpret_cast<const float4*>(sc + col);
        float4 f;
        f.x = lv[i].x * rstd2 * g2v.x * (1.f + c4.x) + s4.x; f.y = lv[i].y * rstd2 * g2v.y * (1.f + c4.y) + s4.y;
        f.z = lv[i].z * rstd2 * g2v.z * (1.f + c4.z) + s4.z; f.w = lv[i].w * rstd2 * g2v.w * (1.f + c4.w) + s4.w;
        st4bf(p.abuf + (long)row * D + col, f);
        float* fd = frow + lr * FS + col;
        fd[0] = f.x; fd[1] = f.y; fd[2] = f.z; fd[3] = f.w;
      }
    }
    __syncthreads();
    {
      f32x4 acc0 = f32x4{0.f, 0.f, 0.f, 0.f}, acc1 = acc0;
      const float* fa = frow + fr * FS + wid * 256 + fq;
#pragma unroll
      for (int s = 0; s < 64; ++s) {
        const float a = fa[4 * s];
        acc0 = __builtin_amdgcn_mfma_f32_16x16x4f32(a, wreg0[s], acc0, 0, 0, 0);
        acc1 = __builtin_amdgcn_mfma_f32_16x16x4f32(a, wreg1[s], acc1, 0, 0, 0);
      }
#pragma unroll
      for (int j = 0; j < 4; ++j) {
        part[(wid * 16 + 4 * fq + j) * 32 + fr] = acc0[j];
        part[(wid * 16 + 4 * fq + j) * 32 + 16 + fr] = acc1[j];
      }
    }
    __syncthreads();
#pragma unroll 1
    for (int rr = 0; rr < 4; ++rr) {
      const int lr = wid * 4 + rr, row = row0 + lr;
      if (lr >= nvalid) continue;
      float logit = -3.0e38f;
      if (lane < 32)
        logit = part[(0 * 16 + lr) * 32 + lane] + part[(1 * 16 + lr) * 32 + lane] + part[(2 * 16 + lr) * 32 + lane] +
                part[(3 * 16 + lr) * 32 + lane] + p.router_b[layer * 32 + lane];
      float tv4[4]; int ti4[4];
#pragma unroll
      for (int k = 0; k < 4; ++k) {
        float bv = logit; int bi = lane;
#pragma unroll
        for (int of = 32; of > 0; of >>= 1) {
          float ov = __shfl_xor(bv, of); int oi = __shfl_xor(bi, of);
          if (ov > bv || (ov == bv && oi < bi)) { bv = ov; bi = oi; }
        }
        tv4[k] = bv; ti4[k] = bi;
        if (lane == bi) logit = -3.0e38f;
      }
      if (lane == 0) {
        float m = tv4[0];
        float e0 = 1.f, e1 = __expf(tv4[1] - m), e2 = __expf(tv4[2] - m), e3 = __expf(tv4[3] - m);
        float inv = 1.f / (e0 + e1 + e2 + e3);
        *reinterpret_cast<int4*>(p.tok_e + (long)row * 4) = make_int4(ti4[0], ti4[1], ti4[2], ti4[3]);
        *reinterpret_cast<float4*>(p.tok_gw + (long)row * 4) = make_float4(e0 * inv, e1 * inv, e2 * inv, e3 * inv);
        if (!dry) { atomicAdd(hist + ti4[0], 1); atomicAdd(hist + ti4[1], 1); atomicAdd(hist + ti4[2], 1); atomicAdd(hist + ti4[3], 1); }
      }
    }
    __syncthreads();
  }
  __syncthreads();
  if (!dry && tid < 32 && hist[tid]) atomicAdd(p.cnt + CNTI(layer, 0, tid), hist[tid]);
}

__device__ __forceinline__ void phase_moe_scatter(const Params& p, int layer) {
  int* base = (int*)smem;
  int* lcnt = base + 32;
  int* lbase = base + 64;
  const int tid = opaque_tid();
  if (tid == 0) {
    int run = 0;
    for (int e = 0; e < NE; ++e) { base[e] = run; run += p.cnt[CNTI(layer, 0, e)]; }
  }
  if (tid < 32) lcnt[tid] = 0;
  __syncthreads();
  int e_[4], r_[4]; long id_[4];
#pragma unroll
  for (int k = 0; k < 4; ++k) {
    const long idx = (long)VBID * NTH + tid + (long)k * NVB * NTH;
    id_[k] = -1; e_[k] = 0; r_[k] = 0;
    if (idx < (long)T * 4) {
      const int tok = (int)(idx >> 2);
      if (!(layer == 1 && (tok % PB) < CTXL)) {
        id_[k] = idx;
        e_[k] = p.tok_e[idx];
        r_[k] = atomicAdd(lcnt + e_[k], 1);
      }
    }
  }
  __syncthreads();
  if (tid < 32) lbase[tid] = lcnt[tid] ? atomicAdd(p.cnt + CNTI(layer, 1, tid), lcnt[tid]) : 0;
  __syncthreads();
#pragma unroll
  for (int k = 0; k < 4; ++k) {
    if (id_[k] >= 0) {
      const int slot = base[e_[k]] + lbase[e_[k]] + r_[k];
      p.slot_tok[slot] = (int)(id_[k] >> 2);
      p.slot_gw[slot] = p.tok_gw[id_[k]];
      p.tok_slot[id_[k]] = slot;
    }
  }
  __syncthreads();
}

struct MoeTab { int tstart[33]; int base[33]; };

__device__ __forceinline__ void moe_build_tab(const Params& p, int layer, MoeTab* tab) {
  __syncthreads();
  if ((threadIdx.x & 255) == 0) {
    int run = 0, trun = 0;
    for (int e = 0; e < NE; ++e) {
      int cnt = p.cnt[CNTI(layer, 0, e)];
      tab->base[e] = run; tab->tstart[e] = trun;
      run += cnt; trun += (cnt + 127) >> 7;
    }
    tab->base[32] = run; tab->tstart[32] = trun;
  }
  __syncthreads();
}

__device__ __forceinline__ void phase_moe_gemm1(const Params& p, int layer) {
  MoeTab* tab = (MoeTab*)(smem + 73728);
  moe_build_tab(p, layer, tab);
  const int ntiles = tab->tstart[32];
  const int tid = opaque_tid(), wid = tid >> 6, lane = tid & 63, wr = wid >> 1, wc = wid & 1, fr = lane & 15, fq = lane >> 4;
  for (int item = VBID; item < ntiles * 8; item += NVB) {
    const int ti = item >> 3, nt = item & 7;
    int e = 0;
    for (int q = 1; q < NE; ++q) if (ti >= tab->tstart[q]) e = q;
    const int mt = ti - tab->tstart[e];
    const int cnt = tab->base[e + 1] - tab->base[e];
    const int valid = min(128, cnt - mt * 128);
    const int slot0 = tab->base[e] + mt * 128;
    const u16* Bt = p.MoeInT + (long)(layer * 32 + e) * 2048 * 1024;
    f32x4 acc[4][8];
    gemm_tile(p.abuf, D, Bt, D, D,
              [&](int r) { return p.slot_tok[slot0 + min(r, valid - 1)]; },
              [&](int r) { int wcc = r >> 7, n = (r >> 4) & 7, f = r & 15;
                           return (n < 4 ? 0 : 1024) + nt * 128 + wcc * 64 + (n & 3) * 16 + f; },
              acc);
    const float* bi = p.moe_b_in + (long)(layer * 32 + e) * 2048;
#pragma unroll
    for (int m = 0; m < 4; ++m) {
      const int r = wr * 64 + m * 16 + fr;
#pragma unroll
      for (int n = 0; n < 4; ++n) {
        const int ca = nt * 128 + wc * 64 + n * 16 + fq * 4;
        const float4 bg = *reinterpret_cast<const float4*>(bi + ca);
        const float4 bl = *reinterpret_cast<const float4*>(bi + 1024 + ca);
        const float bgv[4] = {bg.x, bg.y, bg.z, bg.w}, blv[4] = {bl.x, bl.y, bl.z, bl.w};
        float v[4];
#pragma unroll
        for (int j = 0; j < 4; ++j) {
          float glu = fminf(acc[m][n][j] + bgv[j], 7.0f);
          float lin = fminf(fmaxf(acc[m][n + 4][j] + blv[j], -7.0f), 7.0f);
          v[j] = glu * sigmoidf_(1.702f * glu) * (lin + 1.0f);
        }
        if (r < valid) {
          uint2 o; o.x = pack2(v[0], v[1]); o.y = pack2(v[2], v[3]);
          *reinterpret_cast<uint2*>(p.act + (long)(slot0 + r) * D + ca) = o;
        }
      }
    }
  }
}

__device__ __forceinline__ void phase_moe_gemm2(const Params& p, int layer) {
  MoeTab* tab = (MoeTab*)(smem + 73728);
  moe_build_tab(p, layer, tab);
  const int ntiles = tab->tstart[32];
  const int tid = opaque_tid(), wid = tid >> 6, lane = tid & 63, wr = wid >> 1, wc = wid & 1, fr = lane & 15, fq = lane >> 4;
  for (int item = VBID; item < ntiles * 4; item += NVB) {
    const int ti = item >> 2, nt = item & 3;
    int e = 0;
    for (int q = 1; q < NE; ++q) if (ti >= tab->tstart[q]) e = q;
    const int mt = ti - tab->tstart[e];
    const int cnt = tab->base[e + 1] - tab->base[e];
    const int valid = min(128, cnt - mt * 128);
    const int slot0 = tab->base[e] + mt * 128;
    const u16* Bt = p.MoeOutT + (long)(layer * 32 + e) * 1024 * 1024;
    f32x4 acc[4][8];
    gemm_tile(p.act, D, Bt, D, D,
              [&](int r) { return slot0 + min(r, valid - 1); },
              [&](int r) { return nt * 256 + r; },
              acc);
    const float* bo = p.moe_b_out + (long)(layer * 32 + e) * 1024;
#pragma unroll
    for (int m = 0; m < 4; ++m) {
      const int r = wr * 64 + m * 16 + fr;
      const float gw = r < valid ? p.slot_gw[slot0 + r] : 0.f;
#pragma unroll
      for (int n = 0; n < 8; ++n) {
        const int cc = nt * 256 + wc * 128 + n * 16 + fq * 4;
        const float4 bv = *reinterpret_cast<const float4*>(bo + cc);
        if (r < valid) {
          uint2 o;
          o.x = pack2((acc[m][n][0] + bv.x) * gw, (acc[m][n][1] + bv.y) * gw);
          o.y = pack2((acc[m][n][2] + bv.z) * gw, (acc[m][n][3] + bv.w) * gw);
          *reinterpret_cast<uint2*>(p.oslot + (long)(slot0 + r) * D + cc) = o;
        }
      }
    }
  }
}

__device__ __forceinline__ void phase_moe_combine(const Params& p, int layer, bool dry = false) {
  u16* const xdst = dry ? p.yf : p.xs;
  const int tid_ = opaque_tid(); const int lane = tid_ & 63, wid = tid_ >> 6;
  const float* g3 = p.norm_g + (long)(layer * 4 + 3) * 1024;
  const float* g0n = p.norm_g + (long)((layer + 1) * 4 + 0) * 1024;
  for (int row0 = VBID * 4 + wid; row0 < T; row0 += NVB * 8) {
    int rows[2]; bool act[2]; int bb[2], ppp[2], mrow[2];
#pragma unroll
    for (int q = 0; q < 2; ++q) {
      rows[q] = row0 + q * NVB * 4;
      act[q] = rows[q] < T;
      const int rr = act[q] ? rows[q] : row0;
      bb[q] = rr / PB; ppp[q] = rr % PB;
      if (layer == 1 && ppp[q] < CTXL) act[q] = false;
      mrow[q] = ppp[q] < CTXL ? 2 : bb[q];
      rows[q] = rr;
    }
    if (!act[0] && !act[1]) continue;
    int4 sl[2];
#pragma unroll
    for (int q = 0; q < 2; ++q) sl[q] = *reinterpret_cast<const int4*>(p.tok_slot + (long)rows[q] * 4);
    float y[2][16];
    float4 xv[2][4];
#pragma unroll
    for (int q = 0; q < 2; ++q) {
#pragma unroll
      for (int i = 0; i < 16; ++i) y[q][i] = 0.f;
      const int sls[4] = {sl[q].x, sl[q].y, sl[q].z, sl[q].w};
#pragma unroll
      for (int k = 0; k < 4; ++k) {
#pragma unroll
        for (int i = 0; i < 4; ++i) {
          uint2 a = *reinterpret_cast<const uint2*>(p.oslot + (long)sls[k] * D + (i * 64 + lane) * 4);
          y[q][i * 4 + 0] += __uint_as_float(a.x << 16); y[q][i * 4 + 1] += __uint_as_float(a.x & 0xffff0000u);
          y[q][i * 4 + 2] += __uint_as_float(a.y << 16); y[q][i * 4 + 3] += __uint_as_float(a.y & 0xffff0000u);
        }
      }
#pragma unroll
      for (int i = 0; i < 4; ++i) xv[q][i] = ld4bf(p.xs + (long)rows[q] * D + (i * 64 + lane) * 4);
    }
#pragma unroll
    for (int q = 0; q < 2; ++q) {
      if (!act[q]) continue;
      const int row = rows[q];
      float ss = 0.f;
#pragma unroll
      for (int i = 0; i < 16; ++i) ss += y[q][i] * y[q][i];
      ss = wave_sum(ss);
      const float rstd = rsqrtf(ss * (1.f / 1024.f) + 1e-6f);
      float lat[16];
      float ss2 = 0.f;
      const float* gate = modp(p, layer, mrow[q], 5);
#pragma unroll
      for (int i = 0; i < 4; ++i) {
        const int col = (i * 64 + lane) * 4;
        const float4 gg = *reinterpret_cast<const float4*>(g3 + col);
        const float4 gt = *reinterpret_cast<const float4*>(gate + col);
        lat[i * 4 + 0] = xv[q][i].x + gt.x * (y[q][i * 4 + 0] * rstd * gg.x);
        lat[i * 4 + 1] = xv[q][i].y + gt.y * (y[q][i * 4 + 1] * rstd * gg.y);
        lat[i * 4 + 2] = xv[q][i].z + gt.z * (y[q][i * 4 + 2] * rstd * gg.z);
        lat[i * 4 + 3] = xv[q][i].w + gt.w * (y[q][i * 4 + 3] * rstd * gg.w);
#pragma unroll
        for (int e = 0; e < 4; ++e) ss2 += lat[i * 4 + e] * lat[i * 4 + e];
        const float4 ov = make_float4(lat[i * 4 + 0], lat[i * 4 + 1], lat[i * 4 + 2], lat[i * 4 + 3]);
        if (layer == 0) st4bf(xdst + (long)row * D + col, ov);
        else *reinterpret_cast<float4*>(p.out + ((long)bb[q] * SEQ + (ppp[q] - CTXL)) * D + col) = ov;
      }
      if (layer == 0) {
        ss2 = wave_sum(ss2);
        const float rstd2 = rsqrtf(ss2 * (1.f / 1024.f) + 1e-6f);
        const float* sh = modp(p, 1, mrow[q], 0);
        const float* sc = modp(p, 1, mrow[q], 1);
#pragma unroll
        for (int i = 0; i < 4; ++i) {
          const int col = (i * 64 + lane) * 4;
          const float4 gg = *reinterpret_cast<const float4*>(g0n + col);
          const float4 s4 = *reinterpret_cast<const float4*>(sh + col);
          const float4 c4 = *reinterpret_cast<const float4*>(sc + col);
          const float h0 = lat[i * 4 + 0] * rstd2 * gg.x * (1.f + c4.x) + s4.x;
          const float h1 = lat[i * 4 + 1] * rstd2 * gg.y * (1.f + c4.y) + s4.y;
          const float h2 = lat[i * 4 + 2] * rstd2 * gg.z * (1.f + c4.z) + s4.z;
          const float h3 = lat[i * 4 + 3] * rstd2 * gg.w * (1.f + c4.w) + s4.w;
          uint2 o; o.x = pack2(h0, h1); o.y = pack2(h2, h3);
          *reinterpret_cast<uint2*>(p.abuf + (long)row * D + col) = o;
        }
      }
    }
  }
}
namespace g8 {
constexpr int BK = 64, HTB = 128 * BK * 2;
__device__ __forceinline__ int lds_byte(int r, int c) { const int st = (r >> 4) * 2 + (c >> 5), rr = r & 15, cc = c & 31, ob = rr * 64 + cc * 2; return st * 1024 + (ob ^ (((ob >> 9) & 1) << 5)); }
__device__ __forceinline__ int perm32(int rho) { const int n = rho >> 4, i = rho & 15; return 8 * (i >> 2) + 4 * n + (i & 3); }
__device__ __forceinline__ void stage_rc(int b, int& R, int& C) { const int st = b / 1024, sb = b % 1024, swz = sb ^ (((sb >> 9) & 1) << 5); R = (st >> 1) * 16 + swz / 64; C = (st & 1) * 32 + (swz % 64) / 2; }

__device__ __forceinline__ const char* uni(const char* p) { unsigned long long v = (unsigned long long)p; unsigned lo = __builtin_amdgcn_readfirstlane((unsigned)v), hi = __builtin_amdgcn_readfirstlane((unsigned)(v >> 32)); return (const char*)(((unsigned long long)hi << 32) | lo); }
struct Unit { const char* b0; int i0, i1, i2, i3; };

template <class Sched, class RowOf, class Epi>
__device__ __forceinline__ void gemm_phase(const u16* __restrict__ Aptr, int K, const Sched& S, const RowOf& rowof, const Epi& E) {
  LAS unsigned char* lds = (LAS unsigned char*)smem_raw;
  int tid_ = threadIdx.x; asm volatile("" : "+v"(tid_));
  const int tid = tid_, wid = __builtin_amdgcn_readfirstlane(tid >> 6), lane = tid & 63, wr = wid >> 2, wc = wid & 3, fr = lane & 15, fq = lane >> 4;
  const int nt = K / BK;
  unsigned voffB[2];
#pragma unroll
  for (int i = 0; i < 2; ++i) { int R_, C_; stage_rc(tid * 16 + i * 8192, R_, C_); const int Rb = (R_ & ~31) + perm32(R_ & 31); voffB[i] = (unsigned)(Rb * K + C_) * 2u; }
  const size_t kstep = (size_t)(BK * 2);
  const unsigned ldsw = (unsigned)wid * 1024u;
  const int aoff = lds_byte(wr * 64 + fr, fq * 8), boff = lds_byte(wc * 32 + fr, fq * 8);
#define G8_SA(b, h) (((b) * 2 + (h)) * HTB)
#define G8_SB(b, h) ((4 + (b) * 2 + (h)) * HTB)
#define G8_STAGE(bufoff, gbase, voff) do { _Pragma("unroll") for (int _i = 0; _i < 2; ++_i) \
    __builtin_amdgcn_global_load_lds((const unsigned*)(uni((const char*)(gbase)) + (voff)[_i]), (LAS unsigned*)(lds + (bufoff) + ldsw + _i * 8192), 16, 0, 0); } while (0)
#define G8_STAGEB(bufoff, gbase) do { _Pragma("unroll") for (int _i = 0; _i < 2; ++_i) \
    __builtin_amdgcn_global_load_lds((const unsigned*)(uni((const char*)(gbase)) + _i * bstep + voffB), (LAS unsigned*)(lds + (bufoff) + ldsw + _i * 8192), 16, 0, 0); } while (0)
#define G8_LDA(dst, b, h) do { _Pragma("unroll") for (int m = 0; m < 4; ++m) _Pragma("unroll") for (int k = 0; k < 2; ++k) dst[m][k] = *(const LAS bf16x8*)(lds + G8_SA(b, h) + aoff + m * 2048 + k * 1024); } while (0)
#define G8_LDB(dst, b, h) do { _Pragma("unroll") for (int n = 0; n < 2; ++n) _Pragma("unroll") for (int k = 0; k < 2; ++k) dst[n][k] = *(const LAS bf16x8*)(lds + G8_SB(b, h) + boff + n * 2048 + k * 1024); } while (0)
#define G8_MMA(ai, bj, At, Bt) do { __builtin_amdgcn_s_setprio(1); _Pragma("unroll") for (int m = 0; m < 4; ++m) _Pragma("unroll") for (int n = 0; n < 2; ++n) _Pragma("unroll") for (int k = 0; k < 2; ++k) \
    acc[ai][bj][m][n] = __builtin_amdgcn_mfma_f32_16x16x32_bf16(Bt[n][k], At[m][k], acc[ai][bj][m][n], 0, 0, 0); __builtin_amdgcn_s_setprio(0); } while (0)
#define G8_WAIT_V(n) asm volatile("s_waitcnt vmcnt(" #n ")" ::: "memory")
#define G8_WAIT_L(n) asm volatile("s_waitcnt lgkmcnt(" #n ")" ::: "memory")
#define G8_BAR __builtin_amdgcn_s_barrier()
#define G8_SCHED __builtin_amdgcn_sched_barrier(0)
  Unit cur, nxt, nn; int ui = 0;
  if (!S.next(0, cur)) return;
  f32x4 acc[2][2][4][2];
#pragma unroll
  for (int a = 0; a < 2; ++a)
#pragma unroll
    for (int b = 0; b < 2; ++b)
#pragma unroll
      for (int m = 0; m < 4; ++m)
#pragma unroll
        for (int n = 0; n < 2; ++n) acc[a][b][m][n] = f32x4{0.f, 0.f, 0.f, 0.f};
  bf16x8 At[4][2], B0[2][2], B1[2][2];
  const char* Ab = (const char*)Aptr;
  unsigned gc0[2], gc1[2], gn0[2], gn1[2];
  bool has_next = S.next(1, nxt);
#pragma unroll
  for (int i = 0; i < 2; ++i) {
    int R_, C_; stage_rc(tid * 16 + i * 8192, R_, C_);
    gc0[i] = (unsigned)(((long)rowof(cur, R_) * K + C_) * 2);
    gc1[i] = (unsigned)(((long)rowof(cur, 128 + R_) * K + C_) * 2);
    gn0[i] = gc0[i]; gn1[i] = gc1[i];
    if (has_next) {
      gn0[i] = (unsigned)(((long)rowof(nxt, R_) * K + C_) * 2);
      gn1[i] = (unsigned)(((long)rowof(nxt, 128 + R_) * K + C_) * 2);
    }
  }
  const long b1d = S.b1delta;
  const char* cB0 = cur.b0;
#define cB1 (cB0 + b1d)
#define nB1 (nB0 + b1d)
  __syncthreads();
  G8_STAGE(G8_SB(0, 0), cB0, voffB); G8_STAGE(G8_SA(0, 0), Ab, gc0); G8_STAGE(G8_SB(0, 1), cB1, voffB); G8_STAGE(G8_SA(0, 1), Ab, gc1);
  if (wr == 1) G8_BAR;
  G8_WAIT_V(4); G8_BAR;
  G8_STAGE(G8_SB(1, 0), cB0 + kstep, voffB); G8_STAGE(G8_SA(1, 0), Ab + kstep, gc0); G8_STAGE(G8_SB(1, 1), cB1 + kstep, voffB);
  G8_WAIT_V(6); G8_BAR;
  for (;;) {
    const char* nB0 = has_next ? nxt.b0 : cB0;
    for (int t = 0; t < nt; t += 2) {
      const bool last = (t == nt - 2);
      const bool first = (t == 0) && (ui > 0);
      const char* a1 = Ab + (size_t)(t + 1) * kstep;
      const char* a2 = last ? Ab : Ab + (size_t)(t + 2) * kstep;
      const char* b20 = last ? nB0 : cB0 + (size_t)(t + 2) * kstep; const char* b21 = last ? nB1 : cB1 + (size_t)(t + 2) * kstep;
      const char* a3 = a2 + kstep; const char* b30 = b20 + kstep; const char* b31 = b21 + kstep;
      G8_LDB(B0, 0, 0); G8_SCHED; G8_LDA(At, 0, 0); if (!first) G8_STAGE(G8_SA(1, 1), a1, gc1);
      G8_WAIT_L(8); G8_BAR; G8_WAIT_L(0); G8_MMA(0, 0, At, B0); G8_BAR; G8_SCHED;
      G8_LDB(B1, 0, 1); G8_STAGE(G8_SB(0, 0), b20, voffB);
      G8_BAR; G8_WAIT_L(0); G8_MMA(0, 1, At, B1); G8_BAR;
      G8_LDA(At, 0, 1); G8_STAGE(G8_SA(0, 0), a2, (last ? gn0 : gc0));
      G8_BAR; G8_WAIT_L(0); G8_MMA(1, 0, At, B0); G8_BAR; G8_SCHED;
      G8_STAGE(G8_SB(0, 1), b21, voffB);
      if (first) { if (Epi::NST == 16) G8_WAIT_V(22); else G8_WAIT_V(14); } else G8_WAIT_V(6);
      G8_BAR; G8_MMA(1, 1, At, B1); G8_BAR;
      G8_LDB(B0, 1, 0); G8_SCHED; G8_LDA(At, 1, 0); G8_STAGE(G8_SA(0, 1), a2, (last ? gn1 : gc1));
      G8_WAIT_L(8); G8_BAR; G8_WAIT_L(0); G8_MMA(0, 0, At, B0); G8_BAR; G8_SCHED;
      G8_LDB(B1, 1, 1); G8_STAGE(G8_SB(1, 0), b30, voffB);
      G8_BAR; G8_WAIT_L(0); G8_MMA(0, 1, At, B1); G8_BAR;
      G8_LDA(At, 1, 1); G8_STAGE(G8_SA(1, 0), a3, (last ? gn0 : gc0));
      G8_BAR; G8_WAIT_L(0); G8_MMA(1, 0, At, B0); G8_BAR; G8_SCHED;
      G8_STAGE(G8_SB(1, 1), b31, voffB);
      G8_WAIT_V(6); G8_BAR; G8_MMA(1, 1, At, B1); G8_BAR;
    }
    G8_SCHED;
    typename Epi::Pre epre;
    E.load(epre, cur, wr, wc, fr, fq);
    G8_SCHED;
    G8_STAGE(G8_SA(1, 1), Ab + kstep, gn1);
    bool has_nn = false;
    if (has_next) has_nn = S.next(ui + 2, nn);
    int rq[4] = {0, 0, 0, 0};
    if (RowOf::GATHER && has_nn) {
#pragma unroll
      for (int i = 0; i < 2; ++i) {
        int R_, C_; stage_rc(tid * 16 + i * 8192, R_, C_);
        const int* q0 = rowof.addr(nn, R_); const int* q1 = rowof.addr(nn, 128 + R_);
        asm volatile("global_load_dword %0, %1, off" : "=v"(rq[i]) : "v"(q0) : "memory");
        asm volatile("global_load_dword %0, %1, off" : "=v"(rq[2 + i]) : "v"(q1) : "memory");
      }
    }
    G8_SCHED;
    E(acc, cur, epre, wr, wc, fr, fq);
    G8_SCHED;
#ifdef G8_EPI2
    E(acc, cur, epre, wr, wc, fr, fq);
    G8_SCHED;
#endif
    if (!has_next) break;
#pragma unroll
    for (int a = 0; a < 2; ++a)
#pragma unroll
      for (int b = 0; b < 2; ++b)
#pragma unroll
        for (int m = 0; m < 4; ++m)
#pragma unroll
          for (int n = 0; n < 2; ++n) acc[a][b][m][n] = f32x4{0.f, 0.f, 0.f, 0.f};
    cur = nxt; cB0 = nB0; ++ui;
#pragma unroll
    for (int i = 0; i < 2; ++i) { gc0[i] = gn0[i]; gc1[i] = gn1[i]; }
    if (has_nn) {
      if (RowOf::GATHER) {
        if (Epi::NST == 16) asm volatile("s_waitcnt vmcnt(16)" : "+v"(rq[0]), "+v"(rq[1]), "+v"(rq[2]), "+v"(rq[3]) :: "memory");
        else asm volatile("s_waitcnt vmcnt(8)" : "+v"(rq[0]), "+v"(rq[1]), "+v"(rq[2]), "+v"(rq[3]) :: "memory");
      }
#pragma unroll
      for (int i = 0; i < 2; ++i) {
        int R_, C_; stage_rc(tid * 16 + i * 8192, R_, C_);
        const int r0 = RowOf::GATHER ? rq[i] : rowof(nn, R_), r1 = RowOf::GATHER ? rq[2 + i] : rowof(nn, 128 + R_);
        gn0[i] = (unsigned)(((long)r0 * K + C_) * 2);
        gn1[i] = (unsigned)(((long)r1 * K + C_) * 2);
      }
    }
    nxt = nn; has_next = has_nn;
  }
  G8_WAIT_V(0);
  if (wr == 0) G8_BAR;
  G8_BAR;
#undef cB1
#undef nB1
#undef G8_SA
#undef G8_SB
#undef G8_STAGE
#undef G8_STAGEB
#undef G8_LDA
#undef G8_LDB
#undef G8_MMA
#undef G8_WAIT_V
#undef G8_WAIT_L
#undef G8_BAR
#undef G8_SCHED
}
}
struct DenseSched {
  const u16* Bt; int ntn, nunits, G, c, K, lat_only;
  long b1delta;
  __device__ __forceinline__ bool next(int i, g8::Unit& u) const {
    const long L = (long)i * G + c;
    if (L >= nunits) return false;
    const int nM = lat_only ? T / 256 - 2 : T / 256, nN = ntn, nwg = nunits;
    int wgid = (int)L;
    { const int q = nwg / 8, r = nwg % 8, xcd = wgid % 8, off = wgid / 8; wgid = (xcd < r ? xcd * (q + 1) : r * (q + 1) + (xcd - r) * q) + off; }
    const int nig = 8 * nN, gid = wgid / nig, fm = gid * 8, gsz = (nM - fm) < 8 ? (nM - fm) : 8;
    int pm = fm + ((wgid % nig) % gsz); const int pn = (wgid % nig) / gsz;
    if (lat_only) pm = pm < 64 ? pm + 1 : pm + 2;
    u.b0 = (const char*)(Bt + (long)(pn * 256) * K);
    u.i0 = pm * 256; u.i1 = pn * 256; u.i2 = 0; u.i3 = 0;
    return true;
  }
};
struct DenseRow { static constexpr bool GATHER = false;
  __device__ __forceinline__ int operator()(const g8::Unit& u, int r) const { return u.i0 + r; }
  __device__ __forceinline__ const int* addr(const g8::Unit&, int) const { return nullptr; } };
struct DenseEpi {
  static constexpr int NST = 16;
  u16* z; u16* tmp; u16* trash; int N, mode;
  struct Pre {};
  __device__ __forceinline__ void load(Pre&, const g8::Unit&, int, int, int, int) const {}
  __device__ __forceinline__ void operator()(const f32x4 (&acc)[2][2][4][2], const g8::Unit& u, const Pre&, int wr, int wc, int fr, int fq) const {
#pragma unroll
    for (int ai = 0; ai < 2; ++ai)
#pragma unroll
      for (int m = 0; m < 4; ++m) {
        const long row = u.i0 + ai * 128 + wr * 64 + m * 16 + fr;
#pragma unroll
        for (int bj = 0; bj < 2; ++bj) {
          const int col = u.i1 + bj * 128 + wc * 32 + fq * 8;
          const f32x4 v0 = acc[ai][bj][m][0], v1 = acc[ai][bj][m][1];
          uint4 o; o.x = pack2(v0[0], v0[1]); o.y = pack2(v0[2], v0[3]); o.z = pack2(v1[0], v1[1]); o.w = pack2(v1[2], v1[3]);
          u16* dst = mode == 0 ? (col < N ? z + row * N + col : trash + ((row & 255) * 1024 + (col & 1023))) : tmp + row * D + col;
          *reinterpret_cast<uint4*>(dst) = o;
        }
      }
  }
};
__device__ __forceinline__ void phase_gemm_dense8(const Params& p, const u16* Bt, int Npad, int N, int mode, int lat_only = 0) {
  DenseSched S; S.Bt = Bt; S.ntn = Npad / 256; S.lat_only = lat_only; S.nunits = (lat_only ? T / 256 - 2 : T / 256) * S.ntn; S.G = gridDim.x; S.c = blockIdx.x; S.K = D; S.b1delta = (long)128 * D * 2;
  DenseEpi E; E.z = p.zbuf; E.tmp = p.tmp; E.trash = p.trash; E.N = N; E.mode = mode;
  g8::gemm_phase(p.abuf, D, S, DenseRow(), E);
}

struct MoeTab8 { int tstart[33]; int base[33]; };
__device__ __forceinline__ MoeTab8* moe_tab8(const Params& p, int layer) {
  MoeTab8* tab = (MoeTab8*)(smem_raw + 131072 + 1024);
  __syncthreads();
  if (threadIdx.x == 0) {
    int run = 0, trun = 0;
    for (int e = 0; e < NE; ++e) {
      int cnt = p.cnt[CNTI(layer, 0, e)];
      tab->base[e] = run; tab->tstart[e] = trun;
      run += cnt; trun += (cnt + 255) >> 8;
    }
    tab->base[32] = run; tab->tstart[32] = trun;
  }
  __syncthreads();
  return tab;
}
struct MoeSched {
  const MoeTab8* tab; const u16* W; int NU, G, c, which;
  long b1delta;
  __device__ __forceinline__ bool next(int i, g8::Unit& u) const {
    const long L = (long)i * G + c;
    const int ntiles = __builtin_amdgcn_readfirstlane(tab->tstart[32]);
    const int nun = ntiles * NU;
    if (L >= (long)nun) return false;
    int wg = (int)L;
    { const int q = nun / 8, r = nun % 8, xcd = wg % 8, off = wg / 8; wg = (xcd < r ? xcd * (q + 1) : r * (q + 1) + (xcd - r) * q) + off; }
    const int ti = wg / NU, nu = wg % NU;
    int e = min(NE - 1, (int)(((long)ti * NE) / max(ntiles, 1)));
#pragma unroll 1
    while (e > 0 && ti < __builtin_amdgcn_readfirstlane(tab->tstart[e])) --e;
#pragma unroll 1
    while (e < NE - 1 && ti >= __builtin_amdgcn_readfirstlane(tab->tstart[e + 1])) ++e;
    const int mt = ti - __builtin_amdgcn_readfirstlane(tab->tstart[e]);
    const int be = __builtin_amdgcn_readfirstlane(tab->base[e]);
    const int cnt = __builtin_amdgcn_readfirstlane(tab->base[e + 1]) - be;
    u.i0 = be + mt * 256;
    u.i1 = min(256, cnt - mt * 256);
    u.i2 = e; u.i3 = nu;
    if (which == 0) {
      const u16* We = W + (long)e * 2048 * 1024;
      u.b0 = (const char*)(We + (long)(nu * 128) * 1024);
    } else {
      const u16* We = W + (long)e * 1024 * 1024;
      u.b0 = (const char*)(We + (long)(nu * 256) * 1024);
    }
    return true;
  }
};
struct Moe1Row { const int* slot_tok; static constexpr bool GATHER = true;
  __device__ __forceinline__ int operator()(const g8::Unit& u, int r) const { return slot_tok[u.i0 + min(r, u.i1 - 1)]; }
  __device__ __forceinline__ const int* addr(const g8::Unit& u, int r) const { return slot_tok + (u.i0 + min(r, u.i1 - 1)); } };
struct Moe2Row { static constexpr bool GATHER = false;
  __device__ __forceinline__ int operator()(const g8::Unit& u, int r) const { return u.i0 + min(r, u.i1 - 1); }
  __device__ __forceinline__ const int* addr(const g8::Unit&, int) const { return nullptr; } };
struct Moe1Epi {
  static constexpr int NST = 8;
  u16* act; u16* trash; const float* b_in;
  struct Pre { float4 g0, g1, l0, l1; };
  __device__ __forceinline__ void load(Pre& q, const g8::Unit& u, int wr, int wc, int fr, int fq) const {
    const float* bi = b_in + (long)u.i2 * 2048;
    const int ca = u.i3 * 128 + wc * 32 + fq * 8;
    q.g0 = *reinterpret_cast<const float4*>(bi + ca); q.g1 = *reinterpret_cast<const float4*>(bi + ca + 4);
    q.l0 = *reinterpret_cast<const float4*>(bi + 1024 + ca); q.l1 = *reinterpret_cast<const float4*>(bi + 1024 + ca + 4);
  }
  __device__ __forceinline__ void operator()(const f32x4 (&acc)[2][2][4][2], const g8::Unit& u, const Pre& q, int wr, int wc, int fr, int fq) const {
    const int ca = u.i3 * 128 + wc * 32 + fq * 8;
    const fl2_t bg2[4] = {{q.g0.x, q.g0.y}, {q.g0.z, q.g0.w}, {q.g1.x, q.g1.y}, {q.g1.z, q.g1.w}};
    const fl2_t bl2[4] = {{q.l0.x, q.l0.y}, {q.l0.z, q.l0.w}, {q.l1.x, q.l1.y}, {q.l1.z, q.l1.w}};
    const fl2_t one2 = {1.0f, 1.0f}, sc2 = {-2.4554669595929157f, -2.4554669595929157f};
#pragma unroll
    for (int ai = 0; ai < 2; ++ai)
#pragma unroll
      for (int m = 0; m < 4; ++m) {
        const int r = ai * 128 + wr * 64 + m * 16 + fr;
        uint4 o;
        unsigned ow[4];
#pragma unroll
        for (int n = 0; n < 2; ++n)
#pragma unroll
          for (int jp = 0; jp < 2; ++jp) {
            fl2_t g = fl2_t{acc[ai][0][m][n][2 * jp], acc[ai][0][m][n][2 * jp + 1]} + bg2[n * 2 + jp];
            fl2_t l = fl2_t{acc[ai][1][m][n][2 * jp], acc[ai][1][m][n][2 * jp + 1]} + bl2[n * 2 + jp];
            g.x = fminf(g.x, 7.0f); g.y = fminf(g.y, 7.0f);
            l.x = fminf(fmaxf(l.x, -7.0f), 7.0f); l.y = fminf(fmaxf(l.y, -7.0f), 7.0f);
            fl2_t e = g * sc2;
            e.x = __builtin_amdgcn_exp2f(e.x); e.y = __builtin_amdgcn_exp2f(e.y);
            e = e + one2;
            fl2_t s = {__builtin_amdgcn_rcpf(e.x), __builtin_amdgcn_rcpf(e.y)};
            const fl2_t v = (g * s) * (l + one2);
            ow[n * 2 + jp] = __builtin_bit_cast(unsigned, __builtin_convertvector(v, bf2_t));
          }
        o.x = ow[0]; o.y = ow[1]; o.z = ow[2]; o.w = ow[3];
        *reinterpret_cast<uint4*>(r < u.i1 ? act + (long)(u.i0 + r) * D + ca : trash + (r * 1024 + (ca & 1023))) = o;
      }
  }
};
struct Moe2Epi {
  static constexpr int NST = 16;
  u16* oslot; u16* trash; const float* b_out; const float* slot_gw;
  struct Pre { float4 b[2][2]; float gw[8]; };
  __device__ __forceinline__ void load(Pre& q, const g8::Unit& u, int wr, int wc, int fr, int fq) const {
    const float* bo = b_out + (long)u.i2 * 1024;
#pragma unroll
    for (int bj = 0; bj < 2; ++bj) {
      const int cc = u.i3 * 256 + bj * 128 + wc * 32 + fq * 8;
      q.b[bj][0] = *reinterpret_cast<const float4*>(bo + cc); q.b[bj][1] = *reinterpret_cast<const float4*>(bo + cc + 4);
    }
#pragma unroll
    for (int ai = 0; ai < 2; ++ai)
#pragma unroll
      for (int m = 0; m < 4; ++m) q.gw[ai * 4 + m] = slot_gw[u.i0 + min(ai * 128 + wr * 64 + m * 16 + fr, u.i1 - 1)];
  }
  __device__ __forceinline__ void operator()(const f32x4 (&acc)[2][2][4][2], const g8::Unit& u, const Pre& q, int wr, int wc, int fr, int fq) const {
#pragma unroll
    for (int ai = 0; ai < 2; ++ai)
#pragma unroll
      for (int m = 0; m < 4; ++m) {
        const int r = ai * 128 + wr * 64 + m * 16 + fr;
        const bool ok = r < u.i1;
        const float gw = q.gw[ai * 4 + m];
#pragma unroll
        for (int bj = 0; bj < 2; ++bj) {
          const int cc = u.i3 * 256 + bj * 128 + wc * 32 + fq * 8;
          const float4 b0 = q.b[bj][0], b1 = q.b[bj][1];
          const f32x4 v0 = acc[ai][bj][m][0], v1 = acc[ai][bj][m][1];
          const fl2_t g2 = {gw, gw};
          const fl2_t o0 = (fl2_t{v0[0], v0[1]} + fl2_t{b0.x, b0.y}) * g2, o1 = (fl2_t{v0[2], v0[3]} + fl2_t{b0.z, b0.w}) * g2;
          const fl2_t o2 = (fl2_t{v1[0], v1[1]} + fl2_t{b1.x, b1.y}) * g2, o3 = (fl2_t{v1[2], v1[3]} + fl2_t{b1.z, b1.w}) * g2;
          uint4 o;
          o.x = __builtin_bit_cast(unsigned, __builtin_convertvector(o0, bf2_t)); o.y = __builtin_bit_cast(unsigned, __builtin_convertvector(o1, bf2_t));
          o.z = __builtin_bit_cast(unsigned, __builtin_convertvector(o2, bf2_t)); o.w = __builtin_bit_cast(unsigned, __builtin_convertvector(o3, bf2_t));
          *reinterpret_cast<uint4*>(ok ? oslot + (long)(u.i0 + r) * D + cc : trash + (r * 1024 + cc)) = o;
        }
      }
  }
};
__device__ __forceinline__ void phase_moe_gemm1_8(const Params& p, int layer) {
  const MoeTab8* tab = moe_tab8(p, layer);
  MoeSched S; S.tab = tab; S.W = p.MoeInT + (long)layer * 32 * 2048 * 1024; S.NU = 8; S.G = gridDim.x; S.c = blockIdx.x; S.which = 0; S.b1delta = (long)1024 * 1024 * 2;
  Moe1Row R; R.slot_tok = p.slot_tok;
  Moe1Epi E; E.act = p.act; E.trash = p.trash; E.b_in = p.moe_b_in + (long)layer * 32 * 2048;
  g8::gemm_phase(p.abuf, D, S, R, E);
}
__device__ __forceinline__ void phase_moe_gemm2_8(const Params& p, int layer) {
  const MoeTab8* tab = moe_tab8(p, layer);
  MoeSched S; S.tab = tab; S.W = p.MoeOutT + (long)layer * 32 * 1024 * 1024; S.NU = 4; S.G = gridDim.x; S.c = blockIdx.x; S.which = 1; S.b1delta = (long)128 * 1024 * 2;
  Moe2Epi E; E.oslot = p.oslot; E.trash = p.trash; E.b_out = p.moe_b_out + (long)layer * 32 * 1024; E.slot_gw = p.slot_gw;
  g8::gemm_phase(p.act, D, S, Moe2Row(), E);
}
__device__ __forceinline__ void phase_gemm_dense(const Params& p, const u16* Bt, int Npad, int N, int mode) {
  const int ntn = Npad / 256;
  const int tiles = (T / 128) * ntn;
  const int tid = opaque_tid(), wid = tid >> 6, lane = tid & 63, wr = wid >> 1, wc = wid & 1, fr = lane & 15, fq = lane >> 4;
  for (int t = VBID; t < tiles; t += NVB) {
    const int mt = t / ntn, nt = t % ntn;
    f32x4 acc[4][8];
    gemm_tile(p.abuf, D, Bt, D, D, [&](int r) { return mt * 128 + r; }, [&](int r) { return nt * 256 + r; }, acc);
#pragma unroll
    for (int m = 0; m < 4; ++m)
#pragma unroll
      for (int n = 0; n < 8; ++n) {
        const long row = mt * 128 + wr * 64 + m * 16 + fr;
        const int col = nt * 256 + wc * 128 + n * 16 + fq * 4;
        if (mode == 0) {
          if (col < N) {
            uint2 o; o.x = pack2(acc[m][n][0], acc[m][n][1]); o.y = pack2(acc[m][n][2], acc[m][n][3]);
            *reinterpret_cast<uint2*>(p.zbuf + row * N + col) = o;
          }
        } else {
          { uint2 o; o.x = pack2(acc[m][n][0], acc[m][n][1]); o.y = pack2(acc[m][n][2], acc[m][n][3]); *reinterpret_cast<uint2*>(p.tmp + row * D + col) = o; }
        }
      }
  }
}

#ifndef WSLP_G
#define WSLP_G 0
#endif
#ifndef WSLP_R
#define WSLP_R 0
#endif
#ifndef RW_LATE
#define RW_LATE 1
#endif
#ifndef RW_WF
#define RW_WF 4
#endif
#ifndef GDN_WF
#define GDN_WF 0
#endif
#ifndef GDN_LATE
#define GDN_LATE 100
#endif
#ifndef REP_MOE
#define REP_MOE 1
#endif
#ifndef REP_DENSE
#define REP_DENSE 1
#endif
#ifndef REP_PREP
#define REP_PREP 1
#endif
#ifndef REP_SCAN
#define REP_SCAN 1
#endif
#ifndef REP_W
#define REP_W 1
#endif
#ifndef PREP_SKEW
#define PREP_SKEW 0
#endif
#ifndef REP_PREP_R
#define REP_PREP_R 1
#endif
#ifndef REP_PREP_G
#define REP_PREP_G 1
#endif
#ifndef REP_POST
#define REP_POST 1
#endif
#ifndef REP_COMB
#define REP_COMB 1
#endif
#ifndef REP_ROW
#define REP_ROW 1
#endif
#ifndef REP_POOL
#define REP_POOL 1
#endif
__global__ void __launch_bounds__(512, 2) mega(Params p) {
  cg::grid_group grid = cg::this_grid();
  volatile LAS unsigned* xbst = (volatile LAS unsigned*)(smem_raw + LDS_BYTES - 16);
  if (threadIdx.x == 0) { xbst[0] = 0u; xbst[1] = 0u; xbst[2] = 0u; xbst[3] = 0u; }
  __syncthreads();
  const XcdBarrier xb = xcd_barrier_post(p.bar, xbst);
  for (int rep = 0; rep < REP_W; ++rep) phase_weights(p, 0, p.early_tiles, VBID, NVB);
  phase_mods_partial(p);
  if (p.total_tiles < 0) grid.sync();
  xcd_barrier(xb);
  phase_mods_reduce(p);
  xcd_barrier(xb);
  for (int rep = 0; rep < REP_ROW; ++rep) phase_norm_in(p, 0, true);
  xcd_barrier(xb);
  for (int rep = 0; rep < REP_DENSE; ++rep) phase_gemm_dense8(p, p.WabT, AB_PAD, AB_IN, 0);
  xcd_barrier(xb);
  constexpr int RW_S0 = RW_LATE ? RW_CUT : NCH;
  static_assert(RW_S0 * NB * 12 * 2 <= RW_N0_ && RW_S0 % 5 == 0, "every item of the scan's first part must be prepared in the prep phase");
  for (int rep = 0; rep < REP_PREP_R; ++rep) { if (half_id()) rwkv_prep_all<1, false>(p); else rwkv_prep_all<0, false>(p); }
  xcd_barrier(xb);
  {
#define RW_WSPLIT (p.early_tiles + ((int)(((long)(p.mid_tiles - p.early_tiles) * RW_WF) / 5) & ~15))
#pragma unroll 1
    for (int part = 0; part < (RW_LATE ? 2 : 1); ++part) {
      if (blockIdx.x < 48) {
        const int s_begin = part ? RW_S0 : 0, s_end = part ? NCH : RW_S0;
        if (half_id() == 0) rwkv_scan_block(p, blockIdx.x, s_begin, s_end); else rwkv_scan_copy(p, blockIdx.x, s_begin, s_end);
      } else if (part == 0) {
        if (RW_LATE) { if (half_id()) rwkv_prep_all<1, true>(p); else rwkv_prep_all<0, true>(p); }
        for (int rep = 0; rep < REP_POOL; ++rep)
        for (int it = VBID - 96; it < NB * 260 * 4; it += NVB - 96) {
          int g = it & 3, r = it >> 2;
          int rb = r % 260, b = r / 260;
          pool_item(p, b, rb, g);
        }
        phase_weights<WSLP_R>(p, p.early_tiles, RW_LATE ? RW_WSPLIT : p.mid_tiles, VBID - 96, NVB - 96);
      } else {
        phase_weights<WSLP_R>(p, RW_WSPLIT, p.mid_tiles, VBID - 96, NVB - 96);
      }
      xcd_barrier(xb);
    }
  }
  for (int rep = 0; rep < REP_ROW; ++rep)
  for (int it = VBID; it < NB * NCH * 12; it += NVB) {
    int h = it % 12, r = it / 12;
    int c = r % NCH, b = r / NCH;
    rwkv_out_item(p, b, c, h);
  }
  xcd_barrier(xb);
  for (int rep = 0; rep < REP_DENSE; ++rep) phase_gemm_dense8(p, p.WoutT, 1024, 1024, 1);
  xcd_barrier(xb);
  for (int rep = 1; rep < REP_POST; ++rep) phase_post_mixer(p, 0, true);
  phase_post_mixer(p, 0);
  xcd_barrier(xb);
  phase_moe_scatter(p, 0);
  xcd_barrier(xb);
  for (int rep = 0; rep < REP_MOE; ++rep) { phase_moe_gemm1_8(p, 0);
  xcd_barrier(xb);
  phase_moe_gemm2_8(p, 0); if (rep + 1 < REP_MOE) xcd_barrier(xb); }
  xcd_barrier(xb);
  for (int rep = 1; rep < REP_COMB; ++rep) phase_moe_combine(p, 0, true);
  phase_moe_combine(p, 0);
  xcd_barrier(xb);
  for (int rep = 0; rep < REP_DENSE; ++rep) phase_gemm_dense8(p, p.WgdnT, GDN_PAD, GDN_IN, 0);
  xcd_barrier(xb);
  constexpr int GDN_S0 = GDN_S0_;
  for (int rep = 0; rep < REP_PREP_G; ++rep) { if (half_id()) gdn_prep_all<1, false>(p); else gdn_prep_all<0, false>(p); }
  xcd_barrier(xb);
  {
    const int bx = blockIdx.x, sid2 = (((bx & 7) + 8 * (bx >> 4)) << 1) | ((bx >> 3) & 1);
#define GDN_WSPLIT (p.mid_tiles + ((int)(((long)(p.total_tiles - p.mid_tiles) * GDN_WF) / 5) & ~15))
#pragma unroll 1
    for (int part = 0; part < (GDN_LATE ? 2 : 1); ++part) {
      if (blockIdx.x < 64) {
        const int s_begin = part ? GDN_S0 : 0, s_end = part ? NCH : GDN_S0;
        if (half_id() == 0) gdn_scan_compute(p, sid2, s_begin, s_end); else gdn_scan_loader(p, sid2, s_begin, s_end);
      } else if (part == 0) {
        if (half_id()) gdn_prep_all<1, true>(p); else gdn_prep_all<0, true>(p);
        phase_weights<WSLP_G>(p, p.mid_tiles, GDN_LATE ? GDN_WSPLIT : p.total_tiles, VBID - 128, NVB - 128);
      } else {
        phase_weights<WSLP_G>(p, GDN_WSPLIT, p.total_tiles, VBID - 128, NVB - 128);
      }
      xcd_barrier(xb);
    }
  }
  for (int rep = 0; rep < REP_ROW; ++rep) phase_gdn_out(p);
  xcd_barrier(xb);
  for (int rep = 0; rep < REP_DENSE; ++rep) phase_gemm_dense8(p, p.WoutT + 1024 * 1024, 1024, 1024, 1, 1);
  xcd_barrier(xb);
  for (int rep = 1; rep < REP_POST; ++rep) phase_post_mixer(p, 1, true);
  phase_post_mixer(p, 1);
  xcd_barrier(xb);
  phase_moe_scatter(p, 1);
  xcd_barrier(xb);
  for (int rep = 0; rep < REP_MOE; ++rep) { phase_moe_gemm1_8(p, 1);
  xcd_barrier(xb);
  phase_moe_gemm2_8(p, 1); if (rep + 1 < REP_MOE) xcd_barrier(xb); }
  xcd_barrier(xb);
  for (int rep = 1; rep < REP_COMB; ++rep) phase_moe_combine(p, 1, true);
  phase_moe_combine(p, 1);
}

extern "C" void kernel_launch(void* const* d_in, const int* in_sizes, int n_in, void* d_out, int out_size, void* d_ws,
                              size_t ws_size, hipStream_t stream) {
  static int grid_blocks = 0;
  if (!grid_blocks) {
    int dev = 0, cus = 0, per_cu = 0;
    (void)hipGetDevice(&dev);
    (void)hipDeviceGetAttribute(&cus, hipDeviceAttributeMultiprocessorCount, dev);
    (void)hipFuncSetAttribute((const void*)mega, hipFuncAttributeMaxDynamicSharedMemorySize, (int)LDS_BYTES);
    (void)hipOccupancyMaxActiveBlocksPerMultiprocessor(&per_cu, mega, 512, LDS_BYTES);
    if (per_cu > 1) per_cu = 1;
    if (per_cu < 1) per_cu = 1;
    grid_blocks = cus * per_cu;
  }
  Params p;
  memset(&p, 0, sizeof(p));
  const float** fp = (const float**)&p.x;
  for (int i = 0; i < 33; ++i) fp[i] = (const float*)d_in[i];
  p.out = (float*)d_out;
  char* ws = (char*)d_ws;
  size_t off = 0;
  auto take = [&](size_t bytes) { char* r = ws + off; off += (bytes + 255) & ~(size_t)255; return r; };
  p.cnt = (int*)take(32768);
  p.bar = (unsigned*)take((size_t)XCD_BAR_WORDS * 4);
  p.modpart = (float*)take((size_t)8 * 2 * 3 * 6144 * 4);
  p.mods = (float*)take((size_t)2 * 3 * 6144 * 4);
  p.WabT = (u16*)take((size_t)AB_PAD * 1024 * 2);
  p.WoutT = (u16*)take((size_t)2 * 1024 * 1024 * 2);
  p.WgdnT = (u16*)take((size_t)GDN_PAD * 1024 * 2);
  p.MoeInT = (u16*)take((size_t)64 * 2048 * 1024 * 2);
  p.MoeOutT = (u16*)take((size_t)64 * 1024 * 1024 * 2);
  p.WupT = (u16*)take((size_t)2 * 768 * 64 * 2);
  p.AupT = (u16*)take((size_t)2 * 768 * 64 * 2);
  p.GupT = (u16*)take((size_t)768 * 128 * 2);
  p.PoolT = (u16*)take((size_t)4 * 64 * 64 * 2);
  p.xs = (u16*)take((size_t)T * D * 2);
  p.abuf = (u16*)take((size_t)T * D * 2);
  p.zbuf = (u16*)take((size_t)T * GDN_IN * 2);
  p.tmp = p.zbuf;
  p.oslot = p.zbuf;
  p.prep = (u16*)take((size_t)NB * 8 * 2 * NCH * GD_ITEM * 2);
  p.act = p.prep;
  p.yf = (u16*)take((size_t)T * D * 2);
  p.yb = (u16*)take((size_t)T * D * 2);
  p.tok_e = (int*)take((size_t)T * 4 * 4);
  p.tok_gw = (float*)take((size_t)T * 4 * 4);
  p.tok_slot = (int*)take((size_t)T * 4 * 4);
  p.slot_tok = (int*)take((size_t)T * 4 * 4);
  p.slot_gw = (float*)take((size_t)T * 4 * 4);
  p.trash = (u16*)take((size_t)256 * 1024 * 2);
  if (off > ws_size) { fprintf(stderr, "workspace too small: need %zu have %zu\n", off, ws_size); return; }
  int ts = 0;
  auto fam = [&](int i, const float* src, u16* dst, int nmat, int K, int N, int Npad) {
    TFam& F = p.fam[i];
    F.src = src; F.dst = dst; F.nmat = nmat; F.K = K; F.N = N; F.Npad = Npad;
    F.sstride = (long)K * N; F.dstride = (long)Npad * K;
    F.tiles_per_mat = (K / 64) * (Npad / 64); F.tile_start = ts;
    ts += nmat * F.tiles_per_mat;
  };
  fam(0, p.ab_w_in, p.WabT, 1, 1024, AB_IN, AB_PAD);
  fam(1, p.w_out, p.WoutT, 2, 1024, 1024, 1024);
  fam(2, p.gdn_w_in, p.WgdnT, 1, 1024, GDN_IN, GDN_PAD);
  fam(3, p.rwkv_w_up, p.WupT, 2, 64, 768, 768);
  fam(4, p.rwkv_a_up, p.AupT, 2, 64, 768, 768);
  fam(5, p.rwkv_g_up, p.GupT, 1, 128, 768, 768);
  fam(6, p.pool_w, p.PoolT, 4, 64, 64, 64);
  p.early_tiles = ts;
  fam(7, p.moe_w_in, p.MoeInT, 32, 1024, 2048, 2048);
  fam(8, p.moe_w_out, p.MoeOutT, 32, 1024, 1024, 1024);
  p.mid_tiles = ts;
  fam(9, p.moe_w_in + (size_t)32 * 1024 * 2048, p.MoeInT + (size_t)32 * 2048 * 1024, 32, 1024, 2048, 2048);
  fam(10, p.moe_w_out + (size_t)32 * 1024 * 1024, p.MoeOutT + (size_t)32 * 1024 * 1024, 32, 1024, 1024, 1024);
  p.total_tiles = ts;
  (void)hipMemsetAsync(p.cnt, 0, 32768 + ((XCD_BAR_WORDS * 4 + 255) & ~255), stream);
  void* args[] = {&p};
  hipError_t e = hipLaunchCooperativeKernel((void*)mega, dim3(grid_blocks), dim3(512), args, LDS_BYTES, stream);
  if (e != hipSuccess) fprintf(stderr, "coop launch failed: %s (grid %d)\n", hipGetErrorString(e), grid_blocks);
}
```

```cpp
#include <hip/hip_runtime.h>
#include <hip/hip_cooperative_groups.h>
#include <cstdio>
#include <cstdint>
#include <cstring>
namespace cg = cooperative_groups;

typedef unsigned short u16;
using bf16x8 = __attribute__((ext_vector_type(8))) short;
using f32x4 = __attribute__((ext_vector_type(4))) float;
using u16x4 = __attribute__((ext_vector_type(4))) unsigned short;
#define MFMA16(a, b, c) __builtin_amdgcn_mfma_f32_16x16x32_bf16(a, b, c, 0, 0, 0)

constexpr int D = 1024, NB = 2, SEQ = 16384, CTXL = 256, PB = SEQ + CTXL, T = NB * PB, NCH = PB / 64;
constexpr int AB_IN = 2944, AB_PAD = 3072, GDN_IN = 4128, GDN_PAD = 4352, RWKV_IN = 2688;
constexpr int NE = 32, TOPK = 4;
constexpr int NTH = 256;
constexpr int LDS_HALF = 75776;
constexpr size_t LDS_BYTES = 2 * LDS_HALF;
constexpr int MB = 9216;
constexpr int RW_ITEM = 16384;
constexpr int GD_ITEM = 49152;

#define CNTI(layer, which, e) ((((layer) * 2 + (which)) * 32 + (e)) * 64)

struct TFam { const float* src; u16* dst; long sstride, dstride; int nmat, K, N, Npad, tiles_per_mat, tile_start; };

struct Params {
  const float *x, *c, *ctx, *c_ctx, *ada_w, *ada_b, *norm_g, *w_out, *ab_w_in, *ab_mu, *pool_w, *pool_scale,
      *rwkv_w0, *rwkv_w_up, *rwkv_a0, *rwkv_a_up, *rwkv_g_up, *rwkv_k_k, *rwkv_k_a, *rwkv_r_k, *rwkv_gn_w, *rwkv_gn_b,
      *gdn_w_in, *gdn_conv, *gdn_a_log, *gdn_dt_bias, *gdn_norm_g, *router_w, *router_b, *moe_w_in, *moe_b_in,
      *moe_w_out, *moe_b_out;
  float* out;
  int* cnt;
  unsigned* bar;
  float* modpart;
  float* mods;
  u16 *WabT, *WoutT, *WgdnT, *MoeInT, *MoeOutT, *WupT, *AupT, *GupT, *PoolT;
  u16* xs;
  u16* abuf;
  u16* zbuf;
  u16* tmp;
  u16* prep;
  u16 *yf, *yb;
  u16* act;
  u16* oslot;
  int* tok_e;
  float* tok_gw;
  int* tok_slot;
  int* slot_tok;
  float* slot_gw;
  u16* trash;
  TFam fam[11];
  int total_tiles;
  int early_tiles;
  int mid_tiles;
  int pad1;
};

typedef __bf16 bf2_t __attribute__((ext_vector_type(2)));
typedef float fl2_t __attribute__((ext_vector_type(2)));
__device__ __forceinline__ unsigned pack2(float a, float b) {
  fl2_t f = {a, b};
  bf2_t h = __builtin_convertvector(f, bf2_t);
  return __builtin_bit_cast(unsigned, h);
}
__device__ __forceinline__ u16 f2bf(float f) { return (u16)(pack2(f, 0.f) & 0xffffu); }
__device__ __forceinline__ float bf2f(u16 h) { return __uint_as_float(((unsigned)h) << 16); }
__device__ __forceinline__ float sigmoidf_(float x) { return __builtin_amdgcn_rcpf(1.0f + __expf(-x)); }
__device__ __forceinline__ float siluf_(float x) { return x * __builtin_amdgcn_rcpf(1.0f + __expf(-x)); }
__device__ __forceinline__ float softplusf_(float y) { return fmaxf(y, 0.0f) + __logf(1.0f + __expf(-fabsf(y))); }
__device__ __forceinline__ float tanhf_(float x) { return 2.0f * __builtin_amdgcn_rcpf(1.0f + __expf(-2.0f * x)) - 1.0f; }
typedef __bf16 bf2v_t __attribute__((ext_vector_type(2)));
__device__ __forceinline__ float dot2bf(unsigned a, unsigned b, float c) {
  return __builtin_amdgcn_fdot2_f32_bf16(__builtin_bit_cast(bf2v_t, a), __builtin_bit_cast(bf2v_t, b), c, false);
}
__device__ __forceinline__ float wave_sum(float v) {
#pragma unroll
  for (int o = 32; o > 0; o >>= 1) v += __shfl_xor(v, o);
  return v;
}
__device__ __forceinline__ float4 ld4bf(const u16* p) {
  uint2 a = *reinterpret_cast<const uint2*>(p);
  return make_float4(__uint_as_float(a.x << 16), __uint_as_float(a.x & 0xffff0000u), __uint_as_float(a.y << 16), __uint_as_float(a.y & 0xffff0000u));
}
__device__ __forceinline__ void st4bf(u16* p, float4 v) { uint2 o; o.x = pack2(v.x, v.y); o.y = pack2(v.z, v.w); *reinterpret_cast<uint2*>(p) = o; }
__device__ __forceinline__ void ld8(const u16* p, float* o) {
  uint4 v = *reinterpret_cast<const uint4*>(p);
  o[0] = __uint_as_float(v.x << 16); o[1] = __uint_as_float(v.x & 0xffff0000u);
  o[2] = __uint_as_float(v.y << 16); o[3] = __uint_as_float(v.y & 0xffff0000u);
  o[4] = __uint_as_float(v.z << 16); o[5] = __uint_as_float(v.z & 0xffff0000u);
  o[6] = __uint_as_float(v.w << 16); o[7] = __uint_as_float(v.w & 0xffff0000u);
}
__device__ __forceinline__ void st8(u16* p, const float* v) {
  uint4 o;
  o.x = pack2(v[0], v[1]); o.y = pack2(v[2], v[3]); o.z = pack2(v[4], v[5]); o.w = pack2(v[6], v[7]);
  *reinterpret_cast<uint4*>(p) = o;
}

extern __shared__ __attribute__((aligned(16))) unsigned char smem_raw[];
__device__ __forceinline__ int half_id() { return __builtin_amdgcn_readfirstlane((int)(threadIdx.x >> 8)); }
#define smem (smem_raw + half_id() * LDS_HALF)
#define VBID ((int)(blockIdx.x * 2 + half_id()))
#define NVB ((int)(gridDim.x * 2))
__device__ __forceinline__ int opaque_tid() { int t = threadIdx.x; asm volatile("" : "+v"(t)); return t & 255; }


#define XB_TMO      128
#define XB_XCNT(j)  (256  + 64 * (j))
#define XB_XSUB(j)  (1280 + 64 * (j))
#define XB_XGEN(j)  (2304 + 64 * (j))
#define XB_TOP      3328
#define XB_TOPGEN   3392
#define XCD_BAR_WORDS 3456
#define XB_SPIN_CAP (1u << 22)
#ifndef REP_BAR
#define REP_BAR 1
#endif
#define LAS __attribute__((address_space(3)))
__device__ __forceinline__ unsigned xb_ld(unsigned* p) { return __hip_atomic_load(p, __ATOMIC_RELAXED, __HIP_MEMORY_SCOPE_AGENT); }
__device__ __forceinline__ unsigned xb_add(unsigned* p, unsigned v) { return __hip_atomic_fetch_add(p, v, __ATOMIC_RELAXED, __HIP_MEMORY_SCOPE_AGENT); }
__device__ __forceinline__ unsigned xb_xcc_id() { return (unsigned)__builtin_amdgcn_s_getreg((3 << 11) | 20) & 0xFu; }
#define XB_SPIN(cond, bar) do { unsigned _sp = 0; while (cond) { __builtin_amdgcn_s_sleep(1); \
    if ((++_sp & 255u) == 0u) { if (xb_ld(&(bar)[XB_TMO])) break; if (_sp > XB_SPIN_CAP) { atomicAdd(&(bar)[XB_TMO], 1u); break; } } } } while (0)
struct XcdBarrier { unsigned* bar; unsigned x; volatile LAS unsigned* st; };
__device__ __forceinline__ XcdBarrier xcd_barrier_post(unsigned* bar, volatile LAS unsigned* st) {
  XcdBarrier b; b.bar = bar; b.x = xb_xcc_id(); b.st = st;
  if (threadIdx.x == 0) (void)xb_add(&bar[XB_XCNT(b.x)], 1u);
  return b;
}
__device__ __forceinline__ void xcd_barrier_complete(unsigned* bar, unsigned x, unsigned& nloc, unsigned& nx) {
  const unsigned G = gridDim.x * gridDim.y * gridDim.z;
  unsigned sum, cnt, mine, sp = 0u;
  for (;;) {
    sum = 0u; cnt = 0u; mine = 0u;
#pragma unroll
    for (unsigned j = 0; j < 16; ++j) { const unsigned c = xb_ld(&bar[XB_XCNT(j)]); sum += c; cnt += (c > 0u) ? 1u : 0u; mine = (j == x) ? c : mine; }
    if (sum == G) break;
    __builtin_amdgcn_s_sleep(1);
    if ((++sp & 255u) == 0u) { if (xb_ld(&bar[XB_TMO])) break; if (sp > XB_SPIN_CAP) { atomicAdd(&bar[XB_TMO], 1u); break; } }
  }
  nloc = mine > 0u ? mine : 1u; nx = cnt > 0u ? cnt : 1u;
}
__device__ __forceinline__ void xcd_barrier1(const XcdBarrier& b) {
  asm volatile("s_waitcnt vmcnt(0)" ::: "memory");
  __syncthreads();
  if (threadIdx.x == 0) {
    unsigned* bar = b.bar;
    const unsigned bx = xb_xcc_id();
    __builtin_amdgcn_s_waitcnt(0);
    unsigned nloc = b.st[0], nx = b.st[1];
    if (nloc == 0u) { xcd_barrier_complete(bar, bx, nloc, nx); b.st[0] = nloc; b.st[1] = nx; }
    const unsigned old = xb_add(&bar[XB_XSUB(bx)], 1u);
    const unsigned gen = old / nloc;
    if (old + 1u == (gen + 1u) * nloc) {
      __builtin_amdgcn_fence(__ATOMIC_RELEASE, "agent");
      asm volatile("s_waitcnt vmcnt(0)" ::: "memory");
      const unsigned og = xb_add(&bar[XB_TOP], 1u);
      const unsigned tg = og / nx;
      if (og + 1u == (tg + 1u) * nx) xb_add(&bar[XB_TOPGEN], 1u);
      else XB_SPIN(xb_ld(&bar[XB_TOPGEN]) == tg, bar);
      __builtin_amdgcn_fence(__ATOMIC_ACQUIRE, "agent");
      xb_add(&bar[XB_XGEN(bx)], 1u);
      asm volatile("s_waitcnt vmcnt(0)" ::: "memory");
    } else {
      XB_SPIN(xb_ld(&bar[XB_XGEN(bx)]) == gen, bar);
      __builtin_amdgcn_fence(__ATOMIC_ACQUIRE, "agent");
      asm volatile("s_waitcnt vmcnt(0)" ::: "memory");
    }
  }
  __syncthreads();
}

__device__ __forceinline__ void xcd_barrier(const XcdBarrier& b) { for (int r = 0; r < REP_BAR; ++r) xcd_barrier1(b); }

template <int SLP = 0>
__device__ __forceinline__ void phase_weights(const Params& p, int t_begin, int t_end, int blk, int nblk) {
  float* tl = (float*)smem;
  const int tid = opaque_tid();
  for (int w = t_begin + blk; w < t_end; w += nblk) {
    int f = 0;
#pragma unroll
    for (int i = 1; i < 11; ++i) if (w >= p.fam[i].tile_start) f = i;
    const TFam& F = p.fam[f];
    int loc = w - F.tile_start;
    int mat = loc / F.tiles_per_mat, tt = loc % F.tiles_per_mat;
    int ntn = F.Npad / 64;
    int k0 = (tt / ntn) * 64, n0 = (tt % ntn) * 64;
    const float* src = F.src + (long)mat * F.sstride;
    u16* dst = F.dst + (long)mat * F.dstride;
#pragma unroll
    for (int i = 0; i < 4; ++i) {
      int k = (tid >> 4) + 16 * i, n4 = (tid & 15) * 4;
      float4 v = make_float4(0.f, 0.f, 0.f, 0.f);
      if (n0 + n4 < F.N) v = *reinterpret_cast<const float4*>(src + (long)(k0 + k) * F.N + n0 + n4);
      tl[k * 65 + n4 + 0] = v.x; tl[k * 65 + n4 + 1] = v.y; tl[k * 65 + n4 + 2] = v.z; tl[k * 65 + n4 + 3] = v.w;
    }
    __syncthreads();
    {
      int n = tid >> 2, kq = (tid & 3) * 16;
      float v[16];
#pragma unroll
      for (int i = 0; i < 16; ++i) v[i] = tl[(kq + i) * 65 + n];
      u16* d = dst + (long)(n0 + n) * F.K + k0 + kq;
      st8(d, v); st8(d + 8, v + 8);
    }
    if (SLP) __builtin_amdgcn_s_sleep(SLP);
    __syncthreads();
  }
}

__device__ __forceinline__ void phase_mods_partial(const Params& p) {
  float* sl = (float*)smem;
  const int tid = opaque_tid();
  for (int it = VBID; it < 384; it += NVB) {
    int ks = it / 48, cb = it % 48;
    int o = cb * 256 + tid;
    int layer = o / 6144, col = o % 6144;
    __syncthreads();
    if (tid < 128) {
      int k = ks * 128 + tid;
      sl[tid] = siluf_(p.c[k]); sl[128 + tid] = siluf_(p.c[1024 + k]); sl[256 + tid] = siluf_(p.c_ctx[k]);
    }
    __syncthreads();
    const float* w = p.ada_w + (long)layer * 1024 * 6144 + (long)(ks * 128) * 6144 + col;
    float s0 = 0.f, s1 = 0.f, s2 = 0.f;
#pragma unroll 8
    for (int k = 0; k < 128; ++k) {
      float wv = w[(long)k * 6144];
      s0 += sl[k] * wv; s1 += sl[128 + k] * wv; s2 += sl[256 + k] * wv;
    }
    float* dst = p.modpart + ((long)(ks * 2 + layer) * 3) * 6144 + col;
    dst[0] = s0; dst[6144] = s1; dst[2 * 6144] = s2;
  }
  __syncthreads();
}

__device__ __forceinline__ void phase_mods_reduce(const Params& p) {
  for (int o = VBID * NTH + (int)(threadIdx.x & 255); o < 2 * 3 * 6144; o += NVB * NTH) {
    int layer = o / (3 * 6144), rem = o % (3 * 6144), col = rem % 6144;
    float s = p.ada_b[layer * 6144 + col];
#pragma unroll
    for (int ks = 0; ks < 8; ++ks) s += p.modpart[(long)(ks * 2 + layer) * 3 * 6144 + rem];
    p.mods[o] = s;
  }
}

__device__ __forceinline__ const float* modp(const Params& p, int layer, int mrow, int which) {
  return p.mods + ((long)(layer * 3 + mrow) * 6 + which) * 1024;
}

__device__ __forceinline__ void phase_norm_in(const Params& p, int layer, bool first) {
  const int tid_ = opaque_tid(); const int lane = tid_ & 63, wid = tid_ >> 6;
  const float* g = p.norm_g + (long)(layer * 4 + 0) * 1024;
  for (int row = VBID * 4 + wid; row < T; row += NVB * 4) {
    int b = row / PB, pp = row % PB, mrow = pp < CTXL ? 2 : b;
    const float* src;
    if (first) src = pp < CTXL ? p.ctx + ((long)b * CTXL + pp) * D : p.x + ((long)b * SEQ + (pp - CTXL)) * D;
    else src = (const float*)p.xs + (long)row * D;
    float4 v[4];
    float ss = 0.f;
#pragma unroll
    for (int i = 0; i < 4; ++i) {
      v[i] = reinterpret_cast<const float4*>(src)[i * 64 + lane];
      ss += v[i].x * v[i].x + v[i].y * v[i].y + v[i].z * v[i].z + v[i].w * v[i].w;
    }
    ss = wave_sum(ss);
    float rstd = rsqrtf(ss * (1.0f / 1024.0f) + 1e-6f);
    const float* sh = modp(p, layer, mrow, 0);
    const float* sc = modp(p, layer, mrow, 1);
#pragma unroll
    for (int i = 0; i < 4; ++i) {
      int col = (i * 64 + lane) * 4;
      float4 gg = *reinterpret_cast<const float4*>(g + col);
      float4 s4 = *reinterpret_cast<const float4*>(sh + col);
      float4 c4 = *reinterpret_cast<const float4*>(sc + col);
      float h0 = v[i].x * rstd * gg.x * (1.f + c4.x) + s4.x;
      float h1 = v[i].y * rstd * gg.y * (1.f + c4.y) + s4.y;
      float h2 = v[i].z * rstd * gg.z * (1.f + c4.z) + s4.z;
      float h3 = v[i].w * rstd * gg.w * (1.f + c4.w) + s4.w;
      uint2 o; o.x = pack2(h0, h1); o.y = pack2(h2, h3);
      *reinterpret_cast<uint2*>(p.abuf + (long)row * D + col) = o;
    }
  }
}

#ifndef GP_DS
#define GP_DS 0
#endif
#ifndef GP_MFMA
#define GP_MFMA 0
#endif
__device__ __forceinline__ int swz4(int row) { return (0x78 >> (((row >> 2) & 3) * 2)) & 3; }
template <typename AMap, typename BMap>
__device__ __forceinline__ void gemm_tile(const u16* __restrict__ A, long lda, const u16* __restrict__ Bt, long ldb, int K,
                                          AMap amap, BMap bmap, f32x4 (&acc)[4][8]) {
  char* S = (char*)smem;
  const int tid = opaque_tid(), lane = tid & 63, fr = lane & 15, fq = lane >> 4;
  const int wid = __builtin_amdgcn_readfirstlane(tid >> 6), wr = wid >> 1, wc = wid & 1;
  const u16* pa[2];
  const u16* pb[4];
#pragma unroll
  for (int i = 0; i < 2; ++i) {
    const int q = i * 256 + tid, r = q >> 2, kc = (q & 3) ^ swz4(r);
    pa[i] = A + (long)amap(r) * lda + kc * 8;
  }
#pragma unroll
  for (int i = 0; i < 4; ++i) {
    const int q = i * 256 + tid, r = q >> 2, kc = (q & 3) ^ swz4(r);
    pb[i] = Bt + (long)bmap(r) * ldb + kc * 8;
  }
#pragma unroll
  for (int m = 0; m < 4; ++m)
#pragma unroll
    for (int n = 0; n < 8; ++n) acc[m][n] = f32x4{0.f, 0.f, 0.f, 0.f};
  const int nk = K / 32;
  int offA[4], offB[8];
#pragma unroll
  for (int m = 0; m < 4; ++m) { const int ra = wr * 64 + m * 16 + fr; offA[m] = ra * 64 + ((fq ^ swz4(ra)) << 4); }
#pragma unroll
  for (int n = 0; n < 8; ++n) { const int rb = wc * 128 + n * 16 + fr; offB[n] = 8192 + rb * 64 + ((fq ^ swz4(rb)) << 4); }
  __syncthreads();
#pragma unroll
  for (int t = 0; t < 2; ++t) {
    char* st = S + t * 24576;
#pragma unroll
    for (int i = 0; i < 2; ++i) __builtin_amdgcn_global_load_lds((const unsigned*)(pa[i] + t * 32), (LAS unsigned*)(st + (i * 256 + tid) * 16), 16, 0, 0);
#pragma unroll
    for (int i = 0; i < 4; ++i) __builtin_amdgcn_global_load_lds((const unsigned*)(pb[i] + t * 32), (LAS unsigned*)(st + 8192 + (i * 256 + tid) * 16), 16, 0, 0);
  }
  int cs = 0;
  for (int kt = 0; kt < nk; ++kt) {
    if (kt + 1 < nk) asm volatile("s_waitcnt vmcnt(6)" ::: "memory");
    else asm volatile("s_waitcnt vmcnt(0)" ::: "memory");
    __builtin_amdgcn_s_barrier();
    asm volatile("" ::: "memory");
    char* cur = S + cs * 24576;
    if (kt + 2 < nk) {
      int ns = cs + 2; if (ns >= 3) ns -= 3;
      char* nx = S + ns * 24576;
#pragma unroll
      for (int i = 0; i < 2; ++i) __builtin_amdgcn_global_load_lds((const unsigned*)(pa[i] + (kt + 2) * 32), (LAS unsigned*)(nx + (i * 256 + tid) * 16), 16, 0, 0);
#pragma unroll
      for (int i = 0; i < 4; ++i) __builtin_amdgcn_global_load_lds((const unsigned*)(pb[i] + (kt + 2) * 32), (LAS unsigned*)(nx + 8192 + (i * 256 + tid) * 16), 16, 0, 0);
    }
#if GP_NOBAR2
#endif
    bf16x8 af[4], bfr[8];
#pragma unroll
    for (int m = 0; m < 4; ++m) af[m] = *reinterpret_cast<const bf16x8*>(cur + offA[m]);
#pragma unroll
    for (int n = 0; n < 8; ++n) bfr[n] = *reinterpret_cast<const bf16x8*>(cur + offB[n]);
#if GP_DS
    {
      bf16x8 t2[4];
#pragma unroll
      for (int rr = 0; rr < 3; ++rr) {
#pragma unroll
        for (int m = 0; m < 4; ++m) t2[m] = *reinterpret_cast<const volatile bf16x8*>(cur + offB[m + (rr & 1) * 4]);
#pragma unroll
        for (int m = 0; m < 4; ++m) asm volatile("" :: "v"(t2[m]));
      }
    }
#endif
#pragma unroll
    for (int m = 0; m < 4; ++m)
#pragma unroll
      for (int n = 0; n < 8; ++n) acc[m][n] = MFMA16(bfr[n], af[m], acc[m][n]);
#if GP_MFMA
    {
      f32x4 d2[8];
#pragma unroll
      for (int n = 0; n < 8; ++n) d2[n] = f32x4{0.f, 0.f, 0.f, 0.f};
#pragma unroll
      for (int m = 0; m < 4; ++m)
#pragma unroll
        for (int n = 0; n < 8; ++n) d2[n] = MFMA16(bfr[n], af[m], d2[n]);
#pragma unroll
      for (int n = 0; n < 8; ++n) asm volatile("" :: "v"(d2[n]));
    }
#endif
    cs = cs + 1; if (cs >= 3) cs = 0;
  }
  __syncthreads();
}
#ifndef RP_A
#define RP_A 1
#endif
#ifndef RP_B
#define RP_B 1
#endif
#ifndef RP_C
#define RP_C 1
#endif
#ifndef RP_D
#define RP_D 1
#endif
template <int KK, int NT>
__device__ __forceinline__ void mm_strip(const u16* A, int lda, int arow0, const u16* Bt, int ldb, int brow0, f32x4* acc, int lane) {
  const int fr = lane & 15, fq = lane >> 4;
#pragma unroll
  for (int ks = 0; ks < KK / 32; ++ks) {
    bf16x8 a = *reinterpret_cast<const bf16x8*>(A + (arow0 + fr) * lda + ks * 32 + fq * 8);
#pragma unroll
    for (int nt = 0; nt < NT; ++nt) {
      bf16x8 b = *reinterpret_cast<const bf16x8*>(Bt + (brow0 + nt * 16 + fr) * ldb + ks * 32 + fq * 8);
      acc[nt] = MFMA16(a, b, acc[nt]);
    }
  }
}

template <int t>
__device__ __forceinline__ void solve_load_row(uint4 (&r)[8], const u16* Ls) {
  constexpr int nb = ((t + 1) / 2 + 3) / 4;
#pragma unroll
  for (int q = 0; q < nb; ++q) r[q] = *reinterpret_cast<const uint4*>(Ls + t * 72 + q * 8);
}
template <int t, bool IDENT>
__device__ __forceinline__ void solve_rows(float (&x)[64], unsigned (&xp)[32], const u16* Ls, int lane, uint4 (&r0)[8], uint4 (&r1)[8], uint4 (&r2)[8]) {
  if constexpr (t + 2 < 64) solve_load_row<t + 2>(r2, Ls);
  __builtin_amdgcn_sched_barrier(0);
  constexpr int npair = (t + 1) / 2, nb = (npair + 3) / 4;
  float sa[2] = {0.f, 0.f};
#pragma unroll
  for (int q = 0; q < nb; ++q) {
    const unsigned w[4] = {r0[q].x, r0[q].y, r0[q].z, r0[q].w};
#pragma unroll
    for (int e = 0; e < 4; ++e)
      if (q * 4 + e < npair) sa[e & 1] = dot2bf(w[e], xp[q * 4 + e], sa[e & 1]);
  }
  const float xt = (IDENT ? (lane == t ? 1.f : 0.f) : x[t]) - (sa[0] + sa[1]);
  x[t] = xt;
  if constexpr (t & 1) xp[t >> 1] = pack2(x[t - 1], xt);
  else xp[t >> 1] = pack2(xt, 0.f);
  if constexpr (t + 1 < 64) solve_rows<t + 1, IDENT>(x, xp, Ls, lane, r1, r2, r0);
}
template <bool IDENT = false>
__device__ __forceinline__ void fwd_solve64(float (&x)[64], const u16* Ls, u16* dst, int lane = 0) {
  unsigned xp[32];
  uint4 r0[8], r1[8], r2[8];
  solve_load_row<1>(r0, Ls);
  solve_load_row<2>(r1, Ls);
  if (IDENT) x[0] = (lane == 0) ? 1.f : 0.f;
  xp[0] = pack2(x[0], 0.f);
  solve_rows<1, IDENT>(x, xp, Ls, lane, r0, r1, r2);
#pragma unroll
  for (int q = 0; q < 8; ++q) {
    uint4 o;
    o.x = xp[4 * q + 0] ^ 0x80008000u; o.y = xp[4 * q + 1] ^ 0x80008000u;
    o.z = xp[4 * q + 2] ^ 0x80008000u; o.w = xp[4 * q + 3] ^ 0x80008000u;
    *reinterpret_cast<uint4*>(dst + 8 * q) = o;
  }
}

__device__ __forceinline__ void load_mixed8(const u16* pz, bool hp, bool hn, const float* m0, float* out) {
  float c[8], pv[8], nx[8];
  ld8(pz, c);
  if (hp) ld8(pz - AB_IN, pv);
  else {
#pragma unroll
    for (int e = 0; e < 8; ++e) pv[e] = 0.f;
  }
  if (hn) ld8(pz + AB_IN, nx);
  else {
#pragma unroll
    for (int e = 0; e < 8; ++e) nx[e] = 0.f;
  }
  const float4 a0 = *reinterpret_cast<const float4*>(m0), a1 = *reinterpret_cast<const float4*>(m0 + 4);
  const float4 b0 = *reinterpret_cast<const float4*>(m0 + RWKV_IN), b1 = *reinterpret_cast<const float4*>(m0 + RWKV_IN + 4);
  const float ma[8] = {a0.x, a0.y, a0.z, a0.w, a1.x, a1.y, a1.z, a1.w};
  const float mb[8] = {b0.x, b0.y, b0.z, b0.w, b1.x, b1.y, b1.z, b1.w};
#pragma unroll
  for (int e = 0; e < 8; ++e) out[e] = c[e] + ma[e] * (pv[e] - c[e]) + mb[e] * (nx[e] - c[e]);
}
__device__ __forceinline__ void load_mixed16(const u16* zb, long row, int pp, int col, const float* mu, float* out) {
  const u16* pz = zb + row * AB_IN + col;
  const bool hp = !(pp == 0 || pp == CTXL), hn = !(pp == CTXL - 1 || pp == PB - 1);
  load_mixed8(pz, hp, hn, mu + (col - 256), out);
  __builtin_amdgcn_sched_barrier(0);
  load_mixed8(pz + 8, hp, hn, mu + (col - 256) + 8, out + 8);
  __builtin_amdgcn_sched_barrier(0);
}

template <int DIR>
__device__ __forceinline__ void load_mixed_2x8(const u16* zb, int b, int c, int rp, int col, const float* mu, float (&out)[2][8]) {
  const int tmin = DIR ? 62 - 2 * rp : 2 * rp;
  const int pp0 = c * 64 + tmin;
  const int seg_lo = (c < 4) ? 0 : CTXL, seg_hi = (c < 4) ? CTXL : PB;
  const u16* pz = zb + ((long)b * PB + pp0) * AB_IN + col;
  float zr[4][8];
#pragma unroll
  for (int j = 0; j < 4; ++j) {
    const int pt = pp0 - 1 + j;
    if (pt >= seg_lo && pt < seg_hi) ld8(pz + (long)(j - 1) * AB_IN, zr[j]);
    else {
#pragma unroll
      for (int e = 0; e < 8; ++e) zr[j][e] = 0.f;
    }
  }
  const float* m0 = mu + (col - 256);
  const float4 a0 = *reinterpret_cast<const float4*>(m0), a1 = *reinterpret_cast<const float4*>(m0 + 4);
  const float4 b0 = *reinterpret_cast<const float4*>(m0 + RWKV_IN), b1 = *reinterpret_cast<const float4*>(m0 + RWKV_IN + 4);
  const float ma[8] = {a0.x, a0.y, a0.z, a0.w, a1.x, a1.y, a1.z, a1.w};
  const float mb[8] = {b0.x, b0.y, b0.z, b0.w, b1.x, b1.y, b1.z, b1.w};
#pragma unroll
  for (int r = 0; r < 2; ++r) {
    const int to = DIR ? 1 - r : r;
#pragma unroll
    for (int e = 0; e < 8; ++e) {
      const float cc = zr[to + 1][e];
      out[r][e] = cc + ma[e] * (zr[to][e] - cc) + mb[e] * (zr[to + 2][e] - cc);
    }
  }
}

using u32x4 = __attribute__((ext_vector_type(4))) unsigned;
__device__ __forceinline__ void load_raw4(const char* ub, unsigned loff, int c, int tmin, u32x4 (&raw)[4]) {
  const int pp0 = c * 64 + tmin;
  const int seg_lo = (c < 4) ? 0 : CTXL, seg_hi = (c < 4) ? CTXL : PB;
#pragma unroll
  for (int j = 0; j < 4; ++j) {
    const int pt = pp0 - 1 + j;
    if (pt >= seg_lo && pt < seg_hi) raw[j] = *reinterpret_cast<const u32x4*>(ub + (long)(j - 1) * (AB_IN * 2) + loff);
    else raw[j] = u32x4{0u, 0u, 0u, 0u};
  }
}
template <int DIR>
__device__ __forceinline__ void mix_raw_2x8(const u32x4 (&raw)[4], int col, const float* mu, float (&out)[2][8]) {
  float zr[4][8];
#pragma unroll
  for (int j = 0; j < 4; ++j) {
#pragma unroll
    for (int q = 0; q < 4; ++q) { zr[j][2 * q] = __uint_as_float(raw[j][q] << 16); zr[j][2 * q + 1] = __uint_as_float(raw[j][q] & 0xffff0000u); }
  }
  const float* m0 = mu + (col - 256);
  const float4 a0 = *reinterpret_cast<const float4*>(m0), a1 = *reinterpret_cast<const float4*>(m0 + 4);
  const float4 b0 = *reinterpret_cast<const float4*>(m0 + RWKV_IN), b1 = *reinterpret_cast<const float4*>(m0 + RWKV_IN + 4);
  const float ma[8] = {a0.x, a0.y, a0.z, a0.w, a1.x, a1.y, a1.z, a1.w};
  const float mb[8] = {b0.x, b0.y, b0.z, b0.w, b1.x, b1.y, b1.z, b1.w};
#pragma unroll
  for (int r = 0; r < 2; ++r) {
    const int to = DIR ? 1 - r : r;
#pragma unroll
    for (int e = 0; e < 8; ++e) {
      const float cc = zr[to + 1][e];
      out[r][e] = cc + ma[e] * (zr[to][e] - cc) + mb[e] * (zr[to + 2][e] - cc);
    }
  }
}

#ifndef RW_LATE
#define RW_LATE 1
#endif
#ifndef RW_R0
#define RW_R0 22
#endif
#ifndef RW_CUT
#define RW_CUT 230
#endif
constexpr int RW_N0_ = RW_LATE ? RW_R0 * 512 : NB * NCH * 12 * 2;
template <int DIR, bool LATEPART>
__device__ __forceinline__ void rwkv_prep_all(const Params& p) {
  constexpr int RWN_ = NB * NCH * 12 * 2;
  const int it_first = LATEPART ? RW_N0_ + VBID - 96 : VBID, it_end = LATEPART ? RWN_ : RW_N0_, it_stride = LATEPART ? NVB - 96 : NVB;
  const u16* z = p.zbuf;
  const float* mu = p.ab_mu;
  u32x4 rwd[4], rad[4], rk[4], rr[4], rv[4], swv[2], sav[2];
#define RWKV_ZB(B_, C_, COL) ((const char*)(z + ((long)(B_) * PB + (C_) * 64) * AB_IN + (COL)))
#define RWKV_ISSUE(IT, TID) do { int r_ = (IT) >> 1; const int h_ = r_ % 12; r_ /= 12; const int b_ = r_ % NB, o_ = r_ / NB; \
    const int c_ = DIR ? (o_ < 4 ? 3 - o_ : 263 - o_) : o_; \
    const int rp_ = (TID) >> 3, tmin_ = DIR ? 62 - 2 * rp_ : 2 * rp_; \
    const unsigned zoff_ = (unsigned)(tmin_ * AB_IN + ((TID) & 7) * 8) * 2u, woff_ = (unsigned)(((TID) >> 2) * 64 + ((TID) & 3) * 16) * 2u; \
    load_raw4(RWKV_ZB(b_, c_, 2688 + DIR * 64), zoff_, c_, tmin_, rwd); \
    load_raw4(RWKV_ZB(b_, c_, 2816 + DIR * 64), zoff_, c_, tmin_, rad); \
    const char* sw_ = (const char*)(p.WupT + ((long)DIR * 768 + 64 * h_) * 64); \
    const char* sa_ = (const char*)(p.AupT + ((long)DIR * 768 + 64 * h_) * 64); \
    swv[0] = *reinterpret_cast<const u32x4*>(sw_ + woff_); swv[1] = *reinterpret_cast<const u32x4*>(sw_ + 16 + woff_); \
    sav[0] = *reinterpret_cast<const u32x4*>(sa_ + woff_); sav[1] = *reinterpret_cast<const u32x4*>(sa_ + 16 + woff_); } while (0)
  { const int tid0 = opaque_tid(); RWKV_ISSUE(min(it_first, it_end - 2), tid0); }
#pragma unroll 1
  for (int it = it_first; it < it_end; it += it_stride) {
  u16* buf[8];
#pragma unroll
  for (int i = 0; i < 8; ++i) buf[i] = (u16*)(smem + i * MB);
  float* LW = (float*)(smem + 5 * MB);
  u16* AA = buf[7];
  float* gC = (float*)(smem + 8 * MB);
  const int tid = opaque_tid(), lane = tid & 63, wid = tid >> 6, fr = lane & 15, fq = lane >> 4;
  const int i = tid >> 2, sub = tid & 3, cj = sub * 16;
  const int cg8 = (tid & 7) * 8, rp = tid >> 3;
  const int tmin = DIR ? 62 - 2 * rp : 2 * rp;
  const unsigned zoff = (unsigned)(tmin * AB_IN + cg8) * 2u;
  int b, c, h;
  { int r_ = it >> 1; h = r_ % 12; r_ /= 12; b = r_ % NB; const int o_ = r_ / NB; c = DIR ? (o_ < 4 ? 3 - o_ : 263 - o_) : o_; }
  load_raw4(RWKV_ZB(b, c, 1024 + 64 * h), zoff, c, tmin, rk);
  load_raw4(RWKV_ZB(b, c, 256 + 64 * h), zoff, c, tmin, rr);
  load_raw4(RWKV_ZB(b, c, 1792 + 64 * h), zoff, c, tmin, rv);
  {
    {
      const int cg = cg8;
      float wd[2][8], ad[2][8];
      mix_raw_2x8<DIR>(rwd, 2688 + DIR * 64 + cg, mu, wd);
      mix_raw_2x8<DIR>(rad, 2816 + DIR * 64 + cg, mu, ad);
#pragma unroll
      for (int r = 0; r < 2; ++r) {
#pragma unroll
        for (int e = 0; e < 8; ++e) wd[r][e] = tanhf_(wd[r][e]);
        st8(buf[0] + (2 * rp + r) * 72 + cg, wd[r]);
        st8(buf[1] + (2 * rp + r) * 72 + cg, ad[r]);
      }
    }
    *reinterpret_cast<u32x4*>(buf[2] + i * 72 + cj) = swv[0];
    *reinterpret_cast<u32x4*>(buf[2] + i * 72 + cj + 8) = swv[1];
    *reinterpret_cast<u32x4*>(buf[3] + i * 72 + cj) = sav[0];
    *reinterpret_cast<u32x4*>(buf[3] + i * 72 + cj + 8) = sav[1];
  }
  __syncthreads();
  {
    f32x4 aw[4], aa[4];
#pragma unroll
    for (int n = 0; n < 4; ++n) { aw[n] = f32x4{0.f, 0.f, 0.f, 0.f}; aa[n] = f32x4{0.f, 0.f, 0.f, 0.f}; }
    mm_strip<64, 4>(buf[0], 72, 16 * wid, buf[2], 72, 0, aw, lane);
    mm_strip<64, 4>(buf[1], 72, 16 * wid, buf[3], 72, 0, aa, lane);
    float* stot = gC + 64;
    float cum[4][4];
#pragma unroll
    for (int nt = 0; nt < 4; ++nt) {
      const int col = 16 * nt + fr, ch = 64 * h + col;
      const float w0v = p.rwkv_w0[DIR * 768 + ch], a0v = p.rwkv_a0[DIR * 768 + ch];
      float run = 0.f;
#pragma unroll
      for (int j = 0; j < 4; ++j) {
        const int t = 16 * wid + 4 * fq + j;
        const float xw = w0v + aw[nt][j];
        const float wlog = -softplusf_(-xw) - 0.5f;
        run += -__expf(wlog);
        cum[nt][j] = run;
        AA[t * 72 + col] = f2bf(sigmoidf_(a0v + aa[nt][j]));
      }
      const float s1 = __shfl_up(run, 16), s2 = __shfl_up(run, 32), s3 = __shfl_up(run, 48);
      const float excl = (fq >= 1 ? s1 : 0.f) + (fq >= 2 ? s2 : 0.f) + (fq >= 3 ? s3 : 0.f);
#pragma unroll
      for (int j = 0; j < 4; ++j) cum[nt][j] += excl;
      if (fq == 3) stot[wid * 64 + col] = cum[nt][3];
    }
    __syncthreads();
#pragma unroll
    for (int nt = 0; nt < 4; ++nt) {
      const int col = 16 * nt + fr;
      float off = 0.f;
#pragma unroll
      for (int w2 = 0; w2 < 3; ++w2) off += (w2 < wid) ? stot[w2 * 64 + col] : 0.f;
#pragma unroll
      for (int j = 0; j < 4; ++j) LW[(16 * wid + 4 * fq + j) * 65 + col] = cum[nt][j] + off;
      if (wid == 3 && fq == 3) gC[col] = __expf(cum[nt][3] + off);
    }
  }
  __syncthreads();
  {
    const int cg = cg8;
    float k8[2][8], Lg[2][8];
    mix_raw_2x8<DIR>(rk, 1024 + 64 * h + cg, mu, k8);
#pragma unroll
    for (int r = 0; r < 2; ++r) {
      const int ii = 2 * rp + r;
      float kk[8], ss = 0.f;
#pragma unroll
      for (int e = 0; e < 8; ++e) { kk[e] = k8[r][e] * p.rwkv_k_k[64 * h + cg + e]; ss += kk[e] * kk[e]; }
      ss += __shfl_xor(ss, 1); ss += __shfl_xor(ss, 2); ss += __shfl_xor(ss, 4);
      const float inv = rsqrtf(ss + 1e-6f);
      float Ah[8], Bh[8], Kh[8];
#pragma unroll
      for (int e = 0; e < 8; ++e) {
        const int col = cg + e;
        Lg[r][e] = LW[ii * 65 + col];
        const float Lgm1 = ii > 0 ? LW[(ii - 1) * 65 + col] : 0.f;
        const float a = bf2f(AA[ii * 72 + col]);
        const float kkn = kk[e] * inv;
        const float einv = __expf(-Lg[r][e]);
        const float kt = k8[r][e] * (1.f + (a - 1.f) * p.rwkv_k_a[64 * h + col]);
        Ah[e] = __expf(Lgm1) * kkn;
        Bh[e] = kkn * a * einv;
        Kh[e] = kt * einv;
      }
      st8(buf[0] + ii * 72 + cg, Ah);
      st8(buf[1] + ii * 72 + cg, Bh);
      st8(buf[2] + ii * 72 + cg, Kh);
    }
    __builtin_amdgcn_sched_barrier(0);
    {
      float r8[2][8];
      mix_raw_2x8<DIR>(rr, 256 + 64 * h + cg, mu, r8);
#pragma unroll
      for (int r = 0; r < 2; ++r) {
#pragma unroll
        for (int e = 0; e < 8; ++e) r8[r][e] *= __expf(Lg[r][e]);
        st8(buf[3] + (2 * rp + r) * 72 + cg, r8[r]);
      }
    }
    __builtin_amdgcn_sched_barrier(0);
    {
      float v8[2][8];
      mix_raw_2x8<DIR>(rv, 1792 + 64 * h + cg, mu, v8);
#pragma unroll
      for (int r = 0; r < 2; ++r)
#pragma unroll
        for (int e = 0; e < 8; ++e) buf[4][(cg + e) * 72 + 2 * rp + r] = f2bf(v8[r][e]);
    }
  }
  __syncthreads();
  {
    f32x4 a1[4], a2[4];
#pragma unroll
    for (int n = 0; n < 4; ++n) { a1[n] = f32x4{0.f, 0.f, 0.f, 0.f}; a2[n] = f32x4{0.f, 0.f, 0.f, 0.f}; }
    mm_strip<64, 4>(buf[0], 72, 16 * wid, buf[1], 72, 0, a1, lane);
    mm_strip<64, 4>(buf[0], 72, 16 * wid, buf[2], 72, 0, a2, lane);
#pragma unroll
    for (int nt = 0; nt < 4; ++nt)
#pragma unroll
      for (int j = 0; j < 4; ++j) {
        int t = 16 * wid + 4 * fq + j, s = 16 * nt + fr;
        buf[5][t * 72 + s] = f2bf(s < t ? a1[nt][j] : 0.f);
        buf[6][t * 72 + s] = f2bf(s < t ? a2[nt][j] : 0.f);
      }
  }
  __syncthreads();
  {
    f32x4 a1[4];
#pragma unroll
    for (int n = 0; n < 4; ++n) a1[n] = f32x4{0.f, 0.f, 0.f, 0.f};
    mm_strip<64, 4>(buf[6], 72, 16 * wid, buf[4], 72, 0, a1, lane);
#pragma unroll
    for (int nt = 0; nt < 4; ++nt)
#pragma unroll
      for (int j = 0; j < 4; ++j) {
        int t = 16 * wid + 4 * fq + j, v = 16 * nt + fr;
        buf[7][v * 72 + t] = f2bf(a1[nt][j]);
      }
  }
  __syncthreads();
  {
    const int st = tid ^ (half_id() << 7);
    const int iw = (st >> 6) - 2;
    unsigned bgp[8], kgp[8];
    {
      float xr[64];
      if (st < 64) {
#pragma unroll
        for (int t = 0; t < 64; ++t) xr[t] = bf2f(buf[0][t * 72 + st]);
      } else if (st < 128) {
#pragma unroll
        for (int t = 0; t < 64; t += 8) ld8(buf[7] + (st - 64) * 72 + t, xr + t);
      }
      __syncthreads();
      if (st < 128) {
        u16* dst = st < 64 ? buf[0] + st * 72 : buf[7] + (st - 64) * 72;
        fwd_solve64(xr, buf[5], dst);
      } else {
#pragma unroll
        for (int s2 = 0; s2 < 2; ++s2) {
          f32x4 a2[4];
#pragma unroll
          for (int n = 0; n < 4; ++n) a2[n] = f32x4{0.f, 0.f, 0.f, 0.f};
          mm_strip<64, 4>(buf[3], 72, 16 * (2 * iw + s2), buf[1], 72, 0, a2, lane);
#pragma unroll
          for (int nt = 0; nt < 4; ++nt) {
            const int s = 16 * nt + fr, t0 = 16 * (2 * iw + s2) + 4 * fq;
#pragma unroll
            for (int j = 0; j < 4; ++j) buf[6][(t0 + j) * 72 + s] = f2bf(s <= t0 + j ? a2[nt][j] : 0.f);
          }
        }
      }
    }
    {
      float bs[16], ks_[16];
      ld8(buf[1] + i * 72 + cj, bs); ld8(buf[1] + i * 72 + cj + 8, bs + 8);
      ld8(buf[2] + i * 72 + cj, ks_); ld8(buf[2] + i * 72 + cj + 8, ks_ + 8);
#pragma unroll
      for (int e = 0; e < 8; ++e) {
        float g0 = gC[cj + 2 * e], g1 = gC[cj + 2 * e + 1];
        bgp[e] = pack2(bs[2 * e] * g0, bs[2 * e + 1] * g1);
        kgp[e] = pack2(ks_[2 * e] * g0, ks_[2 * e + 1] * g1);
      }
    }
    { const int tidn = opaque_tid(); RWKV_ISSUE((it + it_stride < it_end ? it + it_stride : it), tidn); }
    f32x4 a1[4];
#pragma unroll
    for (int n = 0; n < 4; ++n) a1[n] = f32x4{0.f, 0.f, 0.f, 0.f};
    mm_strip<64, 4>(buf[3], 72, 16 * wid, buf[2], 72, 0, a1, lane);
    __syncthreads();
#pragma unroll
    for (int nt = 0; nt < 4; ++nt)
#pragma unroll
      for (int j = 0; j < 4; ++j) {
        int t = 16 * wid + 4 * fq + j, s = 16 * nt + fr;
        buf[5][t * 72 + s] = f2bf(s <= t ? a1[nt][j] : 0.f);
      }
#pragma unroll
    for (int e = 0; e < 8; ++e) {
      buf[1][(cj + 2 * e) * 72 + i] = (u16)(bgp[e] & 0xffffu);
      buf[1][(cj + 2 * e + 1) * 72 + i] = (u16)(bgp[e] >> 16);
      buf[2][(cj + 2 * e) * 72 + i] = (u16)(kgp[e] & 0xffffu);
      buf[2][(cj + 2 * e + 1) * 72 + i] = (u16)(kgp[e] >> 16);
    }
  }
  __syncthreads();
  {
    u16* outp = p.prep + ((long)((b * 12 + h) * 2 + DIR) * NCH + c) * RW_ITEM;
    const int pq = wid & 1, ntp = (wid >> 1) * 2;
#pragma unroll
    for (int nn = 0; nn < 2; ++nn) {
      const int nt = ntp + nn;
      f32x4 m0 = f32x4{0.f, 0.f, 0.f, 0.f}, m1 = m0, q0 = m0, q1 = m0;
      mm_strip<64, 1>(buf[0], 72, 16 * (2 * pq), buf[1], 72, 16 * nt, &m0, lane);
      mm_strip<64, 1>(buf[0], 72, 16 * (2 * pq + 1), buf[1], 72, 16 * nt, &m1, lane);
      mm_strip<64, 1>(buf[0], 72, 16 * (2 * pq), buf[6], 72, 16 * nt, &q0, lane);
      mm_strip<64, 1>(buf[0], 72, 16 * (2 * pq + 1), buf[6], 72, 16 * nt, &q1, lane);
      float o[8], oq[8];
#pragma unroll
      for (int j = 0; j < 4; ++j) {
        int k0 = 16 * (2 * pq) + 4 * fq + j, k1 = k0 + 16, kp = 16 * nt + fr;
        o[j] = m0[j] + (k0 == kp ? gC[kp] : 0.f);
        o[4 + j] = m1[j] + (k1 == kp ? gC[kp] : 0.f);
        oq[j] = q0[j] + bf2f(buf[3][kp * 72 + k0]);
        oq[4 + j] = q1[j] + bf2f(buf[3][kp * 72 + k1]);
      }
      st8(outp + ((nt * 2 + pq) * 64 + lane) * 8, o);
      st8(outp + (((4 + nt) * 2 + pq) * 64 + lane) * 8, oq);
    }
    f32x4 an[4], ay[4];
#pragma unroll
    for (int n = 0; n < 4; ++n) { an[n] = f32x4{0.f, 0.f, 0.f, 0.f}; ay[n] = f32x4{0.f, 0.f, 0.f, 0.f}; }
    mm_strip<64, 4>(buf[2], 72, 16 * wid, buf[4], 72, 0, an, lane);
    mm_strip<64, 4>(buf[1], 72, 16 * wid, buf[7], 72, 0, an, lane);
    mm_strip<64, 4>(buf[5], 72, 16 * wid, buf[4], 72, 0, ay, lane);
    mm_strip<64, 4>(buf[6], 72, 16 * wid, buf[7], 72, 0, ay, lane);
#pragma unroll
    for (int nt = 0; nt < 4; ++nt) {
      uint2 o1, o2;
      o1.x = pack2(an[nt][0], an[nt][1]); o1.y = pack2(an[nt][2], an[nt][3]);
      o2.x = pack2(ay[nt][0], ay[nt][1]); o2.y = pack2(ay[nt][2], ay[nt][3]);
      *reinterpret_cast<uint2*>(outp + 8192 + ((wid * 4 + nt) * 64 + lane) * 4) = o1;
      *reinterpret_cast<uint2*>(outp + 8192 + (((4 + wid) * 4 + nt) * 64 + lane) * 4) = o2;
    }
  }
  __syncthreads();
  }
#undef RWKV_ISSUE
#undef RWKV_ZB
}

__device__ __forceinline__ void pool_item(const Params& p, int b, int rb, int g) {
  float* vs = (float*)smem;
  u16* As = (u16*)(smem + 16640);
  u16* Bs = (u16*)(smem + 16640 + MB);
  const int tid = opaque_tid(), lane = tid & 63, wid = tid >> 6, fr = lane & 15, fq = lane >> 4;
  const int w = 2 << g, hw = w >> 1;
  const u16* z = p.zbuf;
  const bool isctx = rb >= 256;
  {
    int n = tid >> 2, part = (tid & 3) * 16;
    const u16* s = p.PoolT + ((long)g * 64 + n) * 64 + part;
    *reinterpret_cast<uint4*>(Bs + n * 72 + part) = *reinterpret_cast<const uint4*>(s);
    *reinterpret_cast<uint4*>(Bs + n * 72 + part + 8) = *reinterpret_cast<const uint4*>(s + 8);
  }
  const int cg = (tid & 7) * 8, cl = tid >> 3;
  if (!isctx) {
    const int r_lo = max(rb - hw, 0), r_hi = min(rb + hw, 256);
#pragma unroll
    for (int k = 0; k < 2; ++k) {
      const int col = cl + 32 * k;
      float a8[8];
#pragma unroll
      for (int e = 0; e < 8; ++e) a8[e] = 0.f;
      for (int rr = r_lo; rr < r_hi; ++rr) {
        float v8[8];
        ld8(z + ((long)b * PB + CTXL + rr * 64 + col) * AB_IN + g * 64 + cg, v8);
#pragma unroll
        for (int e = 0; e < 8; ++e) a8[e] += v8[e];
      }
#pragma unroll
      for (int e = 0; e < 8; ++e) vs[col * 65 + cg + e] = a8[e];
    }
    __syncthreads();
#pragma unroll
    for (int k = 0; k < 2; ++k) {
      const int col = cl + 32 * k;
      const int c_lo = max(col - hw, 0), c_hi = min(col + hw, 64);
      float a8[8], pg[8], o8[8];
#pragma unroll
      for (int e = 0; e < 8; ++e) a8[e] = 0.f;
      for (int cc = c_lo; cc < c_hi; ++cc) {
#pragma unroll
        for (int e = 0; e < 8; ++e) a8[e] += vs[cc * 65 + cg + e];
      }
      const float rc = __builtin_amdgcn_rcpf((float)((r_hi - r_lo) * (c_hi - c_lo)));
      ld8(z + ((long)b * PB + CTXL + rb * 64 + col) * AB_IN + g * 64 + cg, pg);
#pragma unroll
      for (int e = 0; e < 8; ++e) o8[e] = a8[e] * rc - pg[e];
      st8(As + col * 72 + cg, o8);
    }
  } else {
    const int t0 = (rb - 256) * 64;
#pragma unroll
    for (int k = 0; k < 2; ++k) {
      const int col = cl + 32 * k, t = t0 + col;
      const int lo = max(t - hw, 0), hi = min(t + hw, CTXL);
      float a8[8], pg[8], o8[8];
#pragma unroll
      for (int e = 0; e < 8; ++e) a8[e] = 0.f;
      for (int tt = lo; tt < hi; ++tt) {
        float v8[8];
        ld8(z + ((long)b * PB + tt) * AB_IN + g * 64 + cg, v8);
#pragma unroll
        for (int e = 0; e < 8; ++e) a8[e] += v8[e];
      }
      const float rc = __builtin_amdgcn_rcpf((float)(hi - lo));
      ld8(z + ((long)b * PB + t) * AB_IN + g * 64 + cg, pg);
#pragma unroll
      for (int e = 0; e < 8; ++e) o8[e] = a8[e] * rc - pg[e];
      st8(As + col * 72 + cg, o8);
    }
  }
  __syncthreads();
  {
    f32x4 acc[4];
#pragma unroll
    for (int n = 0; n < 4; ++n) acc[n] = f32x4{0.f, 0.f, 0.f, 0.f};
    mm_strip<64, 4>(As, 72, 16 * wid, Bs, 72, 0, acc, lane);
    long row0 = isctx ? (long)b * PB + (rb - 256) * 64 : (long)b * PB + CTXL + rb * 64;
#pragma unroll
    for (int nt = 0; nt < 4; ++nt)
#pragma unroll
      for (int j = 0; j < 4; ++j) {
        int t = 16 * wid + 4 * fq + j, n = 16 * nt + fr;
        p.abuf[(row0 + t) * D + g * 64 + n] = f2bf(acc[nt][j] * p.pool_scale[g * 64 + n]);
      }
  }
  __syncthreads();
}

__device__ __forceinline__ void rwkv_scan_block(const Params& p, int sid, int s_begin, int s_end) {
  const int tid = opaque_tid(), lane = tid & 63, fr = lane & 15, fq = lane >> 4;
  const int wv = __builtin_amdgcn_readfirstlane(tid >> 6);
  const int d = sid & 1, bh = sid >> 1, b = bh / 12, h = bh % 12;
  const char* base = (const char*)(p.prep + (long)sid * NCH * RW_ITEM);
  char* L = (char*)smem;
  const unsigned lo16 = lane * 16u, lo8 = lane * 8u;
  f32x4* stsave = (f32x4*)(smem_raw + 98304) + tid * 4;
  f32x4 st[4];
#pragma unroll
  for (int i = 0; i < 4; ++i) st[i] = s_begin > 0 ? stsave[i] : f32x4{0.f, 0.f, 0.f, 0.f};
  auto chunk_of = [&](int step) { step = min(step, NCH - 1); return d == 0 ? step : (step < 4 ? 3 - step : 263 - step); };
  bf16x8 Ar[5][4];
  uint2 Cr[5][8];
#pragma unroll
  for (int u = 0; u < 4; ++u) {
    const char* it = base + (long)chunk_of(s_begin + u) * (RW_ITEM * 2);
    const char* pa = it + (wv * 4) * 1024;
    const char* pc = it + 16384 + wv * 512;
#pragma unroll
    for (int i = 0; i < 4; ++i) Ar[u][i] = *reinterpret_cast<const bf16x8*>(pa + i * 1024 + lo16);
#pragma unroll
    for (int rt = 0; rt < 8; ++rt) Cr[u][rt] = *reinterpret_cast<const uint2*>(pc + rt * 2048 + lo8);
  }
  __syncthreads();
#pragma unroll 1
  for (int s0 = s_begin; s0 < s_end; s0 += 5) {
#pragma unroll
    for (int u = 0; u < 5; ++u) {
      const int step = s0 + u;
      {
        const char* it = base + (long)chunk_of(step + 4) * (RW_ITEM * 2);
        const char* pa = it + (wv * 4) * 1024;
        const char* pc = it + 16384 + wv * 512;
#pragma unroll
        for (int i = 0; i < 4; ++i) Ar[(u + 4) % 5][i] = *reinterpret_cast<const bf16x8*>(pa + i * 1024 + lo16);
#pragma unroll
        for (int rt = 0; rt < 8; ++rt) Cr[(u + 4) % 5][rt] = *reinterpret_cast<const uint2*>(pc + rt * 2048 + lo8);
      }
      char* Lb = L + (step & 1) * 16384;
#pragma unroll
      for (int i = 0; i < 4; ++i) *reinterpret_cast<bf16x8*>(Lb + (wv * 4 + i) * 1024 + lo16) = Ar[u][i];
      asm volatile("s_waitcnt lgkmcnt(0)" ::: "memory");
      __builtin_amdgcn_s_barrier();
      asm volatile("" ::: "memory");
      bf16x8 bfr[2];
#pragma unroll
      for (int ks = 0; ks < 2; ++ks) {
        union { bf16x8 v; unsigned w[4]; } cv;
        cv.w[0] = pack2(st[2 * ks][0], st[2 * ks][1]); cv.w[1] = pack2(st[2 * ks][2], st[2 * ks][3]);
        cv.w[2] = pack2(st[2 * ks + 1][0], st[2 * ks + 1][1]); cv.w[3] = pack2(st[2 * ks + 1][2], st[2 * ks + 1][3]);
        bfr[ks] = cv.v;
      }
      const int c = chunk_of(step);
      u16* Yb = (u16*)(smem_raw + 32768) + (step & 1) * 4608;
#pragma unroll
      for (int rt = 0; rt < 8; ++rt) {
        f32x4 acc;
        acc[0] = __uint_as_float(Cr[u][rt].x << 16); acc[1] = __uint_as_float(Cr[u][rt].x & 0xffff0000u);
        acc[2] = __uint_as_float(Cr[u][rt].y << 16); acc[3] = __uint_as_float(Cr[u][rt].y & 0xffff0000u);
        bf16x8 a0 = *reinterpret_cast<const bf16x8*>(Lb + (rt * 2 + 0) * 1024 + lo16);
        bf16x8 a1 = *reinterpret_cast<const bf16x8*>(Lb + (rt * 2 + 1) * 1024 + lo16);
        acc = MFMA16(a0, bfr[0], acc);
        acc = MFMA16(a1, bfr[1], acc);
        if (rt < 4) st[rt] = acc;
        else {
#pragma unroll
          for (int j = 0; j < 4; ++j) {
            int t = 16 * (rt - 4) + 4 * fq + j;
            Yb[t * 72 + wv * 16 + fr] = f2bf(acc[j]);
          }
        }
      }
      __builtin_amdgcn_sched_barrier(0);
    }
  }
  if (s_end < NCH) {
#pragma unroll
    for (int i = 0; i < 4; ++i) stsave[i] = st[i];
  }
  __syncthreads();
}

__device__ __forceinline__ void rwkv_scan_copy(const Params& p, int sid, int s_begin, int s_end) {
  const int tid = opaque_tid();
  const int d = sid & 1, bh = sid >> 1, b = bh / 12, h = bh % 12;
  u16* ybuf = d ? p.yb : p.yf;
  const int t = tid >> 2, seg = tid & 3;
  const int tau = d ? 63 - t : t;
  auto chunk_of = [&](int step) { return d == 0 ? step : (step < 4 ? 3 - step : 263 - step); };
  auto copy = [&](int step) {
    const u16* Yb = (const u16*)(smem_raw + 32768) + (step & 1) * 4608 + t * 72 + seg * 16;
    const uint4 v0 = *reinterpret_cast<const uint4*>(Yb), v1 = *reinterpret_cast<const uint4*>(Yb + 8);
    u16* dst = ybuf + ((long)b * PB + chunk_of(step) * 64 + tau) * D + h * 64 + seg * 16;
    *reinterpret_cast<uint4*>(dst) = v0; *reinterpret_cast<uint4*>(dst + 8) = v1;
  };
  __syncthreads();
#pragma unroll 1
  for (int s_ = s_begin; s_ < s_end; ++s_) {
    __builtin_amdgcn_s_barrier();
    asm volatile("" ::: "memory");
    if (s_ > s_begin) copy(s_ - 1);
  }
  __syncthreads();
  copy(s_end - 1);
}

__device__ __forceinline__ void rwkv_out_item(const Params& p, int b, int c, int h) {
  u16* Ag = (u16*)smem;
  u16* Bg = (u16*)(smem + 17408);
  float* G = (float*)(smem + 2 * 17408);
  const int tid = opaque_tid(), lane = tid & 63, wid = tid >> 6, fr = lane & 15, fq = lane >> 4;
  const u16* z = p.zbuf;
  const float* mu = p.ab_mu;
  {
    const int cg = (tid & 15) * 8;
#pragma unroll 1
    for (int q = 0; q < 2; ++q) {
      const int rp = (tid >> 4) + 16 * q;
      float gd[2][8];
      load_mixed_2x8<0>(z, b, c, rp, 2560 + cg, mu, gd);
#pragma unroll
      for (int r = 0; r < 2; ++r) {
#pragma unroll
        for (int e = 0; e < 8; ++e) gd[r][e] = sigmoidf_(gd[r][e]);
        st8(Ag + (2 * rp + r) * 136 + cg, gd[r]);
      }
    }
    const int i = tid >> 2, sub = tid & 3;
    const u16* s = p.GupT + ((long)(64 * h + i)) * 128 + sub * 32;
#pragma unroll
    for (int e = 0; e < 32; e += 8) *reinterpret_cast<uint4*>(Bg + i * 136 + sub * 32 + e) = *reinterpret_cast<const uint4*>(s + e);
  }
  __syncthreads();
  {
    f32x4 acc[4];
#pragma unroll
    for (int n = 0; n < 4; ++n) acc[n] = f32x4{0.f, 0.f, 0.f, 0.f};
    mm_strip<128, 4>(Ag, 136, 16 * wid, Bg, 136, 0, acc, lane);
#pragma unroll
    for (int nt = 0; nt < 4; ++nt)
#pragma unroll
      for (int j = 0; j < 4; ++j) G[(16 * wid + 4 * fq + j) * 65 + 16 * nt + fr] = acc[nt][j];
  }
  __syncthreads();
  {
    const int cg = (tid & 7) * 8, rp = tid >> 3;
    const int ch = 64 * h + cg;
    float r8[2][8], k8[2][8], v8[2][8];
    load_mixed_2x8<0>(z, b, c, rp, 256 + ch, mu, r8);
    load_mixed_2x8<0>(z, b, c, rp, 1024 + ch, mu, k8);
    load_mixed_2x8<0>(z, b, c, rp, 1792 + ch, mu, v8);
    float rkw[8], gw8[8], gb8[8];
#pragma unroll
    for (int e = 0; e < 8; ++e) { rkw[e] = p.rwkv_r_k[ch + e]; gw8[e] = p.rwkv_gn_w[ch + e]; gb8[e] = p.rwkv_gn_b[ch + e]; }
#pragma unroll
    for (int r = 0; r < 2; ++r) {
      const int ii = 2 * rp + r;
      const long row = (long)b * PB + c * 64 + ii;
      float yf[8], yb[8];
      ld8(p.yf + row * D + ch, yf);
      ld8(p.yb + row * D + ch, yb);
      float s1 = 0.f, s2 = 0.f, bs = 0.f;
#pragma unroll
      for (int e = 0; e < 8; ++e) { yf[e] += yb[e]; s1 += yf[e]; s2 += yf[e] * yf[e]; bs += r8[r][e] * k8[r][e] * rkw[e]; }
      s1 += __shfl_xor(s1, 1); s1 += __shfl_xor(s1, 2); s1 += __shfl_xor(s1, 4);
      s2 += __shfl_xor(s2, 1); s2 += __shfl_xor(s2, 2); s2 += __shfl_xor(s2, 4);
      bs += __shfl_xor(bs, 1); bs += __shfl_xor(bs, 2); bs += __shfl_xor(bs, 4);
      const float mean = s1 * (1.f / 64.f);
      const float var = fmaxf(s2 * (1.f / 64.f) - mean * mean, 0.f);
      const float rstd = rsqrtf(var + 64e-5f);
      float o[8];
#pragma unroll
      for (int e = 0; e < 8; ++e) {
        const float yn = (yf[e] - mean) * rstd;
        o[e] = (yn * gw8[e] + gb8[e] + bs * v8[r][e]) * G[ii * 65 + cg + e];
      }
      st8(p.abuf + row * D + 256 + ch, o);
    }
  }
  __syncthreads();
}
#ifndef GDN_LATE
#define GDN_LATE 100
#endif
constexpr int GDN_S0_ = NCH - GDN_LATE, GDN_N0_ = GDN_S0_ * NB * 8 * 2, GDN_N_ = NCH * NB * 8 * 2;
template <int DIR, bool LATEPART>
__device__ __forceinline__ void gdn_prep_all(const Params& p) {
  const int it_first = LATEPART ? GDN_N0_ + VBID - 128 : VBID, it_end = LATEPART ? GDN_N_ : GDN_N0_, it_stride = LATEPART ? NVB - 128 : NVB;
  u32x4 rawq[7];
#define GDN_ISSUEQ(IT, TID) do { int r_ = (IT) >> 1; const int h_ = r_ % 8; r_ /= 8; const int b_ = r_ % NB, o_ = r_ / NB; \
    const int c_ = DIR ? (o_ < 4 ? 3 - o_ : 263 - o_) : o_; \
    const int rg_ = (TID) >> 4, tmin_ = DIR ? 60 - 4 * rg_ : 4 * rg_, pp0_ = c_ * 64 + tmin_; \
    const int lo_ = (c_ < 4) ? 0 : CTXL, hi_ = (c_ < 4) ? CTXL : PB; \
    const unsigned zoff_ = (unsigned)(tmin_ * GDN_IN + ((TID) & 15) * 8) * 2u; \
    const char* ub_ = (const char*)(p.zbuf + ((long)b_ * PB + c_ * 64) * GDN_IN + 128 * h_); \
    _Pragma("unroll") for (int j = 0; j < 7; ++j) { const int pt_ = pp0_ - 2 + j; \
      if (pt_ >= lo_ && pt_ < hi_) rawq[j] = *reinterpret_cast<const u32x4*>(ub_ + (long)(j - 2) * (GDN_IN * 2) + zoff_); \
      else rawq[j] = u32x4{0u, 0u, 0u, 0u}; } } while (0)
  { const int tid0 = opaque_tid(); GDN_ISSUEQ(min(it_first, it_end - 2), tid0); }
#pragma unroll 1
  for (int it = it_first; it < it_end; it += it_stride) {
  int b, c, h;
  { int r_ = it >> 1; h = r_ % 8; r_ /= 8; b = r_ % NB; const int o_ = r_ / NB; c = DIR ? (o_ < 4 ? 3 - o_ : 263 - o_) : o_; }
  u16* R1 = (u16*)smem;
  u16* R2 = (u16*)(smem + 18432);
  u16* Ls = (u16*)(smem + 36864);
  u16* As = (u16*)(smem + 46080);
  u16* Ut = (u16*)(smem + 55296);
  float* gc = (float*)(smem + 73728);
  float* bb = gc + 64;
  float* fac = gc + 128;
  const int tid = opaque_tid(), lane = tid & 63, wid = tid >> 6, fr = lane & 15, fq = lane >> 4;
  const int i = tid >> 2, sub = tid & 3;
  const int seg_lo = (c < 4) ? 0 : CTXL, seg_hi = (c < 4) ? CTXL : PB;
  const u16* z = p.zbuf;
  const float* cw = p.gdn_conv;
  {
    const int cg = (tid & 15) * 8, rg = tid >> 4;
    const int tmin = DIR ? 60 - 4 * rg : 4 * rg;
    const int pp0 = c * 64 + tmin;
    const unsigned zoff = (unsigned)(tmin * GDN_IN + cg) * 2u, woff = (unsigned)cg * 4u, soff = (unsigned)(tmin * GDN_IN) * 2u;
    const char* zrow = (const char*)(z + ((long)b * PB + c * 64) * GDN_IN);
    u32x4 raw[3][7];
#pragma unroll
    for (int j = 0; j < 7; ++j) raw[0][j] = rawq[j];
#pragma unroll
    for (int which = 1; which < 3; ++which) {
      const char* ub = zrow + (which * 1024 + 128 * h) * 2;
#pragma unroll
      for (int j = 0; j < 7; ++j) {
        const int pt = pp0 - 2 + j;
        if (pt >= seg_lo && pt < seg_hi) raw[which][j] = *reinterpret_cast<const u32x4*>(ub + (long)(j - 2) * (GDN_IN * 2) + zoff);
        else raw[which][j] = u32x4{0u, 0u, 0u, 0u};
      }
    }
    u16 braw[4], zraw[4];
#pragma unroll
    for (int r = 0; r < 4; ++r) {
      const int to = DIR ? 3 - r : r;
      braw[r] = *reinterpret_cast<const u16*>(zrow + (long)to * (GDN_IN * 2) + (4096 + DIR * 8 + h) * 2 + soff);
      zraw[r] = *reinterpret_cast<const u16*>(zrow + (long)to * (GDN_IN * 2) + (4096 + (2 + DIR) * 8 + h) * 2 + soff);
    }
    f32x4 wv[3][8];
#define GDN_LDW(W) do { const char* wb_ = (const char*)(cw + (W) * 1024 + 128 * h); _Pragma("unroll") for (int tap = 0; tap < 4; ++tap) { \
      wv[W][2 * tap] = *reinterpret_cast<const f32x4*>(wb_ + tap * 12288 + woff); \
      wv[W][2 * tap + 1] = *reinterpret_cast<const f32x4*>(wb_ + tap * 12288 + 16 + woff); } } while (0)
    GDN_LDW(0); GDN_LDW(1);
    __builtin_amdgcn_sched_barrier(0);
    float beta4[4];
#pragma unroll
    for (int r = 0; r < 4; ++r) beta4[r] = sigmoidf_(bf2f(braw[r]));
#pragma unroll
    for (int which = 0; which < 3; ++which) {
      float zr[7][8];
#pragma unroll
      for (int j = 0; j < 7; ++j) {
#pragma unroll
        for (int q = 0; q < 4; ++q) { zr[j][2 * q] = __uint_as_float(raw[which][j][q] << 16); zr[j][2 * q + 1] = __uint_as_float(raw[which][j][q] & 0xffff0000u); }
      }
#pragma unroll
      for (int r = 0; r < 4; ++r) {
        const int to = DIR ? 3 - r : r;
        const int i = 4 * rg + r;
        float o[8], ss = 0.f;
#pragma unroll
        for (int e = 0; e < 8; ++e) {
          float a = zr[to][e] * wv[which][0 + (e >> 2)][e & 3] + zr[to + 1][e] * wv[which][2 + (e >> 2)][e & 3] +
                    zr[to + 2][e] * wv[which][4 + (e >> 2)][e & 3] + zr[to + 3][e] * wv[which][6 + (e >> 2)][e & 3];
          o[e] = siluf_(a); ss += o[e] * o[e];
        }
        if (which < 2) {
          ss += __shfl_xor(ss, 1); ss += __shfl_xor(ss, 2); ss += __shfl_xor(ss, 4); ss += __shfl_xor(ss, 8);
          const float sc = rsqrtf(ss + 1e-6f) * (which == 0 ? 0.08838834764831845f : 1.0f);
#pragma unroll
          for (int e = 0; e < 8; ++e) o[e] *= sc;
          st8((which == 0 ? R2 : R1) + i * 136 + cg, o);
        } else {
#pragma unroll
          for (int e = 0; e < 8; ++e) Ut[(cg + e) * 72 + 63 - i] = f2bf(o[e] * beta4[r]);
        }
      }
      __builtin_amdgcn_sched_barrier(0);
      if (which == 0) { GDN_LDW(2); }
    }
#undef GDN_LDW
    if ((tid & 15) == 0) {
#pragma unroll
      for (int r = 0; r < 4; ++r) {
        const int i = 4 * rg + r;
        float za = bf2f(zraw[r]);
        bb[i] = beta4[r];
        gc[i] = -__expf(p.gdn_a_log[DIR * 8 + h]) * softplusf_(za + p.gdn_dt_bias[DIR * 8 + h]);
      }
    }
  }
  __syncthreads();
  if (wid == 0) {
    float v = gc[lane];
#pragma unroll
    for (int o = 1; o < 64; o <<= 1) { float u = __shfl_up(v, o); if (lane >= o) v += u; }
    gc[lane] = v;
    fac[lane] = bb[lane] * __expf(v);
  }
  __syncthreads();
  u16* const outp = p.prep + ((long)((b * 8 + h) * 2 + DIR) * NCH + c) * GD_ITEM;
  {
    f32x4 a1[4], a2[4];
#pragma unroll
    for (int n = 0; n < 4; ++n) { a1[n] = f32x4{0.f, 0.f, 0.f, 0.f}; a2[n] = f32x4{0.f, 0.f, 0.f, 0.f}; }
    mm_strip<128, 4>(R1, 136, 16 * wid, R1, 136, 0, a1, lane);
    mm_strip<128, 4>(R2, 136, 16 * wid, R1, 136, 0, a2, lane);
#pragma unroll
    for (int nt = 0; nt < 4; ++nt) {
      const int s = 16 * nt + fr, t0 = 16 * wid + 4 * fq;
      float lv[4];
#pragma unroll
      for (int j = 0; j < 4; ++j) {
        const int t = t0 + j;
        float dec = s <= t ? __expf(gc[t] - gc[s]) : 0.f;
        lv[j] = s < t ? bb[t] * a1[nt][j] * dec : 0.f;
        As[t * 72 + s] = f2bf(a2[nt][j] * dec);
      }
      uint2 o; o.x = pack2(lv[3], lv[2]); o.y = pack2(lv[1], lv[0]);
      *reinterpret_cast<uint2*>(Ls + (63 - s) * 72 + 60 - t0) = o;
    }
#pragma unroll
    for (int nt = 0; nt < 4; ++nt) {
      int t = 16 * nt + fr;
      float eg = __expf(gc[t]);
      float o[8];
#pragma unroll
      for (int s2 = 0; s2 < 2; ++s2)
#pragma unroll
        for (int j = 0; j < 4; ++j) o[s2 * 4 + j] = bf2f(R2[t * 136 + 16 * (2 * wid + s2) + 4 * fq + j]) * eg;
      st8(outp + (((8 + nt) * 4 + wid) * 64 + lane) * 8, o);
    }
  }
  {
    bf16x8 bw[2][2], bu[2][2];
#pragma unroll
    for (int ks = 0; ks < 2; ++ks) {
      float f8[8];
#pragma unroll
      for (int j = 0; j < 8; ++j) f8[j] = fac[63 - (32 * ks + 8 * fq + j)];
#pragma unroll
      for (int ct = 0; ct < 2; ++ct) {
        const int ch = 16 * (2 * wid + ct) + fr;
        union { bf16x8 v; unsigned w[4]; } cv;
#pragma unroll
        for (int j2 = 0; j2 < 4; ++j2) {
          const int s0 = 63 - (32 * ks + 8 * fq + 2 * j2);
          cv.w[j2] = pack2(bf2f(R1[s0 * 136 + ch]) * f8[2 * j2], bf2f(R1[(s0 - 1) * 136 + ch]) * f8[2 * j2 + 1]);
        }
        bw[ct][ks] = cv.v;
        bu[ct][ks] = *reinterpret_cast<const bf16x8*>(Ut + ch * 72 + 32 * ks + 8 * fq);
      }
    }
    unsigned kreg[16];
    {
      const float eg = __expf(gc[63] - gc[i]);
#pragma unroll
      for (int e = 0; e < 16; ++e)
        kreg[e] = pack2(bf2f(R1[i * 136 + 32 * sub + 2 * e]) * eg, bf2f(R1[i * 136 + 32 * sub + 2 * e + 1]) * eg);
    }
    __syncthreads();
    if (wid == (half_id() ? 2 : 0)) {
      float xr[64];
      fwd_solve64<true>(xr, Ls, Ls + lane * 72, lane);
    }
    __syncthreads();
    {
      bf16x8 ta[4][2];
#pragma unroll
      for (int tt = 0; tt < 4; ++tt)
#pragma unroll
        for (int ks = 0; ks < 2; ++ks) ta[tt][ks] = *reinterpret_cast<const bf16x8*>(Ls + (16 * tt + fr) * 72 + 32 * ks + 8 * fq);
#pragma unroll
      for (int ct = 0; ct < 2; ++ct) {
        const int ch = 16 * (2 * wid + ct) + fr;
#pragma unroll
        for (int tt = 0; tt < 4; ++tt) {
          f32x4 aw = f32x4{0.f, 0.f, 0.f, 0.f}, au = aw;
          aw = MFMA16(ta[tt][0], bw[ct][0], aw); aw = MFMA16(ta[tt][1], bw[ct][1], aw);
          au = MFMA16(ta[tt][0], bu[ct][0], au); au = MFMA16(ta[tt][1], bu[ct][1], au);
          uint2 ow, ou;
          ow.x = pack2(aw[3], aw[2]); ow.y = pack2(aw[1], aw[0]);
          ou.x = pack2(au[3], au[2]); ou.y = pack2(au[1], au[0]);
          *reinterpret_cast<uint2*>(R2 + ch * 72 + 60 - 16 * tt - 4 * fq) = ow;
          *reinterpret_cast<uint2*>(Ut + ch * 72 + 60 - 16 * tt - 4 * fq) = ou;
        }
      }
    }
#pragma unroll
    for (int e = 0; e < 16; ++e) {
      R1[(32 * sub + 2 * e) * 72 + i] = (u16)(kreg[e] & 0xffffu);
      R1[(32 * sub + 2 * e + 1) * 72 + i] = (u16)(kreg[e] >> 16);
    }
  }
  __syncthreads();
  { const int tidn = opaque_tid(); GDN_ISSUEQ((it + it_stride < it_end ? it + it_stride : it), tidn); }
  {
    const float glast = __expf(gc[63]);
    {
      f32x4 m0[8], m1[8];
#pragma unroll
      for (int n = 0; n < 8; ++n) { m0[n] = f32x4{0.f, 0.f, 0.f, 0.f}; m1[n] = f32x4{0.f, 0.f, 0.f, 0.f}; }
      mm_strip<64, 8>(R2, 72, 16 * (2 * wid), R1, 72, 0, m0, lane);
      mm_strip<64, 8>(R2, 72, 16 * (2 * wid + 1), R1, 72, 0, m1, lane);
#pragma unroll
      for (int nt = 0; nt < 8; ++nt) {
        float o[8];
#pragma unroll
        for (int j = 0; j < 4; ++j) {
          int k0 = 16 * (2 * wid) + 4 * fq + j, k1 = k0 + 16, kp = 16 * nt + fr;
          o[j] = m0[nt][j] + (k0 == kp ? glast : 0.f);
          o[4 + j] = m1[nt][j] + (k1 == kp ? glast : 0.f);
        }
        st8(outp + ((nt * 4 + wid) * 64 + lane) * 8, o);
      }
    }
    {
      f32x4 q0[4], q1[4];
#pragma unroll
      for (int n = 0; n < 4; ++n) { q0[n] = f32x4{0.f, 0.f, 0.f, 0.f}; q1[n] = f32x4{0.f, 0.f, 0.f, 0.f}; }
      mm_strip<64, 4>(R2, 72, 16 * (2 * wid), As, 72, 0, q0, lane);
      mm_strip<64, 4>(R2, 72, 16 * (2 * wid + 1), As, 72, 0, q1, lane);
#pragma unroll
      for (int nt = 0; nt < 4; ++nt) {
        float o[8];
        ld8(outp + (((8 + nt) * 4 + wid) * 64 + lane) * 8, o);
#pragma unroll
        for (int j = 0; j < 4; ++j) { o[j] += q0[nt][j]; o[4 + j] += q1[nt][j]; }
        st8(outp + (((8 + nt) * 4 + wid) * 64 + lane) * 8, o);
      }
    }
    u16* cp = outp + 24576;
#pragma unroll
    for (int s2 = 0; s2 < 2; ++s2) {
      f32x4 an[8];
#pragma unroll
      for (int n = 0; n < 8; ++n) an[n] = f32x4{0.f, 0.f, 0.f, 0.f};
      mm_strip<64, 8>(R1, 72, 16 * (2 * wid + s2), Ut, 72, 0, an, lane);
#pragma unroll
      for (int nt = 0; nt < 8; ++nt) {
        uint2 o; o.x = pack2(-an[nt][0], -an[nt][1]); o.y = pack2(-an[nt][2], -an[nt][3]);
        *reinterpret_cast<uint2*>(cp + (((2 * wid + s2) * 8 + nt) * 64 + lane) * 4) = o;
      }
    }
    {
      f32x4 ao[8];
#pragma unroll
      for (int n = 0; n < 8; ++n) ao[n] = f32x4{0.f, 0.f, 0.f, 0.f};
      mm_strip<64, 8>(As, 72, 16 * wid, Ut, 72, 0, ao, lane);
#pragma unroll
      for (int nt = 0; nt < 8; ++nt) {
        uint2 o; o.x = pack2(-ao[nt][0], -ao[nt][1]); o.y = pack2(-ao[nt][2], -ao[nt][3]);
        *reinterpret_cast<uint2*>(cp + (((8 + wid) * 8 + nt) * 64 + lane) * 4) = o;
      }
    }
  }
  __syncthreads();
  }
#undef GDN_ISSUEQ
}

__device__ __forceinline__ void gdn_scan_block(const Params& p, int sid2) {
  const int tid = opaque_tid(), lane = tid & 63, fr = lane & 15, fq = lane >> 4;
  const int wid = __builtin_amdgcn_readfirstlane(tid >> 6);
  const int vhalf = sid2 & 1, sid = sid2 >> 1;
  const int d = sid & 1, bh = sid >> 1, b = bh / 8, h = bh % 8;
  const int wv = vhalf * 4 + wid;
  const char* base = (const char*)(p.prep + (long)sid * NCH * GD_ITEM);
  u16* obuf = d ? p.yb : p.yf;
  char* L = (char*)smem;
  const unsigned lo16 = lane * 16u, lo8 = lane * 8u;
  f32x4 st[8];
#pragma unroll
  for (int i = 0; i < 8; ++i) st[i] = f32x4{0.f, 0.f, 0.f, 0.f};
  auto chunk_of = [&](int step) { step = min(step, NCH - 1); return d == 0 ? step : (step < 4 ? 3 - step : 263 - step); };
  bf16x8 Ar[4][6];
  uint2 Cr[4][6];
#pragma unroll
  for (int u = 0; u < 3; ++u) {
    const char* it = base + (long)chunk_of(u >> 1) * (GD_ITEM * 2);
    const int half = u & 1;
    const char* pa = it + (half * 24 + wid * 6) * 1024;
    const char* pc = it + 49152 + ((half * 6) * 8 + wv) * 512;
#pragma unroll
    for (int e = 0; e < 6; ++e) Ar[u][e] = *reinterpret_cast<const bf16x8*>(pa + e * 1024 + lo16);
#pragma unroll
    for (int r = 0; r < 6; ++r) Cr[u][r] = *reinterpret_cast<const uint2*>(pc + r * 4096 + lo8);
  }
  __syncthreads();
  bf16x8 bfr[4];
#pragma unroll 1
  for (int P0 = 0; P0 < 2 * NCH; P0 += 8) {
#pragma unroll
    for (int u = 0; u < 8; ++u) {
      const int step = (P0 >> 1) + (u >> 1);
      const int half = u & 1;
      {
        const int Pn = P0 + u + 3;
        const char* it = base + (long)chunk_of(Pn >> 1) * (GD_ITEM * 2);
        const int hn = (u + 1) & 1;
        const char* pa = it + (hn * 24 + wid * 6) * 1024;
        const char* pc = it + 49152 + ((hn * 6) * 8 + wv) * 512;
#pragma unroll
        for (int e = 0; e < 6; ++e) Ar[(u + 3) % 4][e] = *reinterpret_cast<const bf16x8*>(pa + e * 1024 + lo16);
#pragma unroll
        for (int r = 0; r < 6; ++r) Cr[(u + 3) % 4][r] = *reinterpret_cast<const uint2*>(pc + r * 4096 + lo8);
      }
      char* Lb = L + half * 24576;
#pragma unroll
      for (int e = 0; e < 6; ++e) *reinterpret_cast<bf16x8*>(Lb + (wid * 6 + e) * 1024 + lo16) = Ar[u % 4][e];
      asm volatile("s_waitcnt lgkmcnt(0)" ::: "memory");
      __builtin_amdgcn_s_barrier();
      asm volatile("" ::: "memory");
      if (half == 0) {
#pragma unroll
        for (int ks = 0; ks < 4; ++ks) {
          union { bf16x8 v; unsigned w[4]; } cv;
          cv.w[0] = pack2(st[2 * ks][0], st[2 * ks][1]); cv.w[1] = pack2(st[2 * ks][2], st[2 * ks][3]);
          cv.w[2] = pack2(st[2 * ks + 1][0], st[2 * ks + 1][1]); cv.w[3] = pack2(st[2 * ks + 1][2], st[2 * ks + 1][3]);
          bfr[ks] = cv.v;
        }
      }
      const int c = chunk_of(step);
      u16* orow = obuf + ((long)b * PB + c * 64) * D + h * 128 + wv * 16 + fr;
#pragma unroll
      for (int r = 0; r < 6; ++r) {
        const int rt = half * 6 + r;
        f32x4 acc;
        acc[0] = __uint_as_float(Cr[u % 4][r].x << 16); acc[1] = __uint_as_float(Cr[u % 4][r].x & 0xffff0000u);
        acc[2] = __uint_as_float(Cr[u % 4][r].y << 16); acc[3] = __uint_as_float(Cr[u % 4][r].y & 0xffff0000u);
#pragma unroll
        for (int ks = 0; ks < 4; ++ks) {
          bf16x8 a = *reinterpret_cast<const bf16x8*>(Lb + (r * 4 + ks) * 1024 + lo16);
          acc = MFMA16(a, bfr[ks], acc);
        }
        if (rt < 8) st[rt] = acc;
        else {
#pragma unroll
          for (int j = 0; j < 4; ++j) {
            int t = 16 * (rt - 8) + 4 * fq + j;
            int tau = d ? 63 - t : t;
            orow[(long)tau * D] = f2bf(acc[j]);
          }
        }
        if (r & 1) __builtin_amdgcn_sched_barrier(0);
      }
    }
  }
  __syncthreads();
}

__device__ __forceinline__ void gdn_scan_loader(const Params& p, int sid2, int s_begin, int s_end) {
  const int tid = opaque_tid(), lane = tid & 63;
  const int wid = __builtin_amdgcn_readfirstlane(tid >> 6);
  const int vhalf = sid2 & 1, sid = sid2 >> 1, d = sid & 1, bh = sid >> 1, b = bh / 8, h = bh % 8;
  u16* obuf = d ? p.yb : p.yf;
  const int t = tid >> 2, seg = tid & 3;
  const int tau = d ? 63 - t : t;
  const char* base = (const char*)(p.prep + (long)sid * NCH * GD_ITEM);
  char* L = (char*)smem_raw;
  const unsigned lo16 = lane * 16u;
  auto chunk_of = [&](int step) { step = min(step, NCH - 1); return d == 0 ? step : (step < 4 ? 3 - step : 263 - step); };
  auto copy = [&](int step) {
    const u16* Yb = (const u16*)(smem_raw + 49152) + (step & 1) * 4608 + t * 72 + seg * 16;
    const uint4 v0 = *reinterpret_cast<const uint4*>(Yb), v1 = *reinterpret_cast<const uint4*>(Yb + 8);
    const int cc = d == 0 ? step : (step < 4 ? 3 - step : 263 - step);
    u16* dst = obuf + ((long)b * PB + cc * 64 + tau) * D + h * 128 + vhalf * 64 + seg * 16;
    *reinterpret_cast<uint4*>(dst) = v0; *reinterpret_cast<uint4*>(dst + 8) = v1;
  };
  const int PB0 = 2 * s_begin, PE = 2 * s_end;
  bf16x8 Ar[8][6];
#pragma unroll
  for (int u = 0; u < 8; ++u) {
    const char* pa = base + (long)chunk_of(s_begin + (u >> 1)) * (GD_ITEM * 2) + ((u & 1) * 24 + wid * 6) * 1024;
#pragma unroll
    for (int e = 0; e < 6; ++e) Ar[u][e] = *reinterpret_cast<const bf16x8*>(pa + e * 1024 + lo16);
  }
  __syncthreads();
#pragma unroll
  for (int e = 0; e < 6; ++e) *reinterpret_cast<bf16x8*>(L + (wid * 6 + e) * 1024 + lo16) = Ar[0][e];
  {
    const char* pa = base + (long)chunk_of(s_begin + 4) * (GD_ITEM * 2) + (0 * 24 + wid * 6) * 1024;
#pragma unroll
    for (int e = 0; e < 6; ++e) Ar[0][e] = *reinterpret_cast<const bf16x8*>(pa + e * 1024 + lo16);
  }
  asm volatile("s_waitcnt lgkmcnt(0)" ::: "memory");
  __builtin_amdgcn_s_barrier();
#pragma unroll 1
  for (int P0 = PB0; P0 < PE; P0 += 8) {
#pragma unroll
    for (int u = 0; u < 8; ++u) {
      const int Pw = P0 + u + 1;
      if (Pw < PE) {
        char* Lb = L + ((u + 1) & 1) * 24576;
#pragma unroll
        for (int e = 0; e < 6; ++e) *reinterpret_cast<bf16x8*>(Lb + (wid * 6 + e) * 1024 + lo16) = Ar[(u + 1) % 8][e];
      }
      {
        const int Pn = P0 + u + 9;
        const char* pa = base + (long)chunk_of(Pn >> 1) * (GD_ITEM * 2) + (((u + 1) & 1) * 24 + wid * 6) * 1024;
#pragma unroll
        for (int e = 0; e < 6; ++e) Ar[(u + 1) % 8][e] = *reinterpret_cast<const bf16x8*>(pa + e * 1024 + lo16);
      }
      if ((u & 1) == 0 && P0 + u >= PB0 + 2) copy(((P0 + u) >> 1) - 1);
      asm volatile("s_waitcnt lgkmcnt(0)" ::: "memory");
      __builtin_amdgcn_s_barrier();
      asm volatile("" ::: "memory");
    }
  }
  copy(s_end - 1);
  __syncthreads();
}

__device__ __forceinline__ void gdn_scan_compute(const Params& p, int sid2, int s_begin, int s_end) {
  const int tid = opaque_tid(), lane = tid & 63, fr = lane & 15, fq = lane >> 4;
  const int wid = __builtin_amdgcn_readfirstlane(tid >> 6);
  const int vhalf = sid2 & 1, sid = sid2 >> 1;
  const int d = sid & 1, bh = sid >> 1, b = bh / 8, h = bh % 8;
  const int wv = vhalf * 4 + wid;
  const char* base = (const char*)(p.prep + (long)sid * NCH * GD_ITEM);
  u16* obuf = d ? p.yb : p.yf;
  const char* L = (const char*)smem_raw;
  const unsigned lo16 = lane * 16u, lo8 = lane * 8u;
  const int PB0 = 2 * s_begin, PE = 2 * s_end;
  f32x4* stsave = (f32x4*)(smem_raw + 98304) + tid * 8;
  f32x4 st[8];
#pragma unroll
  for (int i = 0; i < 8; ++i) st[i] = s_begin > 0 ? stsave[i] : f32x4{0.f, 0.f, 0.f, 0.f};
  auto chunk_of = [&](int step) { step = min(step, NCH - 1); return d == 0 ? step : (step < 4 ? 3 - step : 263 - step); };
  uint2 Cr[4][6];
#pragma unroll
  for (int u = 0; u < 3; ++u) {
    const char* pc = base + (long)chunk_of(s_begin + (u >> 1)) * (GD_ITEM * 2) + 49152 + (((u & 1) * 6) * 8 + wv) * 512;
#pragma unroll
    for (int r = 0; r < 6; ++r) Cr[u][r] = *reinterpret_cast<const uint2*>(pc + r * 4096 + lo8);
  }
  __syncthreads();
  __builtin_amdgcn_s_barrier();
  asm volatile("" ::: "memory");
  bf16x8 bfr[4];
#pragma unroll 1
  for (int P0 = PB0; P0 < PE; P0 += 8) {
#pragma unroll
    for (int u = 0; u < 8; ++u) {
      const int step = (P0 >> 1) + (u >> 1);
      const int half = u & 1;
      {
        const int Pn = P0 + u + 3;
        const char* pc = base + (long)chunk_of(Pn >> 1) * (GD_ITEM * 2) + 49152 + ((((u + 1) & 1) * 6) * 8 + wv) * 512;
#pragma unroll
        for (int r = 0; r < 6; ++r) Cr[(u + 3) % 4][r] = *reinterpret_cast<const uint2*>(pc + r * 4096 + lo8);
      }
      const char* Lb = L + half * 24576;
      if (half == 0) {
#pragma unroll
        for (int ks = 0; ks < 4; ++ks) {
          union { bf16x8 v; unsigned w[4]; } cv;
          cv.w[0] = pack2(st[2 * ks][0], st[2 * ks][1]); cv.w[1] = pack2(st[2 * ks][2], st[2 * ks][3]);
          cv.w[2] = pack2(st[2 * ks + 1][0], st[2 * ks + 1][1]); cv.w[3] = pack2(st[2 * ks + 1][2], st[2 * ks + 1][3]);
          bfr[ks] = cv.v;
        }
      }
      const int c = chunk_of(step);
      u16* Yb = (u16*)(smem_raw + 49152) + (step & 1) * 4608;
      (void)c;
      bf16x8 fa[8], fb[8];
#pragma unroll
      for (int q = 0; q < 8; ++q) fa[q] = *reinterpret_cast<const bf16x8*>(Lb + q * 1024 + lo16);
#pragma unroll
      for (int k = 0; k < 3; ++k) {
        if (k == 0) {
#pragma unroll
          for (int q = 0; q < 8; ++q) fb[q] = *reinterpret_cast<const bf16x8*>(Lb + (8 + q) * 1024 + lo16);
        } else if (k == 1) {
#pragma unroll
          for (int q = 0; q < 8; ++q) fa[q] = *reinterpret_cast<const bf16x8*>(Lb + (16 + q) * 1024 + lo16);
        }
#pragma unroll
        for (int rr = 0; rr < 2; ++rr) {
          const int r = 2 * k + rr, rt = half * 6 + r;
          f32x4 acc;
          acc[0] = __uint_as_float(Cr[u % 4][r].x << 16); acc[1] = __uint_as_float(Cr[u % 4][r].x & 0xffff0000u);
          acc[2] = __uint_as_float(Cr[u % 4][r].y << 16); acc[3] = __uint_as_float(Cr[u % 4][r].y & 0xffff0000u);
#pragma unroll
          for (int ks = 0; ks < 4; ++ks) acc = MFMA16((k == 1 ? fb : fa)[rr * 4 + ks], bfr[ks], acc);
          if (rt < 8) st[rt] = acc;
          else {
#pragma unroll
            for (int j = 0; j < 4; ++j) {
              int t = 16 * (rt - 8) + 4 * fq + j;
              Yb[t * 72 + wid * 16 + fr] = f2bf(acc[j]);
            }
          }
        }
        __builtin_amdgcn_sched_barrier(0);
      }
      asm volatile("s_waitcnt lgkmcnt(0)" ::: "memory");
      __builtin_amdgcn_s_barrier();
      asm volatile("" ::: "memory");
    }
  }
  if (s_end < NCH) {
#pragma unroll
    for (int i = 0; i < 8; ++i) stsave[i] = st[i];
  }
  __syncthreads();
}

__device__ __forceinline__ void phase_gdn_out(const Params& p) {
  const int tid_ = opaque_tid(); const int lane = tid_ & 63, wid = tid_ >> 6;
  for (int row = VBID * 4 + wid; row < T; row += NVB * 4) {
#pragma unroll
    for (int i = 0; i < 4; ++i) {
      int col = (i * 64 + lane) * 4;
      uint2 a = *reinterpret_cast<const uint2*>(p.yf + (long)row * D + col);
      uint2 bq = *reinterpret_cast<const uint2*>(p.yb + (long)row * D + col);
      uint2 gz = *reinterpret_cast<const uint2*>(p.zbuf + (long)row * GDN_IN + 3072 + col);
      float o[4], gt[4];
      o[0] = __uint_as_float(a.x << 16) + __uint_as_float(bq.x << 16);
      o[1] = __uint_as_float(a.x & 0xffff0000u) + __uint_as_float(bq.x & 0xffff0000u);
      o[2] = __uint_as_float(a.y << 16) + __uint_as_float(bq.y << 16);
      o[3] = __uint_as_float(a.y & 0xffff0000u) + __uint_as_float(bq.y & 0xffff0000u);
      gt[0] = __uint_as_float(gz.x << 16); gt[1] = __uint_as_float(gz.x & 0xffff0000u);
      gt[2] = __uint_as_float(gz.y << 16); gt[3] = __uint_as_float(gz.y & 0xffff0000u);
      float ss = o[0] * o[0] + o[1] * o[1] + o[2] * o[2] + o[3] * o[3];
#pragma unroll
      for (int of = 16; of > 0; of >>= 1) ss += __shfl_xor(ss, of);
      float rstd = rsqrtf(ss * (1.f / 128.f) + 1e-6f);
      float r[4];
#pragma unroll
      for (int e = 0; e < 4; ++e) r[e] = o[e] * rstd * p.gdn_norm_g[(col & 127) + e] * siluf_(gt[e]);
      uint2 w; w.x = pack2(r[0], r[1]); w.y = pack2(r[2], r[3]);
      *reinterpret_cast<uint2*>(p.abuf + (long)row * D + col) = w;
    }
  }
}

__device__ __forceinline__ void phase_post_mixer(const Params& p, int layer, bool dry = false) {
  constexpr int FS = 1026;
  u16* const xdst = dry ? p.yf : p.xs;
  float* frow = (float*)smem;
  float* part = frow + 16 * FS;
  int* hist = (int*)(part + 4 * 16 * 32);
  const int tid = opaque_tid(), lane = tid & 63, fr = lane & 15, fq = lane >> 4;
  const int wid = __builtin_amdgcn_readfirstlane(tid >> 6);
  if (tid < 32) hist[tid] = 0;
  __syncthreads();
  const float* rw = p.router_w + (long)layer * 1024 * 32;
  const float* g1 = p.norm_g + (long)(layer * 4 + 1) * 1024;
  const float* g2 = p.norm_g + (long)(layer * 4 + 2) * 1024;
  float wreg0[64], wreg1[64];
  {
    const float* wb = rw + (long)(wid * 256 + fq) * 32 + fr;
#pragma unroll
    for (int s_ = 0; s_ < 64; ++s_) { wreg0[s_] = wb[(long)(4 * s_) * 32]; wreg1[s_] = wb[(long)(4 * s_) * 32 + 16]; }
  }
  for (int trip = 0; trip < (layer == 0 ? 5 : 4); ++trip) {
    int row0, nvalid = 16;
    if (layer == 0) {
      if (trip < 4) row0 = (VBID + trip * NVB) * 16; else { row0 = 4 * NVB * 16 + VBID; nvalid = 1; }
    } else {
      const int g = VBID + trip * NVB;
      row0 = (g >> 10) * PB + CTXL + (g & 1023) * 16;
    }
    const int b = row0 / PB, pp0 = row0 % PB;
    const bool isctx = pp0 < CTXL;
    const int mrow = isctx ? 2 : b;
    const float* gate = modp(p, layer, mrow, 2);
    const float* sh = modp(p, layer, mrow, 3);
    const float* sc = modp(p, layer, mrow, 4);
#pragma unroll 1
    for (int rr = 0; rr < 4; ++rr) {
      const int lr = wid * 4 + rr, row = row0 + lr, pp = pp0 + lr;
      if (lr >= nvalid) continue;
      float ss = 0.f;
      float4 tv[4];
#pragma unroll
      for (int i = 0; i < 4; ++i) {
        tv[i] = ld4bf(p.tmp + (long)row * D + (i * 64 + lane) * 4);
        ss += tv[i].x * tv[i].x + tv[i].y * tv[i].y + tv[i].z * tv[i].z + tv[i].w * tv[i].w;
      }
      float4 lv[4];
#pragma unroll
      for (int i = 0; i < 4; ++i) {
        const int col = (i * 64 + lane) * 4;
        if (layer == 0) {
          const float* src0 = isctx ? p.ctx + ((long)b * CTXL + pp) * D : p.x + ((long)b * SEQ + (pp - CTXL)) * D;
          lv[i] = *reinterpret_cast<const float4*>(src0 + col);
        } else lv[i] = ld4bf(p.xs + (long)row * D + col);
      }
      ss = wave_sum(ss);
      const float rstd = rsqrtf(ss * (1.f / 1024.f) + 1e-6f);
      float ss2 = 0.f;
#pragma unroll
      for (int i = 0; i < 4; ++i) {
        const int col = (i * 64 + lane) * 4;
        const float4 gg = *reinterpret_cast<const float4*>(g1 + col);
        const float4 gt = *reinterpret_cast<const float4*>(gate + col);
        lv[i].x += gt.x * (tv[i].x * rstd * gg.x); lv[i].y += gt.y * (tv[i].y * rstd * gg.y);
        lv[i].z += gt.z * (tv[i].z * rstd * gg.z); lv[i].w += gt.w * (tv[i].w * rstd * gg.w);
        st4bf(xdst + (long)row * D + col, lv[i]);
        ss2 += lv[i].x * lv[i].x + lv[i].y * lv[i].y + lv[i].z * lv[i].z + lv[i].w * lv[i].w;
      }
      ss2 = wave_sum(ss2);
      const float rstd2 = rsqrtf(ss2 * (1.f / 1024.f) + 1e-6f);
#pragma unroll
      for (int i = 0; i < 4; ++i) {
        const int col = (i * 64 + lane) * 4;
        const float4 g2v = *reinterpret_cast<const float4*>(g2 + col);
        const float4 s4 = *reinterpret_cast<const float4*>(sh + col);
        const float4 c4 = *reinterpret_cast<const float4*>(sc + col);
        float4 f;
        f.x = lv[i].x * rstd2 * g2v.x * (1.f + c4.x) + s4.x; f.y = lv[i].y * rstd2 * g2v.y * (1.f + c4.y) + s4.y;
        f.z = lv[i].z * rstd2 * g2v.z * (1.f + c4.z) + s4.z; f.w = lv[i].w * rstd2 * g2v.w * (1.f + c4.w) + s4.w;
        st4bf(p.abuf + (long)row * D + col, f);
        float* fd = frow + lr * FS + col;
        fd[0] = f.x; fd[1] = f.y; fd[2] = f.z; fd[3] = f.w;
      }
    }
    __syncthreads();
    {
      f32x4 acc0 = f32x4{0.f, 0.f, 0.f, 0.f}, acc1 = acc0;
      const float* fa = frow + fr * FS + wid * 256 + fq;
#pragma unroll
      for (int s = 0; s < 64; ++s) {
        const float a = fa[4 * s];
        acc0 = __builtin_amdgcn_mfma_f32_16x16x4f32(a, wreg0[s], acc0, 0, 0, 0);
        acc1 = __builtin_amdgcn_mfma_f32_16x16x4f32(a, wreg1[s], acc1, 0, 0, 0);
      }
#pragma unroll
      for (int j = 0; j < 4; ++j) {
        part[(wid * 16 + 4 * fq + j) * 32 + fr] = acc0[j];
        part[(wid * 16 + 4 * fq + j) * 32 + 16 + fr] = acc1[j];
      }
    }
    __syncthreads();
#pragma unroll 1
    for (int rr = 0; rr < 4; ++rr) {
      const int lr = wid * 4 + rr, row = row0 + lr;
      if (lr >= nvalid) continue;
      float logit = -3.0e38f;
      if (lane < 32)
        logit = part[(0 * 16 + lr) * 32 + lane] + part[(1 * 16 + lr) * 32 + lane] + part[(2 * 16 + lr) * 32 + lane] +
                part[(3 * 16 + lr) * 32 + lane] + p.router_b[layer * 32 + lane];
      float tv4[4]; int ti4[4];
#pragma unroll
      for (int k = 0; k < 4; ++k) {
        float bv = logit; int bi = lane;
#pragma unroll
        for (int of = 32; of > 0; of >>= 1) {
          float ov = __shfl_xor(bv, of); int oi = __shfl_xor(bi, of);
          if (ov > bv || (ov == bv && oi < bi)) { bv = ov; bi = oi; }
        }
        tv4[k] = bv; ti4[k] = bi;
        if (lane == bi) logit = -3.0e38f;
      }
      if (lane == 0) {
        float m = tv4[0];
        float e0 = 1.f, e1 = __expf(tv4[1] - m), e2 = __expf(tv4[2] - m), e3 = __expf(tv4[3] - m);
        float inv = 1.f / (e0 + e1 + e2 + e3);
        *reinterpret_cast<int4*>(p.tok_e + (long)row * 4) = make_int4(ti4[0], ti4[1], ti4[2], ti4[3]);
        *reinterpret_cast<float4*>(p.tok_gw + (long)row * 4) = make_float4(e0 * inv, e1 * inv, e2 * inv, e3 * inv);
        if (!dry) { atomicAdd(hist + ti4[0], 1); atomicAdd(hist + ti4[1], 1); atomicAdd(hist + ti4[2], 1); atomicAdd(hist + ti4[3], 1); }
      }
    }
    __syncthreads();
  }
  __syncthreads();
  if (!dry && tid < 32 && hist[tid]) atomicAdd(p.cnt + CNTI(layer, 0, tid), hist[tid]);
}

__device__ __forceinline__ void phase_moe_scatter(const Params& p, int layer) {
  int* base = (int*)smem;
  int* lcnt = base + 32;
  int* lbase = base + 64;
  const int tid = opaque_tid();
  if (tid == 0) {
    int run = 0;
    for (int e = 0; e < NE; ++e) { base[e] = run; run += p.cnt[CNTI(layer, 0, e)]; }
  }
  if (tid < 32) lcnt[tid] = 0;
  __syncthreads();
  int e_[4], r_[4]; long id_[4];
#pragma unroll
  for (int k = 0; k < 4; ++k) {
    const long idx = (long)VBID * NTH + tid + (long)k * NVB * NTH;
    id_[k] = -1; e_[k] = 0; r_[k] = 0;
    if (idx < (long)T * 4) {
      const int tok = (int)(idx >> 2);
      if (!(layer == 1 && (tok % PB) < CTXL)) {
        id_[k] = idx;
        e_[k] = p.tok_e[idx];
        r_[k] = atomicAdd(lcnt + e_[k], 1);
      }
    }
  }
  __syncthreads();
  if (tid < 32) lbase[tid] = lcnt[tid] ? atomicAdd(p.cnt + CNTI(layer, 1, tid), lcnt[tid]) : 0;
  __syncthreads();
#pragma unroll
  for (int k = 0; k < 4; ++k) {
    if (id_[k] >= 0) {
      const int slot = base[e_[k]] + lbase[e_[k]] + r_[k];
      p.slot_tok[slot] = (int)(id_[k] >> 2);
      p.slot_gw[slot] = p.tok_gw[id_[k]];
      p.tok_slot[id_[k]] = slot;
    }
  }
  __syncthreads();
}

struct MoeTab { int tstart[33]; int base[33]; };

__device__ __forceinline__ void moe_build_tab(const Params& p, int layer, MoeTab* tab) {
  __syncthreads();
  if ((threadIdx.x & 255) == 0) {
    int run = 0, trun = 0;
    for (int e = 0; e < NE; ++e) {
      int cnt = p.cnt[CNTI(layer, 0, e)];
      tab->base[e] = run; tab->tstart[e] = trun;
      run += cnt; trun += (cnt + 127) >> 7;
    }
    tab->base[32] = run; tab->tstart[32] = trun;
  }
  __syncthreads();
}

__device__ __forceinline__ void phase_moe_gemm1(const Params& p, int layer) {
  MoeTab* tab = (MoeTab*)(smem + 73728);
  moe_build_tab(p, layer, tab);
  const int ntiles = tab->tstart[32];
  const int tid = opaque_tid(), wid = tid >> 6, lane = tid & 63, wr = wid >> 1, wc = wid & 1, fr = lane & 15, fq = lane >> 4;
  for (int item = VBID; item < ntiles * 8; item += NVB) {
    const int ti = item >> 3, nt = item & 7;
    int e = 0;
    for (int q = 1; q < NE; ++q) if (ti >= tab->tstart[q]) e = q;
    const int mt = ti - tab->tstart[e];
    const int cnt = tab->base[e + 1] - tab->base[e];
    const int valid = min(128, cnt - mt * 128);
    const int slot0 = tab->base[e] + mt * 128;
    const u16* Bt = p.MoeInT + (long)(layer * 32 + e) * 2048 * 1024;
    f32x4 acc[4][8];
    gemm_tile(p.abuf, D, Bt, D, D,
              [&](int r) { return p.slot_tok[slot0 + min(r, valid - 1)]; },
              [&](int r) { int wcc = r >> 7, n = (r >> 4) & 7, f = r & 15;
                           return (n < 4 ? 0 : 1024) + nt * 128 + wcc * 64 + (n & 3) * 16 + f; },
              acc);
    const float* bi = p.moe_b_in + (long)(layer * 32 + e) * 2048;
#pragma unroll
    for (int m = 0; m < 4; ++m) {
      const int r = wr * 64 + m * 16 + fr;
#pragma unroll
      for (int n = 0; n < 4; ++n) {
        const int ca = nt * 128 + wc * 64 + n * 16 + fq * 4;
        const float4 bg = *reinterpret_cast<const float4*>(bi + ca);
        const float4 bl = *reinterpret_cast<const float4*>(bi + 1024 + ca);
        const float bgv[4] = {bg.x, bg.y, bg.z, bg.w}, blv[4] = {bl.x, bl.y, bl.z, bl.w};
        float v[4];
#pragma unroll
        for (int j = 0; j < 4; ++j) {
          float glu = fminf(acc[m][n][j] + bgv[j], 7.0f);
          float lin = fminf(fmaxf(acc[m][n + 4][j] + blv[j], -7.0f), 7.0f);
          v[j] = glu * sigmoidf_(1.702f * glu) * (lin + 1.0f);
        }
        if (r < valid) {
          uint2 o; o.x = pack2(v[0], v[1]); o.y = pack2(v[2], v[3]);
          *reinterpret_cast<uint2*>(p.act + (long)(slot0 + r) * D + ca) = o;
        }
      }
    }
  }
}

__device__ __forceinline__ void phase_moe_gemm2(const Params& p, int layer) {
  MoeTab* tab = (MoeTab*)(smem + 73728);
  moe_build_tab(p, layer, tab);
  const int ntiles = tab->tstart[32];
  const int tid = opaque_tid(), wid = tid >> 6, lane = tid & 63, wr = wid >> 1, wc = wid & 1, fr = lane & 15, fq = lane >> 4;
  for (int item = VBID; item < ntiles * 4; item += NVB) {
    const int ti = item >> 2, nt = item & 3;
    int e = 0;
    for (int q = 1; q < NE; ++q) if (ti >= tab->tstart[q]) e = q;
    const int mt = ti - tab->tstart[e];
    const int cnt = tab->base[e + 1] - tab->base[e];
    const int valid = min(128, cnt - mt * 128);
    const int slot0 = tab->base[e] + mt * 128;
    const u16* Bt = p.MoeOutT + (long)(layer * 32 + e) * 1024 * 1024;
    f32x4 acc[4][8];
    gemm_tile(p.act, D, Bt, D, D,
              [&](int r) { return slot0 + min(r, valid - 1); },
              [&](int r) { return nt * 256 + r; },
              acc);
    const float* bo = p.moe_b_out + (long)(layer * 32 + e) * 1024;
#pragma unroll
    for (int m = 0; m < 4; ++m) {
      const int r = wr * 64 + m * 16 + fr;
      const float gw = r < valid ? p.slot_gw[slot0 + r] : 0.f;
#pragma unroll
      for (int n = 0; n < 8; ++n) {
        const int cc = nt * 256 + wc * 128 + n * 16 + fq * 4;
        const float4 bv = *reinterpret_cast<const float4*>(bo + cc);
        if (r < valid) {
          uint2 o;
          o.x = pack2((acc[m][n][0] + bv.x) * gw, (acc[m][n][1] + bv.y) * gw);
          o.y = pack2((acc[m][n][2] + bv.z) * gw, (acc[m][n][3] + bv.w) * gw);
          *reinterpret_cast<uint2*>(p.oslot + (long)(slot0 + r) * D + cc) = o;
        }
      }
    }
  }
}

__device__ __forceinline__ void phase_moe_combine(const Params& p, int layer, bool dry = false) {
  u16* const xdst = dry ? p.yf : p.xs;
  const int tid_ = opaque_tid(); const int lane = tid_ & 63, wid = tid_ >> 6;
  const float* g3 = p.norm_g + (long)(layer * 4 + 3) * 1024;
  const float* g0n = p.norm_g + (long)((layer + 1) * 4 + 0) * 1024;
  for (int row0 = VBID * 4 + wid; row0 < T; row0 += NVB * 8) {
    int rows[2]; bool act[2]; int bb[2], ppp[2], mrow[2];
#pragma unroll
    for (int q = 0; q < 2; ++q) {
      rows[q] = row0 + q * NVB * 4;
      act[q] = rows[q] < T;
      const int rr = act[q] ? rows[q] : row0;
      bb[q] = rr / PB; ppp[q] = rr % PB;
      if (layer == 1 && ppp[q] < CTXL) act[q] = false;
      mrow[q] = ppp[q] < CTXL ? 2 : bb[q];
      rows[q] = rr;
    }
    if (!act[0] && !act[1]) continue;
    int4 sl[2];
#pragma unroll
    for (int q = 0; q < 2; ++q) sl[q] = *reinterpret_cast<const int4*>(p.tok_slot + (long)rows[q] * 4);
    float y[2][16];
    float4 xv[2][4];
#pragma unroll
    for (int q = 0; q < 2; ++q) {
#pragma unroll
      for (int i = 0; i < 16; ++i) y[q][i] = 0.f;
      const int sls[4] = {sl[q].x, sl[q].y, sl[q].z, sl[q].w};
#pragma unroll
      for (int k = 0; k < 4; ++k) {
#pragma unroll
        for (int i = 0; i < 4; ++i) {
          uint2 a = *reinterpret_cast<const uint2*>(p.oslot + (long)sls[k] * D + (i * 64 + lane) * 4);
          y[q][i * 4 + 0] += __uint_as_float(a.x << 16); y[q][i * 4 + 1] += __uint_as_float(a.x & 0xffff0000u);
          y[q][i * 4 + 2] += __uint_as_float(a.y << 16); y[q][i * 4 + 3] += __uint_as_float(a.y & 0xffff0000u);
        }
      }
#pragma unroll
      for (int i = 0; i < 4; ++i) xv[q][i] = ld4bf(p.xs + (long)rows[q] * D + (i * 64 + lane) * 4);
    }
#pragma unroll
    for (int q = 0; q < 2; ++q) {
      if (!act[q]) continue;
      const int row = rows[q];
      float ss = 0.f;
#pragma unroll
      for (int i = 0; i < 16; ++i) ss += y[q][i] * y[q][i];
      ss = wave_sum(ss);
      const float rstd = rsqrtf(ss * (1.f / 1024.f) + 1e-6f);
      float lat[16];
      float ss2 = 0.f;
      const float* gate = modp(p, layer, mrow[q], 5);
#pragma unroll
      for (int i = 0; i < 4; ++i) {
        const int col = (i * 64 + lane) * 4;
        const float4 gg = *reinterpret_cast<const float4*>(g3 + col);
        const float4 gt = *reinterpret_cast<const float4*>(gate + col);
        lat[i * 4 + 0] = xv[q][i].x + gt.x * (y[q][i * 4 + 0] * rstd * gg.x);
        lat[i * 4 + 1] = xv[q][i].y + gt.y * (y[q][i * 4 + 1] * rstd * gg.y);
        lat[i * 4 + 2] = xv[q][i].z + gt.z * (y[q][i * 4 + 2] * rstd * gg.z);
        lat[i * 4 + 3] = xv[q][i].w + gt.w * (y[q][i * 4 + 3] * rstd * gg.w);
#pragma unroll
        for (int e = 0; e < 4; ++e) ss2 += lat[i * 4 + e] * lat[i * 4 + e];
        const float4 ov = make_float4(lat[i * 4 + 0], lat[i * 4 + 1], lat[i * 4 + 2], lat[i * 4 + 3]);
        if (layer == 0) st4bf(xdst + (long)row * D + col, ov);
        else *reinterpret_cast<float4*>(p.out + ((long)bb[q] * SEQ + (ppp[q] - CTXL)) * D + col) = ov;
      }
      if (layer == 0) {
        ss2 = wave_sum(ss2);
        const float rstd2 = rsqrtf(ss2 * (1.f / 1024.f) + 1e-6f);
        const float* sh = modp(p, 1, mrow[q], 0);
        const float* sc = modp(p, 1, mrow[q], 1);
#pragma unroll
        for (int i = 0; i < 4; ++i) {
          const int col = (i * 64 + lane) * 4;
          const float4 gg = *reinterpret_cast<const float4*>(g0n + col);
          const float4 s4 = *reinterpret_cast<const float4*>(sh + col);
          const float4 c4 = *reinterpret_cast<const float4*>(sc + col);
          const float h0 = lat[i * 4 + 0] * rstd2 * gg.x * (1.f + c4.x) + s4.x;
          const float h1 = lat[i * 4 + 1] * rstd2 * gg.y * (1.f + c4.y) + s4.y;
          const float h2 = lat[i * 4 + 2] * rstd2 * gg.z * (1.f + c4.z) + s4.z;
          const float h3 = lat[i * 4 + 3] * rstd2 * gg.w * (1.f + c4.w) + s4.w;
          uint2 o; o.x = pack2(h0, h1); o.y = pack2(h2, h3);
          *reinterpret_cast<uint2*>(p.abuf + (long)row * D + col) = o;
        }
      }
    }
  }
}
namespace g8 {
constexpr int BK = 64, HTB = 128 * BK * 2;
__device__ __forceinline__ int lds_byte(int r, int c) { const int st = (r >> 4) * 2 + (c >> 5), rr = r & 15, cc = c & 31, ob = rr * 64 + cc * 2; return st * 1024 + (ob ^ (((ob >> 9) & 1) << 5)); }
__device__ __forceinline__ int perm32(int rho) { const int n = rho >> 4, i = rho & 15; return 8 * (i >> 2) + 4 * n + (i & 3); }
__device__ __forceinline__ void stage_rc(int b, int& R, int& C) { const int st = b / 1024, sb = b % 1024, swz = sb ^ (((sb >> 9) & 1) << 5); R = (st >> 1) * 16 + swz / 64; C = (st & 1) * 32 + (swz % 64) / 2; }

__device__ __forceinline__ const char* uni(const char* p) { unsigned long long v = (unsigned long long)p; unsigned lo = __builtin_amdgcn_readfirstlane((unsigned)v), hi = __builtin_amdgcn_readfirstlane((unsigned)(v >> 32)); return (const char*)(((unsigned long long)hi << 32) | lo); }
struct Unit { const char* b0; int i0, i1, i2, i3; };

template <class Sched, class RowOf, class Epi>
__device__ __forceinline__ void gemm_phase(const u16* __restrict__ Aptr, int K, const Sched& S, const RowOf& rowof, const Epi& E) {
  LAS unsigned char* lds = (LAS unsigned char*)smem_raw;
  int tid_ = threadIdx.x; asm volatile("" : "+v"(tid_));
  const int tid = tid_, wid = __builtin_amdgcn_readfirstlane(tid >> 6), lane = tid & 63, wr = wid >> 2, wc = wid & 3, fr = lane & 15, fq = lane >> 4;
  const int nt = K / BK;
  unsigned voffB[2];
#pragma unroll
  for (int i = 0; i < 2; ++i) { int R_, C_; stage_rc(tid * 16 + i * 8192, R_, C_); const int Rb = (R_ & ~31) + perm32(R_ & 31); voffB[i] = (unsigned)(Rb * K + C_) * 2u; }
  const size_t kstep = (size_t)(BK * 2);
  const unsigned ldsw = (unsigned)wid * 1024u;
  const int aoff = lds_byte(wr * 64 + fr, fq * 8), boff = lds_byte(wc * 32 + fr, fq * 8);
#define G8_SA(b, h) (((b) * 2 + (h)) * HTB)
#define G8_SB(b, h) ((4 + (b) * 2 + (h)) * HTB)
#define G8_STAGE(bufoff, gbase, voff) do { _Pragma("unroll") for (int _i = 0; _i < 2; ++_i) \
    __builtin_amdgcn_global_load_lds((const unsigned*)(uni((const char*)(gbase)) + (voff)[_i]), (LAS unsigned*)(lds + (bufoff) + ldsw + _i * 8192), 16, 0, 0); } while (0)
#define G8_STAGEB(bufoff, gbase) do { _Pragma("unroll") for (int _i = 0; _i < 2; ++_i) \
    __builtin_amdgcn_global_load_lds((const unsigned*)(uni((const char*)(gbase)) + _i * bstep + voffB), (LAS unsigned*)(lds + (bufoff) + ldsw + _i * 8192), 16, 0, 0); } while (0)
#define G8_LDA(dst, b, h) do { _Pragma("unroll") for (int m = 0; m < 4; ++m) _Pragma("unroll") for (int k = 0; k < 2; ++k) dst[m][k] = *(const LAS bf16x8*)(lds + G8_SA(b, h) + aoff + m * 2048 + k * 1024); } while (0)
#define G8_LDB(dst, b, h) do { _Pragma("unroll") for (int n = 0; n < 2; ++n) _Pragma("unroll") for (int k = 0; k < 2; ++k) dst[n][k] = *(const LAS bf16x8*)(lds + G8_SB(b, h) + boff + n * 2048 + k * 1024); } while (0)
#define G8_MMA(ai, bj, At, Bt) do { __builtin_amdgcn_s_setprio(1); _Pragma("unroll") for (int m = 0; m < 4; ++m) _Pragma("unroll") for (int n = 0; n < 2; ++n) _Pragma("unroll") for (int k = 0; k < 2; ++k) \
    acc[ai][bj][m][n] = __builtin_amdgcn_mfma_f32_16x16x32_bf16(Bt[n][k], At[m][k], acc[ai][bj][m][n], 0, 0, 0); __builtin_amdgcn_s_setprio(0); } while (0)
#define G8_WAIT_V(n) asm volatile("s_waitcnt vmcnt(" #n ")" ::: "memory")
#define G8_WAIT_L(n) asm volatile("s_waitcnt lgkmcnt(" #n ")" ::: "memory")
#define G8_BAR __builtin_amdgcn_s_barrier()
#define G8_SCHED __builtin_amdgcn_sched_barrier(0)
  Unit cur, nxt, nn; int ui = 0;
  if (!S.next(0, cur)) return;
  f32x4 acc[2][2][4][2];
#pragma unroll
  for (int a = 0; a < 2; ++a)
#pragma unroll
    for (int b = 0; b < 2; ++b)
#pragma unroll
      for (int m = 0; m < 4; ++m)
#pragma unroll
        for (int n = 0; n < 2; ++n) acc[a][b][m][n] = f32x4{0.f, 0.f, 0.f, 0.f};
  bf16x8 At[4][2], B0[2][2], B1[2][2];
  const char* Ab = (const char*)Aptr;
  unsigned gc0[2], gc1[2], gn0[2], gn1[2];
  bool has_next = S.next(1, nxt);
#pragma unroll
  for (int i = 0; i < 2; ++i) {
    int R_, C_; stage_rc(tid * 16 + i * 8192, R_, C_);
    gc0[i] = (unsigned)(((long)rowof(cur, R_) * K + C_) * 2);
    gc1[i] = (unsigned)(((long)rowof(cur, 128 + R_) * K + C_) * 2);
    gn0[i] = gc0[i]; gn1[i] = gc1[i];
    if (has_next) {
      gn0[i] = (unsigned)(((long)rowof(nxt, R_) * K + C_) * 2);
      gn1[i] = (unsigned)(((long)rowof(nxt, 128 + R_) * K + C_) * 2);
    }
  }
  const long b1d = S.b1delta;
  const char* cB0 = cur.b0;
#define cB1 (cB0 + b1d)
#define nB1 (nB0 + b1d)
  __syncthreads();
  G8_STAGE(G8_SB(0, 0), cB0, voffB); G8_STAGE(G8_SA(0, 0), Ab, gc0); G8_STAGE(G8_SB(0, 1), cB1, voffB); G8_STAGE(G8_SA(0, 1), Ab, gc1);
  if (wr == 1) G8_BAR;
  G8_WAIT_V(4); G8_BAR;
  G8_STAGE(G8_SB(1, 0), cB0 + kstep, voffB); G8_STAGE(G8_SA(1, 0), Ab + kstep, gc0); G8_STAGE(G8_SB(1, 1), cB1 + kstep, voffB);
  G8_WAIT_V(6); G8_BAR;
  for (;;) {
    const char* nB0 = has_next ? nxt.b0 : cB0;
    for (int t = 0; t < nt; t += 2) {
      const bool last = (t == nt - 2);
      const bool first = (t == 0) && (ui > 0);
      const char* a1 = Ab + (size_t)(t + 1) * kstep;
      const char* a2 = last ? Ab : Ab + (size_t)(t + 2) * kstep;
      const char* b20 = last ? nB0 : cB0 + (size_t)(t + 2) * kstep; const char* b21 = last ? nB1 : cB1 + (size_t)(t + 2) * kstep;
      const char* a3 = a2 + kstep; const char* b30 = b20 + kstep; const char* b31 = b21 + kstep;
      G8_LDB(B0, 0, 0); G8_SCHED; G8_LDA(At, 0, 0); if (!first) G8_STAGE(G8_SA(1, 1), a1, gc1);
      G8_WAIT_L(8); G8_BAR; G8_WAIT_L(0); G8_MMA(0, 0, At, B0); G8_BAR; G8_SCHED;
      G8_LDB(B1, 0, 1); G8_STAGE(G8_SB(0, 0), b20, voffB);
      G8_BAR; G8_WAIT_L(0); G8_MMA(0, 1, At, B1); G8_BAR;
      G8_LDA(At, 0, 1); G8_STAGE(G8_SA(0, 0), a2, (last ? gn0 : gc0));
      G8_BAR; G8_WAIT_L(0); G8_MMA(1, 0, At, B0); G8_BAR; G8_SCHED;
      G8_STAGE(G8_SB(0, 1), b21, voffB);
      if (first) { if (Epi::NST == 16) G8_WAIT_V(22); else G8_WAIT_V(14); } else G8_WAIT_V(6);
      G8_BAR; G8_MMA(1, 1, At, B1); G8_BAR;
      G8_LDB(B0, 1, 0); G8_SCHED; G8_LDA(At, 1, 0); G8_STAGE(G8_SA(0, 1), a2, (last ? gn1 : gc1));
      G8_WAIT_L(8); G8_BAR; G8_WAIT_L(0); G8_MMA(0, 0, At, B0); G8_BAR; G8_SCHED;
      G8_LDB(B1, 1, 1); G8_STAGE(G8_SB(1, 0), b30, voffB);
      G8_BAR; G8_WAIT_L(0); G8_MMA(0, 1, At, B1); G8_BAR;
      G8_LDA(At, 1, 1); G8_STAGE(G8_SA(1, 0), a3, (last ? gn0 : gc0));
      G8_BAR; G8_WAIT_L(0); G8_MMA(1, 0, At, B0); G8_BAR; G8_SCHED;
      G8_STAGE(G8_SB(1, 1), b31, voffB);
      G8_WAIT_V(6); G8_BAR; G8_MMA(1, 1, At, B1); G8_BAR;
    }
    G8_SCHED;
    typename Epi::Pre epre;
    E.load(epre, cur, wr, wc, fr, fq);
    G8_SCHED;
    G8_STAGE(G8_SA(1, 1), Ab + kstep, gn1);
    bool has_nn = false;
    if (has_next) has_nn = S.next(ui + 2, nn);
    int rq[4] = {0, 0, 0, 0};
    if (RowOf::GATHER && has_nn) {
#pragma unroll
      for (int i = 0; i < 2; ++i) {
        int R_, C_; stage_rc(tid * 16 + i * 8192, R_, C_);
        const int* q0 = rowof.addr(nn, R_); const int* q1 = rowof.addr(nn, 128 + R_);
        asm volatile("global_load_dword %0, %1, off" : "=v"(rq[i]) : "v"(q0) : "memory");
        asm volatile("global_load_dword %0, %1, off" : "=v"(rq[2 + i]) : "v"(q1) : "memory");
      }
    }
    G8_SCHED;
    E(acc, cur, epre, wr, wc, fr, fq);
    G8_SCHED;
#ifdef G8_EPI2
    E(acc, cur, epre, wr, wc, fr, fq);
    G8_SCHED;
#endif
    if (!has_next) break;
#pragma unroll
    for (int a = 0; a < 2; ++a)
#pragma unroll
      for (int b = 0; b < 2; ++b)
#pragma unroll
        for (int m = 0; m < 4; ++m)
#pragma unroll
          for (int n = 0; n < 2; ++n) acc[a][b][m][n] = f32x4{0.f, 0.f, 0.f, 0.f};
    cur = nxt; cB0 = nB0; ++ui;
#pragma unroll
    for (int i = 0; i < 2; ++i) { gc0[i] = gn0[i]; gc1[i] = gn1[i]; }
    if (has_nn) {
      if (RowOf::GATHER) {
        if (Epi::NST == 16) asm volatile("s_waitcnt vmcnt(16)" : "+v"(rq[0]), "+v"(rq[1]), "+v"(rq[2]), "+v"(rq[3]) :: "memory");
        else asm volatile("s_waitcnt vmcnt(8)" : "+v"(rq[0]), "+v"(rq[1]), "+v"(rq[2]), "+v"(rq[3]) :: "memory");
      }
#pragma unroll
      for (int i = 0; i < 2; ++i) {
        int R_, C_; stage_rc(tid * 16 + i * 8192, R_, C_);
        const int r0 = RowOf::GATHER ? rq[i] : rowof(nn, R_), r1 = RowOf::GATHER ? rq[2 + i] : rowof(nn, 128 + R_);
        gn0[i] = (unsigned)(((long)r0 * K + C_) * 2);
        gn1[i] = (unsigned)(((long)r1 * K + C_) * 2);
      }
    }
    nxt = nn; has_next = has_nn;
  }
  G8_WAIT_V(0);
  if (wr == 0) G8_BAR;
  G8_BAR;
#undef cB1
#undef nB1
#undef G8_SA
#undef G8_SB
#undef G8_STAGE
#undef G8_STAGEB
#undef G8_LDA
#undef G8_LDB
#undef G8_MMA
#undef G8_WAIT_V
#undef G8_WAIT_L
#undef G8_BAR
#undef G8_SCHED
}
}
struct DenseSched {
  const u16* Bt; int ntn, nunits, G, c, K, lat_only;
  long b1delta;
  __device__ __forceinline__ bool next(int i, g8::Unit& u) const {
    const long L = (long)i * G + c;
    if (L >= nunits) return false;
    const int nM = lat_only ? T / 256 - 2 : T / 256, nN = ntn, nwg = nunits;
    int wgid = (int)L;
    { const int q = nwg / 8, r = nwg % 8, xcd = wgid % 8, off = wgid / 8; wgid = (xcd < r ? xcd * (q + 1) : r * (q + 1) + (xcd - r) * q) + off; }
    const int nig = 8 * nN, gid = wgid / nig, fm = gid * 8, gsz = (nM - fm) < 8 ? (nM - fm) : 8;
    int pm = fm + ((wgid % nig) % gsz); const int pn = (wgid % nig) / gsz;
    if (lat_only) pm = pm < 64 ? pm + 1 : pm + 2;
    u.b0 = (const char*)(Bt + (long)(pn * 256) * K);
    u.i0 = pm * 256; u.i1 = pn * 256; u.i2 = 0; u.i3 = 0;
    return true;
  }
};
struct DenseRow { static constexpr bool GATHER = false;
  __device__ __forceinline__ int operator()(const g8::Unit& u, int r) const { return u.i0 + r; }
  __device__ __forceinline__ const int* addr(const g8::Unit&, int) const { return nullptr; } };
struct DenseEpi {
  static constexpr int NST = 16;
  u16* z; u16* tmp; u16* trash; int N, mode;
  struct Pre {};
  __device__ __forceinline__ void load(Pre&, const g8::Unit&, int, int, int, int) const {}
  __device__ __forceinline__ void operator()(const f32x4 (&acc)[2][2][4][2], const g8::Unit& u, const Pre&, int wr, int wc, int fr, int fq) const {
#pragma unroll
    for (int ai = 0; ai < 2; ++ai)
#pragma unroll
      for (int m = 0; m < 4; ++m) {
        const long row = u.i0 + ai * 128 + wr * 64 + m * 16 + fr;
#pragma unroll
        for (int bj = 0; bj < 2; ++bj) {
          const int col = u.i1 + bj * 128 + wc * 32 + fq * 8;
          const f32x4 v0 = acc[ai][bj][m][0], v1 = acc[ai][bj][m][1];
          uint4 o; o.x = pack2(v0[0], v0[1]); o.y = pack2(v0[2], v0[3]); o.z = pack2(v1[0], v1[1]); o.w = pack2(v1[2], v1[3]);
          u16* dst = mode == 0 ? (col < N ? z + row * N + col : trash + ((row & 255) * 1024 + (col & 1023))) : tmp + row * D + col;
          *reinterpret_cast<uint4*>(dst) = o;
        }
      }
  }
};
__device__ __forceinline__ void phase_gemm_dense8(const Params& p, const u16* Bt, int Npad, int N, int mode, int lat_only = 0) {
  DenseSched S; S.Bt = Bt; S.ntn = Npad / 256; S.lat_only = lat_only; S.nunits = (lat_only ? T / 256 - 2 : T / 256) * S.ntn; S.G = gridDim.x; S.c = blockIdx.x; S.K = D; S.b1delta = (long)128 * D * 2;
  DenseEpi E; E.z = p.zbuf; E.tmp = p.tmp; E.trash = p.trash; E.N = N; E.mode = mode;
  g8::gemm_phase(p.abuf, D, S, DenseRow(), E);
}

struct MoeTab8 { int tstart[33]; int base[33]; };
__device__ __forceinline__ MoeTab8* moe_tab8(const Params& p, int layer) {
  MoeTab8* tab = (MoeTab8*)(smem_raw + 131072 + 1024);
  __syncthreads();
  if (threadIdx.x == 0) {
    int run = 0, trun = 0;
    for (int e = 0; e < NE; ++e) {
      int cnt = p.cnt[CNTI(layer, 0, e)];
      tab->base[e] = run; tab->tstart[e] = trun;
      run += cnt; trun += (cnt + 255) >> 8;
    }
    tab->base[32] = run; tab->tstart[32] = trun;
  }
  __syncthreads();
  return tab;
}
struct MoeSched {
  const MoeTab8* tab; const u16* W; int NU, G, c, which;
  long b1delta;
  __device__ __forceinline__ bool next(int i, g8::Unit& u) const {
    const long L = (long)i * G + c;
    const int ntiles = __builtin_amdgcn_readfirstlane(tab->tstart[32]);
    const int nun = ntiles * NU;
    if (L >= (long)nun) return false;
    int wg = (int)L;
    { const int q = nun / 8, r = nun % 8, xcd = wg % 8, off = wg / 8; wg = (xcd < r ? xcd * (q + 1) : r * (q + 1) + (xcd - r) * q) + off; }
    const int ti = wg / NU, nu = wg % NU;
    int e = min(NE - 1, (int)(((long)ti * NE) / max(ntiles, 1)));
#pragma unroll 1
    while (e > 0 && ti < __builtin_amdgcn_readfirstlane(tab->tstart[e])) --e;
#pragma unroll 1
    while (e < NE - 1 && ti >= __builtin_amdgcn_readfirstlane(tab->tstart[e + 1])) ++e;
    const int mt = ti - __builtin_amdgcn_readfirstlane(tab->tstart[e]);
    const int be = __builtin_amdgcn_readfirstlane(tab->base[e]);
    const int cnt = __builtin_amdgcn_readfirstlane(tab->base[e + 1]) - be;
    u.i0 = be + mt * 256;
    u.i1 = min(256, cnt - mt * 256);
    u.i2 = e; u.i3 = nu;
    if (which == 0) {
      const u16* We = W + (long)e * 2048 * 1024;
      u.b0 = (const char*)(We + (long)(nu * 128) * 1024);
    } else {
      const u16* We = W + (long)e * 1024 * 1024;
      u.b0 = (const char*)(We + (long)(nu * 256) * 1024);
    }
    return true;
  }
};
struct Moe1Row { const int* slot_tok; static constexpr bool GATHER = true;
  __device__ __forceinline__ int operator()(const g8::Unit& u, int r) const { return slot_tok[u.i0 + min(r, u.i1 - 1)]; }
  __device__ __forceinline__ const int* addr(const g8::Unit& u, int r) const { return slot_tok + (u.i0 + min(r, u.i1 - 1)); } };
struct Moe2Row { static constexpr bool GATHER = false;
  __device__ __forceinline__ int operator()(const g8::Unit& u, int r) const { return u.i0 + min(r, u.i1 - 1); }
  __device__ __forceinline__ const int* addr(const g8::Unit&, int) const { return nullptr; } };
struct Moe1Epi {
  static constexpr int NST = 8;
  u16* act; u16* trash; const float* b_in;
  struct Pre { float4 g0, g1, l0, l1; };
  __device__ __forceinline__ void load(Pre& q, const g8::Unit& u, int wr, int wc, int fr, int fq) const {
    const float* bi = b_in + (long)u.i2 * 2048;
    const int ca = u.i3 * 128 + wc * 32 + fq * 8;
    q.g0 = *reinterpret_cast<const float4*>(bi + ca); q.g1 = *reinterpret_cast<const float4*>(bi + ca + 4);
    q.l0 = *reinterpret_cast<const float4*>(bi + 1024 + ca); q.l1 = *reinterpret_cast<const float4*>(bi + 1024 + ca + 4);
  }
  __device__ __forceinline__ void operator()(const f32x4 (&acc)[2][2][4][2], const g8::Unit& u, const Pre& q, int wr, int wc, int fr, int fq) const {
    const int ca = u.i3 * 128 + wc * 32 + fq * 8;
    const fl2_t bg2[4] = {{q.g0.x, q.g0.y}, {q.g0.z, q.g0.w}, {q.g1.x, q.g1.y}, {q.g1.z, q.g1.w}};
    const fl2_t bl2[4] = {{q.l0.x, q.l0.y}, {q.l0.z, q.l0.w}, {q.l1.x, q.l1.y}, {q.l1.z, q.l1.w}};
    const fl2_t one2 = {1.0f, 1.0f}, sc2 = {-2.4554669595929157f, -2.4554669595929157f};
#pragma unroll
    for (int ai = 0; ai < 2; ++ai)
#pragma unroll
      for (int m = 0; m < 4; ++m) {
        const int r = ai * 128 + wr * 64 + m * 16 + fr;
        uint4 o;
        unsigned ow[4];
#pragma unroll
        for (int n = 0; n < 2; ++n)
#pragma unroll
          for (int jp = 0; jp < 2; ++jp) {
            fl2_t g = fl2_t{acc[ai][0][m][n][2 * jp], acc[ai][0][m][n][2 * jp + 1]} + bg2[n * 2 + jp];
            fl2_t l = fl2_t{acc[ai][1][m][n][2 * jp], acc[ai][1][m][n][2 * jp + 1]} + bl2[n * 2 + jp];
            g.x = fminf(g.x, 7.0f); g.y = fminf(g.y, 7.0f);
            l.x = fminf(fmaxf(l.x, -7.0f), 7.0f); l.y = fminf(fmaxf(l.y, -7.0f), 7.0f);
            fl2_t e = g * sc2;
            e.x = __builtin_amdgcn_exp2f(e.x); e.y = __builtin_amdgcn_exp2f(e.y);
            e = e + one2;
            fl2_t s = {__builtin_amdgcn_rcpf(e.x), __builtin_amdgcn_rcpf(e.y)};
            const fl2_t v = (g * s) * (l + one2);
            ow[n * 2 + jp] = __builtin_bit_cast(unsigned, __builtin_convertvector(v, bf2_t));
          }
        o.x = ow[0]; o.y = ow[1]; o.z = ow[2]; o.w = ow[3];
        *reinterpret_cast<uint4*>(r < u.i1 ? act + (long)(u.i0 + r) * D + ca : trash + (r * 1024 + (ca & 1023))) = o;
      }
  }
};
struct Moe2Epi {
  static constexpr int NST = 16;
  u16* oslot; u16* trash; const float* b_out; const float* slot_gw;
  struct Pre { float4 b[2][2]; float gw[8]; };
  __device__ __forceinline__ void load(Pre& q, const g8::Unit& u, int wr, int wc, int fr, int fq) const {
    const float* bo = b_out + (long)u.i2 * 1024;
#pragma unroll
    for (int bj = 0; bj < 2; ++bj) {
      const int cc = u.i3 * 256 + bj * 128 + wc * 32 + fq * 8;
      q.b[bj][0] = *reinterpret_cast<const float4*>(bo + cc); q.b[bj][1] = *reinterpret_cast<const float4*>(bo + cc + 4);
    }
#pragma unroll
    for (int ai = 0; ai < 2; ++ai)
#pragma unroll
      for (int m = 0; m < 4; ++m) q.gw[ai * 4 + m] = slot_gw[u.i0 + min(ai * 128 + wr * 64 + m * 16 + fr, u.i1 - 1)];
  }
  __device__ __forceinline__ void operator()(const f32x4 (&acc)[2][2][4][2], const g8::Unit& u, const Pre& q, int wr, int wc, int fr, int fq) const {
#pragma unroll
    for (int ai = 0; ai < 2; ++ai)
#pragma unroll
      for (int m = 0; m < 4; ++m) {
        const int r = ai * 128 + wr * 64 + m * 16 + fr;
        const bool ok = r < u.i1;
        const float gw = q.gw[ai * 4 + m];
#pragma unroll
        for (int bj = 0; bj < 2; ++bj) {
          const int cc = u.i3 * 256 + bj * 128 + wc * 32 + fq * 8;
          const float4 b0 = q.b[bj][0], b1 = q.b[bj][1];
          const f32x4 v0 = acc[ai][bj][m][0], v1 = acc[ai][bj][m][1];
          const fl2_t g2 = {gw, gw};
          const fl2_t o0 = (fl2_t{v0[0], v0[1]} + fl2_t{b0.x, b0.y}) * g2, o1 = (fl2_t{v0[2], v0[3]} + fl2_t{b0.z, b0.w}) * g2;
          const fl2_t o2 = (fl2_t{v1[0], v1[1]} + fl2_t{b1.x, b1.y}) * g2, o3 = (fl2_t{v1[2], v1[3]} + fl2_t{b1.z, b1.w}) * g2;
          uint4 o;
          o.x = __builtin_bit_cast(unsigned, __builtin_convertvector(o0, bf2_t)); o.y = __builtin_bit_cast(unsigned, __builtin_convertvector(o1, bf2_t));
          o.z = __builtin_bit_cast(unsigned, __builtin_convertvector(o2, bf2_t)); o.w = __builtin_bit_cast(unsigned, __builtin_convertvector(o3, bf2_t));
          *reinterpret_cast<uint4*>(ok ? oslot + (long)(u.i0 + r) * D + cc : trash + (r * 1024 + cc)) = o;
        }
      }
  }
};
__device__ __forceinline__ void phase_moe_gemm1_8(const Params& p, int layer) {
  const MoeTab8* tab = moe_tab8(p, layer);
  MoeSched S; S.tab = tab; S.W = p.MoeInT + (long)layer * 32 * 2048 * 1024; S.NU = 8; S.G = gridDim.x; S.c = blockIdx.x; S.which = 0; S.b1delta = (long)1024 * 1024 * 2;
  Moe1Row R; R.slot_tok = p.slot_tok;
  Moe1Epi E; E.act = p.act; E.trash = p.trash; E.b_in = p.moe_b_in + (long)layer * 32 * 2048;
  g8::gemm_phase(p.abuf, D, S, R, E);
}
__device__ __forceinline__ void phase_moe_gemm2_8(const Params& p, int layer) {
  const MoeTab8* tab = moe_tab8(p, layer);
  MoeSched S; S.tab = tab; S.W = p.MoeOutT + (long)layer * 32 * 1024 * 1024; S.NU = 4; S.G = gridDim.x; S.c = blockIdx.x; S.which = 1; S.b1delta = (long)128 * 1024 * 2;
  Moe2Epi E; E.oslot = p.oslot; E.trash = p.trash; E.b_out = p.moe_b_out + (long)layer * 32 * 1024; E.slot_gw = p.slot_gw;
  g8::gemm_phase(p.act, D, S, Moe2Row(), E);
}
__device__ __forceinline__ void phase_gemm_dense(const Params& p, const u16* Bt, int Npad, int N, int mode) {
  const int ntn = Npad / 256;
  const int tiles = (T / 128) * ntn;
  const int tid = opaque_tid(), wid = tid >> 6, lane = tid & 63, wr = wid >> 1, wc = wid & 1, fr = lane & 15, fq = lane >> 4;
  for (int t = VBID; t < tiles; t += NVB) {
    const int mt = t / ntn, nt = t % ntn;
    f32x4 acc[4][8];
    gemm_tile(p.abuf, D, Bt, D, D, [&](int r) { return mt * 128 + r; }, [&](int r) { return nt * 256 + r; }, acc);
#pragma unroll
    for (int m = 0; m < 4; ++m)
#pragma unroll
      for (int n = 0; n < 8; ++n) {
        const long row = mt * 128 + wr * 64 + m * 16 + fr;
        const int col = nt * 256 + wc * 128 + n * 16 + fq * 4;
        if (mode == 0) {
          if (col < N) {
            uint2 o; o.x = pack2(acc[m][n][0], acc[m][n][1]); o.y = pack2(acc[m][n][2], acc[m][n][3]);
            *reinterpret_cast<uint2*>(p.zbuf + row * N + col) = o;
          }
        } else {
          { uint2 o; o.x = pack2(acc[m][n][0], acc[m][n][1]); o.y = pack2(acc[m][n][2], acc[m][n][3]); *reinterpret_cast<uint2*>(p.tmp + row * D + col) = o; }
        }
      }
  }
}

#ifndef WSLP_G
#define WSLP_G 0
#endif
#ifndef WSLP_R
#define WSLP_R 0
#endif
#ifndef RW_LATE
#define RW_LATE 1
#endif
#ifndef RW_WF
#define RW_WF 4
#endif
#ifndef GDN_WF
#define GDN_WF 0
#endif
#ifndef GDN_LATE
#define GDN_LATE 100
#endif
#ifndef REP_MOE
#define REP_MOE 1
#endif
#ifndef REP_DENSE
#define REP_DENSE 1
#endif
#ifndef REP_PREP
#define REP_PREP 1
#endif
#ifndef REP_SCAN
#define REP_SCAN 1
#endif
#ifndef REP_W
#define REP_W 1
#endif
#ifndef PREP_SKEW
#define PREP_SKEW 0
#endif
#ifndef REP_PREP_R
#define REP_PREP_R 1
#endif
#ifndef REP_PREP_G
#define REP_PREP_G 1
#endif
#ifndef REP_POST
#define REP_POST 1
#endif
#ifndef REP_COMB
#define REP_COMB 1
#endif
#ifndef REP_ROW
#define REP_ROW 1
#endif
#ifndef REP_POOL
#define REP_POOL 1
#endif
__global__ void __launch_bounds__(512, 2) mega(Params p) {
  cg::grid_group grid = cg::this_grid();
  volatile LAS unsigned* xbst = (volatile LAS unsigned*)(smem_raw + LDS_BYTES - 16);
  if (threadIdx.x == 0) { xbst[0] = 0u; xbst[1] = 0u; xbst[2] = 0u; xbst[3] = 0u; }
  __syncthreads();
  const XcdBarrier xb = xcd_barrier_post(p.bar, xbst);
  for (int rep = 0; rep < REP_W; ++rep) phase_weights(p, 0, p.early_tiles, VBID, NVB);
  phase_mods_partial(p);
  if (p.total_tiles < 0) grid.sync();
  xcd_barrier(xb);
  phase_mods_reduce(p);
  xcd_barrier(xb);
  for (int rep = 0; rep < REP_ROW; ++rep) phase_norm_in(p, 0, true);
  xcd_barrier(xb);
  for (int rep = 0; rep < REP_DENSE; ++rep) phase_gemm_dense8(p, p.WabT, AB_PAD, AB_IN, 0);
  xcd_barrier(xb);
  constexpr int RW_S0 = RW_LATE ? RW_CUT : NCH;
  static_assert(RW_S0 * NB * 12 * 2 <= RW_N0_ && RW_S0 % 5 == 0, "every item of the scan's first part must be prepared in the prep phase");
  for (int rep = 0; rep < REP_PREP_R; ++rep) { if (half_id()) rwkv_prep_all<1, false>(p); else rwkv_prep_all<0, false>(p); }
  xcd_barrier(xb);
  {
#define RW_WSPLIT (p.early_tiles + ((int)(((long)(p.mid_tiles - p.early_tiles) * RW_WF) / 5) & ~15))
#pragma unroll 1
    for (int part = 0; part < (RW_LATE ? 2 : 1); ++part) {
      if (blockIdx.x < 48) {
        const int s_begin = part ? RW_S0 : 0, s_end = part ? NCH : RW_S0;
        if (half_id() == 0) rwkv_scan_block(p, blockIdx.x, s_begin, s_end); else rwkv_scan_copy(p, blockIdx.x, s_begin, s_end);
      } else if (part == 0) {
        if (RW_LATE) { if (half_id()) rwkv_prep_all<1, true>(p); else rwkv_prep_all<0, true>(p); }
        for (int rep = 0; rep < REP_POOL; ++rep)
        for (int it = VBID - 96; it < NB * 260 * 4; it += NVB - 96) {
          int g = it & 3, r = it >> 2;
          int rb = r % 260, b = r / 260;
          pool_item(p, b, rb, g);
        }
        phase_weights<WSLP_R>(p, p.early_tiles, RW_LATE ? RW_WSPLIT : p.mid_tiles, VBID - 96, NVB - 96);
      } else {
        phase_weights<WSLP_R>(p, RW_WSPLIT, p.mid_tiles, VBID - 96, NVB - 96);
      }
      xcd_barrier(xb);
    }
  }
  for (int rep = 0; rep < REP_ROW; ++rep)
  for (int it = VBID; it < NB * NCH * 12; it += NVB) {
    int h = it % 12, r = it / 12;
    int c = r % NCH, b = r / NCH;
    rwkv_out_item(p, b, c, h);
  }
  xcd_barrier(xb);
  for (int rep = 0; rep < REP_DENSE; ++rep) phase_gemm_dense8(p, p.WoutT, 1024, 1024, 1);
  xcd_barrier(xb);
  for (int rep = 1; rep < REP_POST; ++rep) phase_post_mixer(p, 0, true);
  phase_post_mixer(p, 0);
  xcd_barrier(xb);
  phase_moe_scatter(p, 0);
  xcd_barrier(xb);
  for (int rep = 0; rep < REP_MOE; ++rep) { phase_moe_gemm1_8(p, 0);
  xcd_barrier(xb);
  phase_moe_gemm2_8(p, 0); if (rep + 1 < REP_MOE) xcd_barrier(xb); }
  xcd_barrier(xb);
  for (int rep = 1; rep < REP_COMB; ++rep) phase_moe_combine(p, 0, true);
  phase_moe_combine(p, 0);
  xcd_barrier(xb);
  for (int rep = 0; rep < REP_DENSE; ++rep) phase_gemm_dense8(p, p.WgdnT, GDN_PAD, GDN_IN, 0);
  xcd_barrier(xb);
  constexpr int GDN_S0 = GDN_S0_;
  for (int rep = 0; rep < REP_PREP_G; ++rep) { if (half_id()) gdn_prep_all<1, false>(p); else gdn_prep_all<0, false>(p); }
  xcd_barrier(xb);
  {
    const int bx = blockIdx.x, sid2 = (((bx & 7) + 8 * (bx >> 4)) << 1) | ((bx >> 3) & 1);
#define GDN_WSPLIT (p.mid_tiles + ((int)(((long)(p.total_tiles - p.mid_tiles) * GDN_WF) / 5) & ~15))
#pragma unroll 1
    for (int part = 0; part < (GDN_LATE ? 2 : 1); ++part) {
      if (blockIdx.x < 64) {
        const int s_begin = part ? GDN_S0 : 0, s_end = part ? NCH : GDN_S0;
        if (half_id() == 0) gdn_scan_compute(p, sid2, s_begin, s_end); else gdn_scan_loader(p, sid2, s_begin, s_end);
      } else if (part == 0) {
        if (half_id()) gdn_prep_all<1, true>(p); else gdn_prep_all<0, true>(p);
        phase_weights<WSLP_G>(p, p.mid_tiles, GDN_LATE ? GDN_WSPLIT : p.total_tiles, VBID - 128, NVB - 128);
      } else {
        phase_weights<WSLP_G>(p, GDN_WSPLIT, p.total_tiles, VBID - 128, NVB - 128);
      }
      xcd_barrier(xb);
    }
  }
  for (int rep = 0; rep < REP_ROW; ++rep) phase_gdn_out(p);
  xcd_barrier(xb);
  for (int rep = 0; rep < REP_DENSE; ++rep) phase_gemm_dense8(p, p.WoutT + 1024 * 1024, 1024, 1024, 1, 1);
  xcd_barrier(xb);
  for (int rep = 1; rep < REP_POST; ++rep) phase_post_mixer(p, 1, true);
  phase_post_mixer(p, 1);
  xcd_barrier(xb);
  phase_moe_scatter(p, 1);
  xcd_barrier(xb);
  for (int rep = 0; rep < REP_MOE; ++rep) { phase_moe_gemm1_8(p, 1);
  xcd_barrier(xb);
  phase_moe_gemm2_8(p, 1); if (rep + 1 < REP_MOE) xcd_barrier(xb); }
  xcd_barrier(xb);
  for (int rep = 1; rep < REP_COMB; ++rep) phase_moe_combine(p, 1, true);
  phase_moe_combine(p, 1);
}

extern "C" void kernel_launch(void* const* d_in, const int* in_sizes, int n_in, void* d_out, int out_size, void* d_ws,
                              size_t ws_size, hipStream_t stream) {
  static int grid_blocks = 0;
  if (!grid_blocks) {
    int dev = 0, cus = 0, per_cu = 0;
    (void)hipGetDevice(&dev);
    (void)hipDeviceGetAttribute(&cus, hipDeviceAttributeMultiprocessorCount, dev);
    (void)hipFuncSetAttribute((const void*)mega, hipFuncAttributeMaxDynamicSharedMemorySize, (int)LDS_BYTES);
    (void)hipOccupancyMaxActiveBlocksPerMultiprocessor(&per_cu, mega, 512, LDS_BYTES);
    if (per_cu > 1) per_cu = 1;
    if (per_cu < 1) per_cu = 1;
    grid_blocks = cus * per_cu;
  }
  Params p;
  memset(&p, 0, sizeof(p));
  const float** fp = (const float**)&p.x;
  for (int i = 0; i < 33; ++i) fp[i] = (const float*)d_in[i];
  p.out = (float*)d_out;
  char* ws = (char*)d_ws;
  size_t off = 0;
  auto take = [&](size_t bytes) { char* r = ws + off; off += (bytes + 255) & ~(size_t)255; return r; };
  p.cnt = (int*)take(32768);
  p.bar = (unsigned*)take((size_t)XCD_BAR_WORDS * 4);
  p.modpart = (float*)take((size_t)8 * 2 * 3 * 6144 * 4);
  p.mods = (float*)take((size_t)2 * 3 * 6144 * 4);
  p.WabT = (u16*)take((size_t)AB_PAD * 1024 * 2);
  p.WoutT = (u16*)take((size_t)2 * 1024 * 1024 * 2);
  p.WgdnT = (u16*)take((size_t)GDN_PAD * 1024 * 2);
  p.MoeInT = (u16*)take((size_t)64 * 2048 * 1024 * 2);
  p.MoeOutT = (u16*)take((size_t)64 * 1024 * 1024 * 2);
  p.WupT = (u16*)take((size_t)2 * 768 * 64 * 2);
  p.AupT = (u16*)take((size_t)2 * 768 * 64 * 2);
  p.GupT = (u16*)take((size_t)768 * 128 * 2);
  p.PoolT = (u16*)take((size_t)4 * 64 * 64 * 2);
  p.xs = (u16*)take((size_t)T * D * 2);
  p.abuf = (u16*)take((size_t)T * D * 2);
  p.zbuf = (u16*)take((size_t)T * GDN_IN * 2);
  p.tmp = p.zbuf;
  p.oslot = p.zbuf;
  p.prep = (u16*)take((size_t)NB * 8 * 2 * NCH * GD_ITEM * 2);
  p.act = p.prep;
  p.yf = (u16*)take((size_t)T * D * 2);
  p.yb = (u16*)take((size_t)T * D * 2);
  p.tok_e = (int*)take((size_t)T * 4 * 4);
  p.tok_gw = (float*)take((size_t)T * 4 * 4);
  p.tok_slot = (int*)take((size_t)T * 4 * 4);
  p.slot_tok = (int*)take((size_t)T * 4 * 4);
  p.slot_gw = (float*)take((size_t)T * 4 * 4);
  p.trash = (u16*)take((size_t)256 * 1024 * 2);
  if (off > ws_size) { fprintf(stderr, "workspace too small: need %zu have %zu\n", off, ws_size); return; }
  int ts = 0;
  auto fam = [&](int i, const float* src, u16* dst, int nmat, int K, int N, int Npad) {
    TFam& F = p.fam[i];
    F.src = src; F.dst = dst; F.nmat = nmat; F.K = K; F.N = N; F.Npad = Npad;
    F.sstride = (long)K * N; F.dstride = (long)Npad * K;
    F.tiles_per_mat = (K / 64) * (Npad / 64); F.tile_start = ts;
    ts += nmat * F.tiles_per_mat;
  };
  fam(0, p.ab_w_in, p.WabT, 1, 1024, AB_IN, AB_PAD);
  fam(1, p.w_out, p.WoutT, 2, 1024, 1024, 1024);
  fam(2, p.gdn_w_in, p.WgdnT, 1, 1024, GDN_IN, GDN_PAD);
  fam(3, p.rwkv_w_up, p.WupT, 2, 64, 768, 768);
  fam(4, p.rwkv_a_up, p.AupT, 2, 64, 768, 768);
  fam(5, p.rwkv_g_up, p.GupT, 1, 128, 768, 768);
  fam(6, p.pool_w, p.PoolT, 4, 64, 64, 64);
  p.early_tiles = ts;
  fam(7, p.moe_w_in, p.MoeInT, 32, 1024, 2048, 2048);
  fam(8, p.moe_w_out, p.MoeOutT, 32, 1024, 1024, 1024);
  p.mid_tiles = ts;
  fam(9, p.moe_w_in + (size_t)32 * 1024 * 2048, p.MoeInT + (size_t)32 * 2048 * 1024, 32, 1024, 2048, 2048);
  fam(10, p.moe_w_out + (size_t)32 * 1024 * 1024, p.MoeOutT + (size_t)32 * 1024 * 1024, 32, 1024, 1024, 1024);
  p.total_tiles = ts;
  (void)hipMemsetAsync(p.cnt, 0, 32768 + ((XCD_BAR_WORDS * 4 + 255) & ~255), stream);
  void* args[] = {&p};
  hipError_t e = hipLaunchCooperativeKernel((void*)mega, dim3(grid_blocks), dim3(512), args, LDS_BYTES, stream);
  if (e != hipSuccess) fprintf(stderr, "coop launch failed: %s (grid %d)\n", hipGetErrorString(e), grid_blocks);
}
```

```cpp
#include <hip/hip_runtime.h>
#include <hip/hip_cooperative_groups.h>
#include <cstdio>
#include <cstdint>
#include <cstring>
namespace cg = cooperative_groups;

typedef unsigned short u16;
using bf16x8 = __attribute__((ext_vector_type(8))) short;
using f32x4 = __attribute__((ext_vector_type(4))) float;
using u16x4 = __attribute__((ext_vector_type(4))) unsigned short;
#define MFMA16(a, b, c) __builtin_amdgcn_mfma_f32_16x16x32_bf16(a, b, c, 0, 0, 0)

constexpr int D = 1024, NB = 2, SEQ = 16384, CTXL = 256, PB = SEQ + CTXL, T = NB * PB, NCH = PB / 64;
constexpr int AB_IN = 2944, AB_PAD = 3072, GDN_IN = 4128, GDN_PAD = 4352, RWKV_IN = 2688;
constexpr int NE = 32, TOPK = 4;
constexpr int NTH = 256;
constexpr int LDS_HALF = 75776;
constexpr size_t LDS_BYTES = 2 * LDS_HALF;
constexpr int MB = 9216;
constexpr int RW_ITEM = 16384;
constexpr int GD_ITEM = 49152;

#define CNTI(layer, which, e) ((((layer) * 2 + (which)) * 32 + (e)) * 64)

struct TFam { const float* src; u16* dst; long sstride, dstride; int nmat, K, N, Npad, tiles_per_mat, tile_start; };

struct Params {
  const float *x, *c, *ctx, *c_ctx, *ada_w, *ada_b, *norm_g, *w_out, *ab_w_in, *ab_mu, *pool_w, *pool_scale,
      *rwkv_w0, *rwkv_w_up, *rwkv_a0, *rwkv_a_up, *rwkv_g_up, *rwkv_k_k, *rwkv_k_a, *rwkv_r_k, *rwkv_gn_w, *rwkv_gn_b,
      *gdn_w_in, *gdn_conv, *gdn_a_log, *gdn_dt_bias, *gdn_norm_g, *router_w, *router_b, *moe_w_in, *moe_b_in,
      *moe_w_out, *moe_b_out;
  float* out;
  int* cnt;
  unsigned* bar;
  float* modpart;
  float* mods;
  u16 *WabT, *WoutT, *WgdnT, *MoeInT, *MoeOutT, *WupT, *AupT, *GupT, *PoolT;
  u16* xs;
  u16* abuf;
  u16* zbuf;
  u16* tmp;
  u16* prep;
  u16 *yf, *yb;
  u16* act;
  u16* oslot;
  int* tok_e;
  float* tok_gw;
  int* tok_slot;
  int* slot_tok;
  float* slot_gw;
  u16* trash;
  TFam fam[11];
  int total_tiles;
  int early_tiles;
  int mid_tiles;
  int pad1;
};

typedef __bf16 bf2_t __attribute__((ext_vector_type(2)));
typedef float fl2_t __attribute__((ext_vector_type(2)));
__device__ __forceinline__ unsigned pack2(float a, float b) {
  fl2_t f = {a, b};
  bf2_t h = __builtin_convertvector(f, bf2_t);
  return __builtin_bit_cast(unsigned, h);
}
__device__ __forceinline__ u16 f2bf(float f) { return (u16)(pack2(f, 0.f) & 0xffffu); }
__device__ __forceinline__ float bf2f(u16 h) { return __uint_as_float(((unsigned)h) << 16); }
__device__ __forceinline__ float sigmoidf_(float x) { return __builtin_amdgcn_rcpf(1.0f + __expf(-x)); }
__device__ __forceinline__ float siluf_(float x) { return x * __builtin_amdgcn_rcpf(1.0f + __expf(-x)); }
__device__ __forceinline__ float softplusf_(float y) { return fmaxf(y, 0.0f) + __logf(1.0f + __expf(-fabsf(y))); }
__device__ __forceinline__ float tanhf_(float x) { return 2.0f * __builtin_amdgcn_rcpf(1.0f + __expf(-2.0f * x)) - 1.0f; }
typedef __bf16 bf2v_t __attribute__((ext_vector_type(2)));
__device__ __forceinline__ float dot2bf(unsigned a, unsigned b, float c) {
  return __builtin_amdgcn_fdot2_f32_bf16(__builtin_bit_cast(bf2v_t, a), __builtin_bit_cast(bf2v_t, b), c, false);
}
__device__ __forceinline__ float wave_sum(float v) {
#pragma unroll
  for (int o = 32; o > 0; o >>= 1) v += __shfl_xor(v, o);
  return v;
}
__device__ __forceinline__ float4 ld4bf(const u16* p) {
  uint2 a = *reinterpret_cast<const uint2*>(p);
  return make_float4(__uint_as_float(a.x << 16), __uint_as_float(a.x & 0xffff0000u), __uint_as_float(a.y << 16), __uint_as_float(a.y & 0xffff0000u));
}
__device__ __forceinline__ void st4bf(u16* p, float4 v) { uint2 o; o.x = pack2(v.x, v.y); o.y = pack2(v.z, v.w); *reinterpret_cast<uint2*>(p) = o; }
__device__ __forceinline__ void ld8(const u16* p, float* o) {
  uint4 v = *reinterpret_cast<const uint4*>(p);
  o[0] = __uint_as_float(v.x << 16); o[1] = __uint_as_float(v.x & 0xffff0000u);
  o[2] = __uint_as_float(v.y << 16); o[3] = __uint_as_float(v.y & 0xffff0000u);
  o[4] = __uint_as_float(v.z << 16); o[5] = __uint_as_float(v.z & 0xffff0000u);
  o[6] = __uint_as_float(v.w << 16); o[7] = __uint_as_float(v.w & 0xffff0000u);
}
__device__ __forceinline__ void st8(u16* p, const float* v) {
  uint4 o;
  o.x = pack2(v[0], v[1]); o.y = pack2(v[2], v[3]); o.z = pack2(v[4], v[5]); o.w = pack2(v[6], v[7]);
  *reinterpret_cast<uint4*>(p) = o;
}

extern __shared__ __attribute__((aligned(16))) unsigned char smem_raw[];
__device__ __forceinline__ int half_id() { return __builtin_amdgcn_readfirstlane((int)(threadIdx.x >> 8)); }
#define smem (smem_raw + half_id() * LDS_HALF)
#define VBID ((int)(blockIdx.x * 2 + half_id()))
#define NVB ((int)(gridDim.x * 2))
#define VBID_P(B0) ((int)((((blockIdx.x - (B0)) >> 1) * 2 + half_id()) * 2 + ((blockIdx.x - (B0)) & 1)))
__device__ __forceinline__ int opaque_tid() { int t = threadIdx.x; asm volatile("" : "+v"(t)); return t & 255; }


#define XB_TMO      128
#define XB_XCNT(j)  (256  + 64 * (j))
#define XB_XSUB(j)  (1280 + 64 * (j))
#define XB_XGEN(j)  (2304 + 64 * (j))
#define XB_TOP      3328
#define XB_TOPGEN   3392
#define XCD_BAR_WORDS 3456
#define XB_SPIN_CAP (1u << 22)
#ifndef REP_BAR
#define REP_BAR 1
#endif
#define LAS __attribute__((address_space(3)))
__device__ __forceinline__ unsigned xb_ld(unsigned* p) { return __hip_atomic_load(p, __ATOMIC_RELAXED, __HIP_MEMORY_SCOPE_AGENT); }
__device__ __forceinline__ unsigned xb_add(unsigned* p, unsigned v) { return __hip_atomic_fetch_add(p, v, __ATOMIC_RELAXED, __HIP_MEMORY_SCOPE_AGENT); }
__device__ __forceinline__ unsigned xb_xcc_id() { return (unsigned)__builtin_amdgcn_s_getreg((3 << 11) | 20) & 0xFu; }
#define XB_SPIN(cond, bar) do { unsigned _sp = 0; while (cond) { __builtin_amdgcn_s_sleep(1); \
    if ((++_sp & 255u) == 0u) { if (xb_ld(&(bar)[XB_TMO])) break; if (_sp > XB_SPIN_CAP) { atomicAdd(&(bar)[XB_TMO], 1u); break; } } } } while (0)
struct XcdBarrier { unsigned* bar; unsigned x; volatile LAS unsigned* st; };
__device__ __forceinline__ XcdBarrier xcd_barrier_post(unsigned* bar, volatile LAS unsigned* st) {
  XcdBarrier b; b.bar = bar; b.x = xb_xcc_id(); b.st = st;
  if (threadIdx.x == 0) (void)xb_add(&bar[XB_XCNT(b.x)], 1u);
  return b;
}
__device__ __forceinline__ void xcd_barrier_complete(unsigned* bar, unsigned x, unsigned& nloc, unsigned& nx) {
  const unsigned G = gridDim.x * gridDim.y * gridDim.z;
  unsigned sum, cnt, mine, sp = 0u;
  for (;;) {
    sum = 0u; cnt = 0u; mine = 0u;
#pragma unroll
    for (unsigned j = 0; j < 16; ++j) { const unsigned c = xb_ld(&bar[XB_XCNT(j)]); sum += c; cnt += (c > 0u) ? 1u : 0u; mine = (j == x) ? c : mine; }
    if (sum == G) break;
    __builtin_amdgcn_s_sleep(1);
    if ((++sp & 255u) == 0u) { if (xb_ld(&bar[XB_TMO])) break; if (sp > XB_SPIN_CAP) { atomicAdd(&bar[XB_TMO], 1u); break; } }
  }
  nloc = mine > 0u ? mine : 1u; nx = cnt > 0u ? cnt : 1u;
}
__device__ __forceinline__ void xcd_barrier1(const XcdBarrier& b) {
  asm volatile("s_waitcnt vmcnt(0)" ::: "memory");
  __syncthreads();
  if (threadIdx.x == 0) {
    unsigned* bar = b.bar;
    const unsigned bx = xb_xcc_id();
    __builtin_amdgcn_s_waitcnt(0);
    unsigned nloc = b.st[0], nx = b.st[1];
    if (nloc == 0u) { xcd_barrier_complete(bar, bx, nloc, nx); b.st[0] = nloc; b.st[1] = nx; }
    const unsigned old = xb_add(&bar[XB_XSUB(bx)], 1u);
    const unsigned gen = old / nloc;
    if (old + 1u == (gen + 1u) * nloc) {
      __builtin_amdgcn_fence(__ATOMIC_RELEASE, "agent");
      asm volatile("s_waitcnt vmcnt(0)" ::: "memory");
      const unsigned og = xb_add(&bar[XB_TOP], 1u);
      const unsigned tg = og / nx;
      if (og + 1u == (tg + 1u) * nx) xb_add(&bar[XB_TOPGEN], 1u);
      else XB_SPIN(xb_ld(&bar[XB_TOPGEN]) == tg, bar);
      __builtin_amdgcn_fence(__ATOMIC_ACQUIRE, "agent");
      xb_add(&bar[XB_XGEN(bx)], 1u);
      asm volatile("s_waitcnt vmcnt(0)" ::: "memory");
    } else {
      XB_SPIN(xb_ld(&bar[XB_XGEN(bx)]) == gen, bar);
      __builtin_amdgcn_fence(__ATOMIC_ACQUIRE, "agent");
      asm volatile("s_waitcnt vmcnt(0)" ::: "memory");
    }
  }
  __syncthreads();
}

__device__ __forceinline__ void xcd_barrier(const XcdBarrier& b) { for (int r = 0; r < REP_BAR; ++r) xcd_barrier1(b); }

template <int SLP = 0>
__device__ __forceinline__ void phase_weights(const Params& p, int t_begin, int t_end, int blk, int nblk) {
  float* tl = (float*)smem;
  const int tid = opaque_tid();
  for (int w = t_begin + blk; w < t_end; w += nblk) {
    int f = 0;
#pragma unroll
    for (int i = 1; i < 11; ++i) if (w >= p.fam[i].tile_start) f = i;
    const TFam& F = p.fam[f];
    int loc = w - F.tile_start;
    int mat = loc / F.tiles_per_mat, tt = loc % F.tiles_per_mat;
    int ntn = F.Npad / 64;
    int k0 = (tt / ntn) * 64, n0 = (tt % ntn) * 64;
    const float* src = F.src + (long)mat * F.sstride;
    u16* dst = F.dst + (long)mat * F.dstride;
#pragma unroll
    for (int i = 0; i < 4; ++i) {
      int k = (tid >> 4) + 16 * i, n4 = (tid & 15) * 4;
      float4 v = make_float4(0.f, 0.f, 0.f, 0.f);
      if (n0 + n4 < F.N) v = *reinterpret_cast<const float4*>(src + (long)(k0 + k) * F.N + n0 + n4);
      tl[k * 65 + n4 + 0] = v.x; tl[k * 65 + n4 + 1] = v.y; tl[k * 65 + n4 + 2] = v.z; tl[k * 65 + n4 + 3] = v.w;
    }
    __syncthreads();
    {
      int n = tid >> 2, kq = (tid & 3) * 16;
      float v[16];
#pragma unroll
      for (int i = 0; i < 16; ++i) v[i] = tl[(kq + i) * 65 + n];
      u16* d = dst + (long)(n0 + n) * F.K + k0 + kq;
      st8(d, v); st8(d + 8, v + 8);
    }
    if (SLP) __builtin_amdgcn_s_sleep(SLP);
    __syncthreads();
  }
}

__device__ __forceinline__ void phase_mods_partial(const Params& p) {
  float* sl = (float*)smem;
  const int tid = opaque_tid();
  for (int it = VBID; it < 384; it += NVB) {
    int ks = it / 48, cb = it % 48;
    int o = cb * 256 + tid;
    int layer = o / 6144, col = o % 6144;
    __syncthreads();
    if (tid < 128) {
      int k = ks * 128 + tid;
      sl[tid] = siluf_(p.c[k]); sl[128 + tid] = siluf_(p.c[1024 + k]); sl[256 + tid] = siluf_(p.c_ctx[k]);
    }
    __syncthreads();
    const float* w = p.ada_w + (long)layer * 1024 * 6144 + (long)(ks * 128) * 6144 + col;
    float s0 = 0.f, s1 = 0.f, s2 = 0.f;
#pragma unroll 8
    for (int k = 0; k < 128; ++k) {
      float wv = w[(long)k * 6144];
      s0 += sl[k] * wv; s1 += sl[128 + k] * wv; s2 += sl[256 + k] * wv;
    }
    float* dst = p.modpart + ((long)(ks * 2 + layer) * 3) * 6144 + col;
    dst[0] = s0; dst[6144] = s1; dst[2 * 6144] = s2;
  }
  __syncthreads();
}

__device__ __forceinline__ void phase_mods_reduce(const Params& p) {
  for (int o = VBID * NTH + (int)(threadIdx.x & 255); o < 2 * 3 * 6144; o += NVB * NTH) {
    int layer = o / (3 * 6144), rem = o % (3 * 6144), col = rem % 6144;
    float s = p.ada_b[layer * 6144 + col];
#pragma unroll
    for (int ks = 0; ks < 8; ++ks) s += p.modpart[(long)(ks * 2 + layer) * 3 * 6144 + rem];
    p.mods[o] = s;
  }
}

__device__ __forceinline__ const float* modp(const Params& p, int layer, int mrow, int which) {
  return p.mods + ((long)(layer * 3 + mrow) * 6 + which) * 1024;
}

__device__ __forceinline__ void phase_norm_in(const Params& p, int layer, bool first) {
  const int tid_ = opaque_tid(); const int lane = tid_ & 63, wid = tid_ >> 6;
  const float* g = p.norm_g + (long)(layer * 4 + 0) * 1024;
  for (int row = VBID * 4 + wid; row < T; row += NVB * 4) {
    int b = row / PB, pp = row % PB, mrow = pp < CTXL ? 2 : b;
    const float* src;
    if (first) src = pp < CTXL ? p.ctx + ((long)b * CTXL + pp) * D : p.x + ((long)b * SEQ + (pp - CTXL)) * D;
    else src = (const float*)p.xs + (long)row * D;
    float4 v[4];
    float ss = 0.f;
#pragma unroll
    for (int i = 0; i < 4; ++i) {
      v[i] = reinterpret_cast<const float4*>(src)[i * 64 + lane];
      ss += v[i].x * v[i].x + v[i].y * v[i].y + v[i].z * v[i].z + v[i].w * v[i].w;
    }
    ss = wave_sum(ss);
    float rstd = rsqrtf(ss * (1.0f / 1024.0f) + 1e-6f);
    const float* sh = modp(p, layer, mrow, 0);
    const float* sc = modp(p, layer, mrow, 1);
#pragma unroll
    for (int i = 0; i < 4; ++i) {
      int col = (i * 64 + lane) * 4;
      float4 gg = *reinterpret_cast<const float4*>(g + col);
      float4 s4 = *reinterpret_cast<const float4*>(sh + col);
      float4 c4 = *reinterpret_cast<const float4*>(sc + col);
      float h0 = v[i].x * rstd * gg.x * (1.f + c4.x) + s4.x;
      float h1 = v[i].y * rstd * gg.y * (1.f + c4.y) + s4.y;
      float h2 = v[i].z * rstd * gg.z * (1.f + c4.z) + s4.z;
      float h3 = v[i].w * rstd * gg.w * (1.f + c4.w) + s4.w;
      uint2 o; o.x = pack2(h0, h1); o.y = pack2(h2, h3);
      *reinterpret_cast<uint2*>(p.abuf + (long)row * D + col) = o;
    }
  }
}

#ifndef GP_DS
#define GP_DS 0
#endif
#ifndef GP_MFMA
#define GP_MFMA 0
#endif
__device__ __forceinline__ int swz4(int row) { return (0x78 >> (((row >> 2) & 3) * 2)) & 3; }
template <typename AMap, typename BMap>
__device__ __forceinline__ void gemm_tile(const u16* __restrict__ A, long lda, const u16* __restrict__ Bt, long ldb, int K,
                                          AMap amap, BMap bmap, f32x4 (&acc)[4][8]) {
  char* S = (char*)smem;
  const int tid = opaque_tid(), lane = tid & 63, fr = lane & 15, fq = lane >> 4;
  const int wid = __builtin_amdgcn_readfirstlane(tid >> 6), wr = wid >> 1, wc = wid & 1;
  const u16* pa[2];
  const u16* pb[4];
#pragma unroll
  for (int i = 0; i < 2; ++i) {
    const int q = i * 256 + tid, r = q >> 2, kc = (q & 3) ^ swz4(r);
    pa[i] = A + (long)amap(r) * lda + kc * 8;
  }
#pragma unroll
  for (int i = 0; i < 4; ++i) {
    const int q = i * 256 + tid, r = q >> 2, kc = (q & 3) ^ swz4(r);
    pb[i] = Bt + (long)bmap(r) * ldb + kc * 8;
  }
#pragma unroll
  for (int m = 0; m < 4; ++m)
#pragma unroll
    for (int n = 0; n < 8; ++n) acc[m][n] = f32x4{0.f, 0.f, 0.f, 0.f};
  const int nk = K / 32;
  int offA[4], offB[8];
#pragma unroll
  for (int m = 0; m < 4; ++m) { const int ra = wr * 64 + m * 16 + fr; offA[m] = ra * 64 + ((fq ^ swz4(ra)) << 4); }
#pragma unroll
  for (int n = 0; n < 8; ++n) { const int rb = wc * 128 + n * 16 + fr; offB[n] = 8192 + rb * 64 + ((fq ^ swz4(rb)) << 4); }
  __syncthreads();
#pragma unroll
  for (int t = 0; t < 2; ++t) {
    char* st = S + t * 24576;
#pragma unroll
    for (int i = 0; i < 2; ++i) __builtin_amdgcn_global_load_lds((const unsigned*)(pa[i] + t * 32), (LAS unsigned*)(st + (i * 256 + tid) * 16), 16, 0, 0);
#pragma unroll
    for (int i = 0; i < 4; ++i) __builtin_amdgcn_global_load_lds((const unsigned*)(pb[i] + t * 32), (LAS unsigned*)(st + 8192 + (i * 256 + tid) * 16), 16, 0, 0);
  }
  int cs = 0;
  for (int kt = 0; kt < nk; ++kt) {
    if (kt + 1 < nk) asm volatile("s_waitcnt vmcnt(6)" ::: "memory");
    else asm volatile("s_waitcnt vmcnt(0)" ::: "memory");
    __builtin_amdgcn_s_barrier();
    asm volatile("" ::: "memory");
    char* cur = S + cs * 24576;
    if (kt + 2 < nk) {
      int ns = cs + 2; if (ns >= 3) ns -= 3;
      char* nx = S + ns * 24576;
#pragma unroll
      for (int i = 0; i < 2; ++i) __builtin_amdgcn_global_load_lds((const unsigned*)(pa[i] + (kt + 2) * 32), (LAS unsigned*)(nx + (i * 256 + tid) * 16), 16, 0, 0);
#pragma unroll
      for (int i = 0; i < 4; ++i) __builtin_amdgcn_global_load_lds((const unsigned*)(pb[i] + (kt + 2) * 32), (LAS unsigned*)(nx + 8192 + (i * 256 + tid) * 16), 16, 0, 0);
    }
#if GP_NOBAR2
#endif
    bf16x8 af[4], bfr[8];
#pragma unroll
    for (int m = 0; m < 4; ++m) af[m] = *reinterpret_cast<const bf16x8*>(cur + offA[m]);
#pragma unroll
    for (int n = 0; n < 8; ++n) bfr[n] = *reinterpret_cast<const bf16x8*>(cur + offB[n]);
#if GP_DS
    {
      bf16x8 t2[4];
#pragma unroll
      for (int rr = 0; rr < 3; ++rr) {
#pragma unroll
        for (int m = 0; m < 4; ++m) t2[m] = *reinterpret_cast<const volatile bf16x8*>(cur + offB[m + (rr & 1) * 4]);
#pragma unroll
        for (int m = 0; m < 4; ++m) asm volatile("" :: "v"(t2[m]));
      }
    }
#endif
#pragma unroll
    for (int m = 0; m < 4; ++m)
#pragma unroll
      for (int n = 0; n < 8; ++n) acc[m][n] = MFMA16(bfr[n], af[m], acc[m][n]);
#if GP_MFMA
    {
      f32x4 d2[8];
#pragma unroll
      for (int n = 0; n < 8; ++n) d2[n] = f32x4{0.f, 0.f, 0.f, 0.f};
#pragma unroll
      for (int m = 0; m < 4; ++m)
#pragma unroll
        for (int n = 0; n < 8; ++n) d2[n] = MFMA16(bfr[n], af[m], d2[n]);
#pragma unroll
      for (int n = 0; n < 8; ++n) asm volatile("" :: "v"(d2[n]));
    }
#endif
    cs = cs + 1; if (cs >= 3) cs = 0;
  }
  __syncthreads();
}
#ifndef RP_A
#define RP_A 1
#endif
#ifndef RP_B
#define RP_B 1
#endif
#ifndef RP_C
#define RP_C 1
#endif
#ifndef RP_D
#define RP_D 1
#endif
template <int KK, int NT>
__device__ __forceinline__ void mm_strip(const u16* A, int lda, int arow0, const u16* Bt, int ldb, int brow0, f32x4* acc, int lane) {
  const int fr = lane & 15, fq = lane >> 4;
#pragma unroll
  for (int ks = 0; ks < KK / 32; ++ks) {
    bf16x8 a = *reinterpret_cast<const bf16x8*>(A + (arow0 + fr) * lda + ks * 32 + fq * 8);
#pragma unroll
    for (int nt = 0; nt < NT; ++nt) {
      bf16x8 b = *reinterpret_cast<const bf16x8*>(Bt + (brow0 + nt * 16 + fr) * ldb + ks * 32 + fq * 8);
      acc[nt] = MFMA16(a, b, acc[nt]);
    }
  }
}

template <int t>
__device__ __forceinline__ void solve_load_row(uint4 (&r)[8], const u16* Ls) {
  constexpr int nb = ((t + 1) / 2 + 3) / 4;
#pragma unroll
  for (int q = 0; q < nb; ++q) r[q] = *reinterpret_cast<const uint4*>(Ls + t * 72 + q * 8);
}
template <int t, bool IDENT>
__device__ __forceinline__ void solve_rows(float (&x)[64], unsigned (&xp)[32], const u16* Ls, int lane, uint4 (&r0)[8], uint4 (&r1)[8], uint4 (&r2)[8]) {
  if constexpr (t + 2 < 64) solve_load_row<t + 2>(r2, Ls);
  __builtin_amdgcn_sched_barrier(0);
  constexpr int npair = (t + 1) / 2, nb = (npair + 3) / 4;
  float sa[2] = {0.f, 0.f};
#pragma unroll
  for (int q = 0; q < nb; ++q) {
    const unsigned w[4] = {r0[q].x, r0[q].y, r0[q].z, r0[q].w};
#pragma unroll
    for (int e = 0; e < 4; ++e)
      if (q * 4 + e < npair) sa[e & 1] = dot2bf(w[e], xp[q * 4 + e], sa[e & 1]);
  }
  const float xt = (IDENT ? (lane == t ? 1.f : 0.f) : x[t]) - (sa[0] + sa[1]);
  x[t] = xt;
  if constexpr (t & 1) xp[t >> 1] = pack2(x[t - 1], xt);
  else xp[t >> 1] = pack2(xt, 0.f);
  if constexpr (t + 1 < 64) solve_rows<t + 1, IDENT>(x, xp, Ls, lane, r1, r2, r0);
}
template <bool IDENT = false>
__device__ __forceinline__ void fwd_solve64(float (&x)[64], const u16* Ls, u16* dst, int lane = 0) {
  unsigned xp[32];
  uint4 r0[8], r1[8], r2[8];
  solve_load_row<1>(r0, Ls);
  solve_load_row<2>(r1, Ls);
  if (IDENT) x[0] = (lane == 0) ? 1.f : 0.f;
  xp[0] = pack2(x[0], 0.f);
  solve_rows<1, IDENT>(x, xp, Ls, lane, r0, r1, r2);
#pragma unroll
  for (int q = 0; q < 8; ++q) {
    uint4 o;
    o.x = xp[4 * q + 0] ^ 0x80008000u; o.y = xp[4 * q + 1] ^ 0x80008000u;
    o.z = xp[4 * q + 2] ^ 0x80008000u; o.w = xp[4 * q + 3] ^ 0x80008000u;
    *reinterpret_cast<uint4*>(dst + 8 * q) = o;
  }
}

__device__ __forceinline__ void load_mixed8(const u16* pz, bool hp, bool hn, const float* m0, float* out) {
  float c[8], pv[8], nx[8];
  ld8(pz, c);
  if (hp) ld8(pz - AB_IN, pv);
  else {
#pragma unroll
    for (int e = 0; e < 8; ++e) pv[e] = 0.f;
  }
  if (hn) ld8(pz + AB_IN, nx);
  else {
#pragma unroll
    for (int e = 0; e < 8; ++e) nx[e] = 0.f;
  }
  const float4 a0 = *reinterpret_cast<const float4*>(m0), a1 = *reinterpret_cast<const float4*>(m0 + 4);
  const float4 b0 = *reinterpret_cast<const float4*>(m0 + RWKV_IN), b1 = *reinterpret_cast<const float4*>(m0 + RWKV_IN + 4);
  const float ma[8] = {a0.x, a0.y, a0.z, a0.w, a1.x, a1.y, a1.z, a1.w};
  const float mb[8] = {b0.x, b0.y, b0.z, b0.w, b1.x, b1.y, b1.z, b1.w};
#pragma unroll
  for (int e = 0; e < 8; ++e) out[e] = c[e] + ma[e] * (pv[e] - c[e]) + mb[e] * (nx[e] - c[e]);
}
__device__ __forceinline__ void load_mixed16(const u16* zb, long row, int pp, int col, const float* mu, float* out) {
  const u16* pz = zb + row * AB_IN + col;
  const bool hp = !(pp == 0 || pp == CTXL), hn = !(pp == CTXL - 1 || pp == PB - 1);
  load_mixed8(pz, hp, hn, mu + (col - 256), out);
  __builtin_amdgcn_sched_barrier(0);
  load_mixed8(pz + 8, hp, hn, mu + (col - 256) + 8, out + 8);
  __builtin_amdgcn_sched_barrier(0);
}

template <int DIR>
__device__ __forceinline__ void load_mixed_2x8(const u16* zb, int b, int c, int rp, int col, const float* mu, float (&out)[2][8]) {
  const int tmin = DIR ? 62 - 2 * rp : 2 * rp;
  const int pp0 = c * 64 + tmin;
  const int seg_lo = (c < 4) ? 0 : CTXL, seg_hi = (c < 4) ? CTXL : PB;
  const u16* pz = zb + ((long)b * PB + pp0) * AB_IN + col;
  float zr[4][8];
#pragma unroll
  for (int j = 0; j < 4; ++j) {
    const int pt = pp0 - 1 + j;
    if (pt >= seg_lo && pt < seg_hi) ld8(pz + (long)(j - 1) * AB_IN, zr[j]);
    else {
#pragma unroll
      for (int e = 0; e < 8; ++e) zr[j][e] = 0.f;
    }
  }
  const float* m0 = mu + (col - 256);
  const float4 a0 = *reinterpret_cast<const float4*>(m0), a1 = *reinterpret_cast<const float4*>(m0 + 4);
  const float4 b0 = *reinterpret_cast<const float4*>(m0 + RWKV_IN), b1 = *reinterpret_cast<const float4*>(m0 + RWKV_IN + 4);
  const float ma[8] = {a0.x, a0.y, a0.z, a0.w, a1.x, a1.y, a1.z, a1.w};
  const float mb[8] = {b0.x, b0.y, b0.z, b0.w, b1.x, b1.y, b1.z, b1.w};
#pragma unroll
  for (int r = 0; r < 2; ++r) {
    const int to = DIR ? 1 - r : r;
#pragma unroll
    for (int e = 0; e < 8; ++e) {
      const float cc = zr[to + 1][e];
      out[r][e] = cc + ma[e] * (zr[to][e] - cc) + mb[e] * (zr[to + 2][e] - cc);
    }
  }
}

using u32x4 = __attribute__((ext_vector_type(4))) unsigned;
__device__ __forceinline__ void load_raw4(const char* ub, unsigned loff, int c, int tmin, u32x4 (&raw)[4]) {
  const int pp0 = c * 64 + tmin;
  const int seg_lo = (c < 4) ? 0 : CTXL, seg_hi = (c < 4) ? CTXL : PB;
#pragma unroll
  for (int j = 0; j < 4; ++j) {
    const int pt = pp0 - 1 + j;
    if (pt >= seg_lo && pt < seg_hi) raw[j] = *reinterpret_cast<const u32x4*>(ub + (long)(j - 1) * (AB_IN * 2) + loff);
    else raw[j] = u32x4{0u, 0u, 0u, 0u};
  }
}
template <int DIR>
__device__ __forceinline__ void mix_raw_2x8(const u32x4 (&raw)[4], int col, const float* mu, float (&out)[2][8]) {
  float zr[4][8];
#pragma unroll
  for (int j = 0; j < 4; ++j) {
#pragma unroll
    for (int q = 0; q < 4; ++q) { zr[j][2 * q] = __uint_as_float(raw[j][q] << 16); zr[j][2 * q + 1] = __uint_as_float(raw[j][q] & 0xffff0000u); }
  }
  const float* m0 = mu + (col - 256);
  const float4 a0 = *reinterpret_cast<const float4*>(m0), a1 = *reinterpret_cast<const float4*>(m0 + 4);
  const float4 b0 = *reinterpret_cast<const float4*>(m0 + RWKV_IN), b1 = *reinterpret_cast<const float4*>(m0 + RWKV_IN + 4);
  const float ma[8] = {a0.x, a0.y, a0.z, a0.w, a1.x, a1.y, a1.z, a1.w};
  const float mb[8] = {b0.x, b0.y, b0.z, b0.w, b1.x, b1.y, b1.z, b1.w};
#pragma unroll
  for (int r = 0; r < 2; ++r) {
    const int to = DIR ? 1 - r : r;
#pragma unroll
    for (int e = 0; e < 8; ++e) {
      const float cc = zr[to + 1][e];
      out[r][e] = cc + ma[e] * (zr[to][e] - cc) + mb[e] * (zr[to + 2][e] - cc);
    }
  }
}

#ifndef RW_LATE
#define RW_LATE 1
#endif
#ifndef RW_R0
#define RW_R0 22
#endif
#ifndef RW_CUT
#define RW_CUT 230
#endif
constexpr int RW_N0_ = RW_LATE ? NB * NCH * 12 * 2 - 3 * 416 : NB * NCH * 12 * 2;
template <int DIR, bool LATEPART>
__device__ __forceinline__ void rwkv_prep_all(const Params& p) {
  constexpr int RWN_ = NB * NCH * 12 * 2;
  const int it_first = LATEPART ? RW_N0_ + VBID_P(48) : VBID_P(0), it_end = LATEPART ? RWN_ : RW_N0_, it_stride = LATEPART ? NVB - 96 : NVB;
  const u16* z = p.zbuf;
  const float* mu = p.ab_mu;
  u32x4 rwd[4], rad[4], rk[4], rr[4], rv[4], swv[2], sav[2];
#define RWKV_ZB(B_, C_, COL) ((const char*)(z + ((long)(B_) * PB + (C_) * 64) * AB_IN + (COL)))
#define RWKV_ISSUE(IT, TID) do { int r_ = (IT) >> 1; const int h_ = r_ % 12; r_ /= 12; const int b_ = r_ % NB, o_ = r_ / NB; \
    const int c_ = DIR ? (o_ < 4 ? 3 - o_ : 263 - o_) : o_; \
    const int rp_ = (TID) >> 3, tmin_ = DIR ? 62 - 2 * rp_ : 2 * rp_; \
    const unsigned zoff_ = (unsigned)(tmin_ * AB_IN + ((TID) & 7) * 8) * 2u, woff_ = (unsigned)(((TID) >> 2) * 64 + ((TID) & 3) * 16) * 2u; \
    load_raw4(RWKV_ZB(b_, c_, 2688 + DIR * 64), zoff_, c_, tmin_, rwd); \
    load_raw4(RWKV_ZB(b_, c_, 2816 + DIR * 64), zoff_, c_, tmin_, rad); \
    const char* sw_ = (const char*)(p.WupT + ((long)DIR * 768 + 64 * h_) * 64); \
    const char* sa_ = (const char*)(p.AupT + ((long)DIR * 768 + 64 * h_) * 64); \
    swv[0] = *reinterpret_cast<const u32x4*>(sw_ + woff_); swv[1] = *reinterpret_cast<const u32x4*>(sw_ + 16 + woff_); \
    sav[0] = *reinterpret_cast<const u32x4*>(sa_ + woff_); sav[1] = *reinterpret_cast<const u32x4*>(sa_ + 16 + woff_); } while (0)
  { const int tid0 = opaque_tid(); RWKV_ISSUE(min(it_first, it_end - 2), tid0); }
#pragma unroll 1
  for (int it = it_first; it < it_end; it += it_stride) {
  u16* buf[8];
#pragma unroll
  for (int i = 0; i < 8; ++i) buf[i] = (u16*)(smem + i * MB);
  float* LW = (float*)(smem + 5 * MB);
  u16* AA = buf[7];
  float* gC = (float*)(smem + 8 * MB);
  const int tid = opaque_tid(), lane = tid & 63, wid = tid >> 6, fr = lane & 15, fq = lane >> 4;
  const int i = tid >> 2, sub = tid & 3, cj = sub * 16;
  const int cg8 = (tid & 7) * 8, rp = tid >> 3;
  const int tmin = DIR ? 62 - 2 * rp : 2 * rp;
  const unsigned zoff = (unsigned)(tmin * AB_IN + cg8) * 2u;
  int b, c, h;
  { int r_ = it >> 1; h = r_ % 12; r_ /= 12; b = r_ % NB; const int o_ = r_ / NB; c = DIR ? (o_ < 4 ? 3 - o_ : 263 - o_) : o_; }
  load_raw4(RWKV_ZB(b, c, 1024 + 64 * h), zoff, c, tmin, rk);
  load_raw4(RWKV_ZB(b, c, 256 + 64 * h), zoff, c, tmin, rr);
  load_raw4(RWKV_ZB(b, c, 1792 + 64 * h), zoff, c, tmin, rv);
  {
    {
      const int cg = cg8;
      float wd[2][8], ad[2][8];
      mix_raw_2x8<DIR>(rwd, 2688 + DIR * 64 + cg, mu, wd);
      mix_raw_2x8<DIR>(rad, 2816 + DIR * 64 + cg, mu, ad);
#pragma unroll
      for (int r = 0; r < 2; ++r) {
#pragma unroll
        for (int e = 0; e < 8; ++e) wd[r][e] = tanhf_(wd[r][e]);
        st8(buf[0] + (2 * rp + r) * 72 + cg, wd[r]);
        st8(buf[1] + (2 * rp + r) * 72 + cg, ad[r]);
      }
    }
    *reinterpret_cast<u32x4*>(buf[2] + i * 72 + cj) = swv[0];
    *reinterpret_cast<u32x4*>(buf[2] + i * 72 + cj + 8) = swv[1];
    *reinterpret_cast<u32x4*>(buf[3] + i * 72 + cj) = sav[0];
    *reinterpret_cast<u32x4*>(buf[3] + i * 72 + cj + 8) = sav[1];
  }
  __syncthreads();
  {
    f32x4 aw[4], aa[4];
#pragma unroll
    for (int n = 0; n < 4; ++n) { aw[n] = f32x4{0.f, 0.f, 0.f, 0.f}; aa[n] = f32x4{0.f, 0.f, 0.f, 0.f}; }
    mm_strip<64, 4>(buf[0], 72, 16 * wid, buf[2], 72, 0, aw, lane);
    mm_strip<64, 4>(buf[1], 72, 16 * wid, buf[3], 72, 0, aa, lane);
    float* stot = gC + 64;
    float cum[4][4];
#pragma unroll
    for (int nt = 0; nt < 4; ++nt) {
      const int col = 16 * nt + fr, ch = 64 * h + col;
      const float w0v = p.rwkv_w0[DIR * 768 + ch], a0v = p.rwkv_a0[DIR * 768 + ch];
      float run = 0.f;
#pragma unroll
      for (int j = 0; j < 4; ++j) {
        const int t = 16 * wid + 4 * fq + j;
        const float xw = w0v + aw[nt][j];
        const float wlog = -softplusf_(-xw) - 0.5f;
        run += -__expf(wlog);
        cum[nt][j] = run;
        AA[t * 72 + col] = f2bf(sigmoidf_(a0v + aa[nt][j]));
      }
      const float s1 = __shfl_up(run, 16), s2 = __shfl_up(run, 32), s3 = __shfl_up(run, 48);
      const float excl = (fq >= 1 ? s1 : 0.f) + (fq >= 2 ? s2 : 0.f) + (fq >= 3 ? s3 : 0.f);
#pragma unroll
      for (int j = 0; j < 4; ++j) cum[nt][j] += excl;
      if (fq == 3) stot[wid * 64 + col] = cum[nt][3];
    }
    __syncthreads();
#pragma unroll
    for (int nt = 0; nt < 4; ++nt) {
      const int col = 16 * nt + fr;
      float off = 0.f;
#pragma unroll
      for (int w2 = 0; w2 < 3; ++w2) off += (w2 < wid) ? stot[w2 * 64 + col] : 0.f;
#pragma unroll
      for (int j = 0; j < 4; ++j) LW[(16 * wid + 4 * fq + j) * 65 + col] = cum[nt][j] + off;
      if (wid == 3 && fq == 3) gC[col] = __expf(cum[nt][3] + off);
    }
  }
  __syncthreads();
  {
    const int cg = cg8;
    float k8[2][8], Lg[2][8];
    mix_raw_2x8<DIR>(rk, 1024 + 64 * h + cg, mu, k8);
#pragma unroll
    for (int r = 0; r < 2; ++r) {
      const int ii = 2 * rp + r;
      float kk[8], ss = 0.f;
#pragma unroll
      for (int e = 0; e < 8; ++e) { kk[e] = k8[r][e] * p.rwkv_k_k[64 * h + cg + e]; ss += kk[e] * kk[e]; }
      ss += __shfl_xor(ss, 1); ss += __shfl_xor(ss, 2); ss += __shfl_xor(ss, 4);
      const float inv = rsqrtf(ss + 1e-6f);
      float Ah[8], Bh[8], Kh[8];
#pragma unroll
      for (int e = 0; e < 8; ++e) {
        const int col = cg + e;
        Lg[r][e] = LW[ii * 65 + col];
        const float Lgm1 = ii > 0 ? LW[(ii - 1) * 65 + col] : 0.f;
        const float a = bf2f(AA[ii * 72 + col]);
        const float kkn = kk[e] * inv;
        const float einv = __expf(-Lg[r][e]);
        const float kt = k8[r][e] * (1.f + (a - 1.f) * p.rwkv_k_a[64 * h + col]);
        Ah[e] = __expf(Lgm1) * kkn;
        Bh[e] = kkn * a * einv;
        Kh[e] = kt * einv;
      }
      st8(buf[0] + ii * 72 + cg, Ah);
      st8(buf[1] + ii * 72 + cg, Bh);
      st8(buf[2] + ii * 72 + cg, Kh);
    }
    __builtin_amdgcn_sched_barrier(0);
    {
      float r8[2][8];
      mix_raw_2x8<DIR>(rr, 256 + 64 * h + cg, mu, r8);
#pragma unroll
      for (int r = 0; r < 2; ++r) {
#pragma unroll
        for (int e = 0; e < 8; ++e) r8[r][e] *= __expf(Lg[r][e]);
        st8(buf[3] + (2 * rp + r) * 72 + cg, r8[r]);
      }
    }
    __builtin_amdgcn_sched_barrier(0);
    {
      float v8[2][8];
      mix_raw_2x8<DIR>(rv, 1792 + 64 * h + cg, mu, v8);
#pragma unroll
      for (int r = 0; r < 2; ++r)
#pragma unroll
        for (int e = 0; e < 8; ++e) buf[4][(cg + e) * 72 + 2 * rp + r] = f2bf(v8[r][e]);
    }
  }
  __syncthreads();
  {
    f32x4 a1[4], a2[4];
#pragma unroll
    for (int n = 0; n < 4; ++n) { a1[n] = f32x4{0.f, 0.f, 0.f, 0.f}; a2[n] = f32x4{0.f, 0.f, 0.f, 0.f}; }
    mm_strip<64, 4>(buf[0], 72, 16 * wid, buf[1], 72, 0, a1, lane);
    mm_strip<64, 4>(buf[0], 72, 16 * wid, buf[2], 72, 0, a2, lane);
#pragma unroll
    for (int nt = 0; nt < 4; ++nt)
#pragma unroll
      for (int j = 0; j < 4; ++j) {
        int t = 16 * wid + 4 * fq + j, s = 16 * nt + fr;
        buf[5][t * 72 + s] = f2bf(s < t ? a1[nt][j] : 0.f);
        buf[6][t * 72 + s] = f2bf(s < t ? a2[nt][j] : 0.f);
      }
  }
  __syncthreads();
  {
    f32x4 a1[4];
#pragma unroll
    for (int n = 0; n < 4; ++n) a1[n] = f32x4{0.f, 0.f, 0.f, 0.f};
    mm_strip<64, 4>(buf[6], 72, 16 * wid, buf[4], 72, 0, a1, lane);
#pragma unroll
    for (int nt = 0; nt < 4; ++nt)
#pragma unroll
      for (int j = 0; j < 4; ++j) {
        int t = 16 * wid + 4 * fq + j, v = 16 * nt + fr;
        buf[7][v * 72 + t] = f2bf(a1[nt][j]);
      }
  }
  __syncthreads();
  {
    float xr[64];
    const int st = tid ^ (half_id() << 7);
    if (st < 64) {
#pragma unroll
      for (int t = 0; t < 64; ++t) xr[t] = bf2f(buf[0][t * 72 + st]);
    } else if (st < 128) {
#pragma unroll
      for (int t = 0; t < 64; t += 8) ld8(buf[7] + (st - 64) * 72 + t, xr + t);
    }
    __syncthreads();
    if (st < 128) {
      u16* dst = st < 64 ? buf[0] + st * 72 : buf[7] + (st - 64) * 72;
      fwd_solve64(xr, buf[5], dst);
    }
  }
  { const int tidn = opaque_tid(); RWKV_ISSUE((it + it_stride < it_end ? it + it_stride : it), tidn); }
  __syncthreads();
  {
    unsigned bgp[8], kgp[8];
    {
      float bs[16], ks_[16];
      ld8(buf[1] + i * 72 + cj, bs); ld8(buf[1] + i * 72 + cj + 8, bs + 8);
      ld8(buf[2] + i * 72 + cj, ks_); ld8(buf[2] + i * 72 + cj + 8, ks_ + 8);
#pragma unroll
      for (int e = 0; e < 8; ++e) {
        float g0 = gC[cj + 2 * e], g1 = gC[cj + 2 * e + 1];
        bgp[e] = pack2(bs[2 * e] * g0, bs[2 * e + 1] * g1);
        kgp[e] = pack2(ks_[2 * e] * g0, ks_[2 * e + 1] * g1);
      }
    }
    f32x4 a1[4], a2[4];
#pragma unroll
    for (int n = 0; n < 4; ++n) { a1[n] = f32x4{0.f, 0.f, 0.f, 0.f}; a2[n] = f32x4{0.f, 0.f, 0.f, 0.f}; }
    mm_strip<64, 4>(buf[3], 72, 16 * wid, buf[2], 72, 0, a1, lane);
    mm_strip<64, 4>(buf[3], 72, 16 * wid, buf[1], 72, 0, a2, lane);
    __syncthreads();
#pragma unroll
    for (int nt = 0; nt < 4; ++nt)
#pragma unroll
      for (int j = 0; j < 4; ++j) {
        int t = 16 * wid + 4 * fq + j, s = 16 * nt + fr;
        buf[5][t * 72 + s] = f2bf(s <= t ? a1[nt][j] : 0.f);
        buf[6][t * 72 + s] = f2bf(s <= t ? a2[nt][j] : 0.f);
      }
#pragma unroll
    for (int e = 0; e < 8; ++e) {
      buf[1][(cj + 2 * e) * 72 + i] = (u16)(bgp[e] & 0xffffu);
      buf[1][(cj + 2 * e + 1) * 72 + i] = (u16)(bgp[e] >> 16);
      buf[2][(cj + 2 * e) * 72 + i] = (u16)(kgp[e] & 0xffffu);
      buf[2][(cj + 2 * e + 1) * 72 + i] = (u16)(kgp[e] >> 16);
    }
  }
  __syncthreads();
  {
    u16* outp = p.prep + ((long)((b * 12 + h) * 2 + DIR) * NCH + c) * RW_ITEM;
    const int pq = wid & 1, ntp = (wid >> 1) * 2;
#pragma unroll
    for (int nn = 0; nn < 2; ++nn) {
      const int nt = ntp + nn;
      f32x4 m0 = f32x4{0.f, 0.f, 0.f, 0.f}, m1 = m0, q0 = m0, q1 = m0;
      mm_strip<64, 1>(buf[0], 72, 16 * (2 * pq), buf[1], 72, 16 * nt, &m0, lane);
      mm_strip<64, 1>(buf[0], 72, 16 * (2 * pq + 1), buf[1], 72, 16 * nt, &m1, lane);
      mm_strip<64, 1>(buf[0], 72, 16 * (2 * pq), buf[6], 72, 16 * nt, &q0, lane);
      mm_strip<64, 1>(buf[0], 72, 16 * (2 * pq + 1), buf[6], 72, 16 * nt, &q1, lane);
      float o[8], oq[8];
#pragma unroll
      for (int j = 0; j < 4; ++j) {
        int k0 = 16 * (2 * pq) + 4 * fq + j, k1 = k0 + 16, kp = 16 * nt + fr;
        o[j] = m0[j] + (k0 == kp ? gC[kp] : 0.f);
        o[4 + j] = m1[j] + (k1 == kp ? gC[kp] : 0.f);
        oq[j] = q0[j] + bf2f(buf[3][kp * 72 + k0]);
        oq[4 + j] = q1[j] + bf2f(buf[3][kp * 72 + k1]);
      }
      st8(outp + ((nt * 2 + pq) * 64 + lane) * 8, o);
      st8(outp + (((4 + nt) * 2 + pq) * 64 + lane) * 8, oq);
    }
    f32x4 an[4], ay[4];
#pragma unroll
    for (int n = 0; n < 4; ++n) { an[n] = f32x4{0.f, 0.f, 0.f, 0.f}; ay[n] = f32x4{0.f, 0.f, 0.f, 0.f}; }
    mm_strip<64, 4>(buf[2], 72, 16 * wid, buf[4], 72, 0, an, lane);
    mm_strip<64, 4>(buf[1], 72, 16 * wid, buf[7], 72, 0, an, lane);
    mm_strip<64, 4>(buf[5], 72, 16 * wid, buf[4], 72, 0, ay, lane);
    mm_strip<64, 4>(buf[6], 72, 16 * wid, buf[7], 72, 0, ay, lane);
#pragma unroll
    for (int nt = 0; nt < 4; ++nt) {
      uint2 o1, o2;
      o1.x = pack2(an[nt][0], an[nt][1]); o1.y = pack2(an[nt][2], an[nt][3]);
      o2.x = pack2(ay[nt][0], ay[nt][1]); o2.y = pack2(ay[nt][2], ay[nt][3]);
      *reinterpret_cast<uint2*>(outp + 8192 + ((wid * 4 + nt) * 64 + lane) * 4) = o1;
      *reinterpret_cast<uint2*>(outp + 8192 + (((4 + wid) * 4 + nt) * 64 + lane) * 4) = o2;
    }
  }
  __syncthreads();
  }
#undef RWKV_ISSUE
#undef RWKV_ZB
}

__device__ __forceinline__ void pool_item(const Params& p, int b, int rb, int g) {
  float* vs = (float*)smem;
  u16* As = (u16*)(smem + 16640);
  u16* Bs = (u16*)(smem + 16640 + MB);
  const int tid = opaque_tid(), lane = tid & 63, wid = tid >> 6, fr = lane & 15, fq = lane >> 4;
  const int w = 2 << g, hw = w >> 1;
  const u16* z = p.zbuf;
  const bool isctx = rb >= 256;
  {
    int n = tid >> 2, part = (tid & 3) * 16;
    const u16* s = p.PoolT + ((long)g * 64 + n) * 64 + part;
    *reinterpret_cast<uint4*>(Bs + n * 72 + part) = *reinterpret_cast<const uint4*>(s);
    *reinterpret_cast<uint4*>(Bs + n * 72 + part + 8) = *reinterpret_cast<const uint4*>(s + 8);
  }
  const int cg = (tid & 7) * 8, cl = tid >> 3;
  if (!isctx) {
    const int r_lo = max(rb - hw, 0), r_hi = min(rb + hw, 256);
#pragma unroll
    for (int k = 0; k < 2; ++k) {
      const int col = cl + 32 * k;
      float a8[8];
#pragma unroll
      for (int e = 0; e < 8; ++e) a8[e] = 0.f;
      for (int rr = r_lo; rr < r_hi; ++rr) {
        float v8[8];
        ld8(z + ((long)b * PB + CTXL + rr * 64 + col) * AB_IN + g * 64 + cg, v8);
#pragma unroll
        for (int e = 0; e < 8; ++e) a8[e] += v8[e];
      }
#pragma unroll
      for (int e = 0; e < 8; ++e) vs[col * 65 + cg + e] = a8[e];
    }
    __syncthreads();
#pragma unroll
    for (int k = 0; k < 2; ++k) {
      const int col = cl + 32 * k;
      const int c_lo = max(col - hw, 0), c_hi = min(col + hw, 64);
      float a8[8], pg[8], o8[8];
#pragma unroll
      for (int e = 0; e < 8; ++e) a8[e] = 0.f;
      for (int cc = c_lo; cc < c_hi; ++cc) {
#pragma unroll
        for (int e = 0; e < 8; ++e) a8[e] += vs[cc * 65 + cg + e];
      }
      const float rc = __builtin_amdgcn_rcpf((float)((r_hi - r_lo) * (c_hi - c_lo)));
      ld8(z + ((long)b * PB + CTXL + rb * 64 + col) * AB_IN + g * 64 + cg, pg);
#pragma unroll
      for (int e = 0; e < 8; ++e) o8[e] = a8[e] * rc - pg[e];
      st8(As + col * 72 + cg, o8);
    }
  } else {
    const int t0 = (rb - 256) * 64;
#pragma unroll
    for (int k = 0; k < 2; ++k) {
      const int col = cl + 32 * k, t = t0 + col;
      const int lo = max(t - hw, 0), hi = min(t + hw, CTXL);
      float a8[8], pg[8], o8[8];
#pragma unroll
      for (int e = 0; e < 8; ++e) a8[e] = 0.f;
      for (int tt = lo; tt < hi; ++tt) {
        float v8[8];
        ld8(z + ((long)b * PB + tt) * AB_IN + g * 64 + cg, v8);
#pragma unroll
        for (int e = 0; e < 8; ++e) a8[e] += v8[e];
      }
      const float rc = __builtin_amdgcn_rcpf((float)(hi - lo));
      ld8(z + ((long)b * PB + t) * AB_IN + g * 64 + cg, pg);
#pragma unroll
      for (int e = 0; e < 8; ++e) o8[e] = a8[e] * rc - pg[e];
      st8(As + col * 72 + cg, o8);
    }
  }
  __syncthreads();
  {
    f32x4 acc[4];
#pragma unroll
    for (int n = 0; n < 4; ++n) acc[n] = f32x4{0.f, 0.f, 0.f, 0.f};
    mm_strip<64, 4>(As, 72, 16 * wid, Bs, 72, 0, acc, lane);
    long row0 = isctx ? (long)b * PB + (rb - 256) * 64 : (long)b * PB + CTXL + rb * 64;
#pragma unroll
    for (int nt = 0; nt < 4; ++nt)
#pragma unroll
      for (int j = 0; j < 4; ++j) {
        int t = 16 * wid + 4 * fq + j, n = 16 * nt + fr;
        p.abuf[(row0 + t) * D + g * 64 + n] = f2bf(acc[nt][j] * p.pool_scale[g * 64 + n]);
      }
  }
  __syncthreads();
}

__device__ __forceinline__ void rwkv_scan_block(const Params& p, int sid, int s_begin, int s_end) {
  const int tid = opaque_tid(), lane = tid & 63, fr = lane & 15, fq = lane >> 4;
  const int wv = __builtin_amdgcn_readfirstlane(tid >> 6);
  const int d = sid & 1, bh = sid >> 1, b = bh / 12, h = bh % 12;
  const char* base = (const char*)(p.prep + (long)sid * NCH * RW_ITEM);
  char* L = (char*)smem;
  const unsigned lo16 = lane * 16u, lo8 = lane * 8u;
  f32x4* stsave = (f32x4*)(smem_raw + 98304) + tid * 4;
  f32x4 st[4];
#pragma unroll
  for (int i = 0; i < 4; ++i) st[i] = s_begin > 0 ? stsave[i] : f32x4{0.f, 0.f, 0.f, 0.f};
  auto chunk_of = [&](int step) { step = min(step, NCH - 1); return d == 0 ? step : (step < 4 ? 3 - step : 263 - step); };
  bf16x8 Ar[5][4];
  uint2 Cr[5][8];
#pragma unroll
  for (int u = 0; u < 4; ++u) {
    const char* it = base + (long)chunk_of(s_begin + u) * (RW_ITEM * 2);
    const char* pa = it + (wv * 4) * 1024;
    const char* pc = it + 16384 + wv * 512;
#pragma unroll
    for (int i = 0; i < 4; ++i) Ar[u][i] = *reinterpret_cast<const bf16x8*>(pa + i * 1024 + lo16);
#pragma unroll
    for (int rt = 0; rt < 8; ++rt) Cr[u][rt] = *reinterpret_cast<const uint2*>(pc + rt * 2048 + lo8);
  }
  __syncthreads();
#pragma unroll 1
  for (int s0 = s_begin; s0 < s_end; s0 += 5) {
#pragma unroll
    for (int u = 0; u < 5; ++u) {
      const int step = s0 + u;
      {
        const char* it = base + (long)chunk_of(step + 4) * (RW_ITEM * 2);
        const char* pa = it + (wv * 4) * 1024;
        const char* pc = it + 16384 + wv * 512;
#pragma unroll
        for (int i = 0; i < 4; ++i) Ar[(u + 4) % 5][i] = *reinterpret_cast<const bf16x8*>(pa + i * 1024 + lo16);
#pragma unroll
        for (int rt = 0; rt < 8; ++rt) Cr[(u + 4) % 5][rt] = *reinterpret_cast<const uint2*>(pc + rt * 2048 + lo8);
      }
      char* Lb = L + (step & 1) * 16384;
#pragma unroll
      for (int i = 0; i < 4; ++i) *reinterpret_cast<bf16x8*>(Lb + (wv * 4 + i) * 1024 + lo16) = Ar[u][i];
      asm volatile("s_waitcnt lgkmcnt(0)" ::: "memory");
      __builtin_amdgcn_s_barrier();
      asm volatile("" ::: "memory");
      bf16x8 bfr[2];
#pragma unroll
      for (int ks = 0; ks < 2; ++ks) {
        union { bf16x8 v; unsigned w[4]; } cv;
        cv.w[0] = pack2(st[2 * ks][0], st[2 * ks][1]); cv.w[1] = pack2(st[2 * ks][2], st[2 * ks][3]);
        cv.w[2] = pack2(st[2 * ks + 1][0], st[2 * ks + 1][1]); cv.w[3] = pack2(st[2 * ks + 1][2], st[2 * ks + 1][3]);
        bfr[ks] = cv.v;
      }
      const int c = chunk_of(step);
      u16* Yb = (u16*)(smem_raw + 32768) + (step & 1) * 4608;
#pragma unroll
      for (int rt = 0; rt < 8; ++rt) {
        f32x4 acc;
        acc[0] = __uint_as_float(Cr[u][rt].x << 16); acc[1] = __uint_as_float(Cr[u][rt].x & 0xffff0000u);
        acc[2] = __uint_as_float(Cr[u][rt].y << 16); acc[3] = __uint_as_float(Cr[u][rt].y & 0xffff0000u);
        bf16x8 a0 = *reinterpret_cast<const bf16x8*>(Lb + (rt * 2 + 0) * 1024 + lo16);
        bf16x8 a1 = *reinterpret_cast<const bf16x8*>(Lb + (rt * 2 + 1) * 1024 + lo16);
        acc = MFMA16(a0, bfr[0], acc);
        acc = MFMA16(a1, bfr[1], acc);
        if (rt < 4) st[rt] = acc;
        else {
#pragma unroll
          for (int j = 0; j < 4; ++j) {
            int t = 16 * (rt - 4) + 4 * fq + j;
            Yb[t * 72 + wv * 16 + fr] = f2bf(acc[j]);
          }
        }
      }
      __builtin_amdgcn_sched_barrier(0);
    }
  }
  if (s_end < NCH) {
#pragma unroll
    for (int i = 0; i < 4; ++i) stsave[i] = st[i];
  }
  __syncthreads();
}

__device__ __forceinline__ void rwkv_scan_copy(const Params& p, int sid, int s_begin, int s_end) {
  const int tid = opaque_tid();
  const int d = sid & 1, bh = sid >> 1, b = bh / 12, h = bh % 12;
  u16* ybuf = d ? p.yb : p.yf;
  const int t = tid >> 2, seg = tid & 3;
  const int tau = d ? 63 - t : t;
  auto chunk_of = [&](int step) { return d == 0 ? step : (step < 4 ? 3 - step : 263 - step); };
  auto copy = [&](int step) {
    const u16* Yb = (const u16*)(smem_raw + 32768) + (step & 1) * 4608 + t * 72 + seg * 16;
    const uint4 v0 = *reinterpret_cast<const uint4*>(Yb), v1 = *reinterpret_cast<const uint4*>(Yb + 8);
    u16* dst = ybuf + ((long)b * PB + chunk_of(step) * 64 + tau) * D + h * 64 + seg * 16;
    *reinterpret_cast<uint4*>(dst) = v0; *reinterpret_cast<uint4*>(dst + 8) = v1;
  };
  __syncthreads();
#pragma unroll 1
  for (int s_ = s_begin; s_ < s_end; ++s_) {
    __builtin_amdgcn_s_barrier();
    asm volatile("" ::: "memory");
    if (s_ > s_begin) copy(s_ - 1);
  }
  __syncthreads();
  copy(s_end - 1);
}

__device__ __forceinline__ void rwkv_out_item(const Params& p, int b, int c, int h) {
  u16* Ag = (u16*)smem;
  u16* Bg = (u16*)(smem + 17408);
  float* G = (float*)(smem + 2 * 17408);
  const int tid = opaque_tid(), lane = tid & 63, wid = tid >> 6, fr = lane & 15, fq = lane >> 4;
  const u16* z = p.zbuf;
  const float* mu = p.ab_mu;
  {
    const int cg = (tid & 15) * 8;
#pragma unroll 1
    for (int q = 0; q < 2; ++q) {
      const int rp = (tid >> 4) + 16 * q;
      float gd[2][8];
      load_mixed_2x8<0>(z, b, c, rp, 2560 + cg, mu, gd);
#pragma unroll
      for (int r = 0; r < 2; ++r) {
#pragma unroll
        for (int e = 0; e < 8; ++e) gd[r][e] = sigmoidf_(gd[r][e]);
        st8(Ag + (2 * rp + r) * 136 + cg, gd[r]);
      }
    }
    const int i = tid >> 2, sub = tid & 3;
    const u16* s = p.GupT + ((long)(64 * h + i)) * 128 + sub * 32;
#pragma unroll
    for (int e = 0; e < 32; e += 8) *reinterpret_cast<uint4*>(Bg + i * 136 + sub * 32 + e) = *reinterpret_cast<const uint4*>(s + e);
  }
  __syncthreads();
  {
    f32x4 acc[4];
#pragma unroll
    for (int n = 0; n < 4; ++n) acc[n] = f32x4{0.f, 0.f, 0.f, 0.f};
    mm_strip<128, 4>(Ag, 136, 16 * wid, Bg, 136, 0, acc, lane);
#pragma unroll
    for (int nt = 0; nt < 4; ++nt)
#pragma unroll
      for (int j = 0; j < 4; ++j) G[(16 * wid + 4 * fq + j) * 65 + 16 * nt + fr] = acc[nt][j];
  }
  __syncthreads();
  {
    const int cg = (tid & 7) * 8, rp = tid >> 3;
    const int ch = 64 * h + cg;
    float r8[2][8], k8[2][8], v8[2][8];
    load_mixed_2x8<0>(z, b, c, rp, 256 + ch, mu, r8);
    load_mixed_2x8<0>(z, b, c, rp, 1024 + ch, mu, k8);
    load_mixed_2x8<0>(z, b, c, rp, 1792 + ch, mu, v8);
    float rkw[8], gw8[8], gb8[8];
#pragma unroll
    for (int e = 0; e < 8; ++e) { rkw[e] = p.rwkv_r_k[ch + e]; gw8[e] = p.rwkv_gn_w[ch + e]; gb8[e] = p.rwkv_gn_b[ch + e]; }
#pragma unroll
    for (int r = 0; r < 2; ++r) {
      const int ii = 2 * rp + r;
      const long row = (long)b * PB + c * 64 + ii;
      float yf[8], yb[8];
      ld8(p.yf + row * D + ch, yf);
      ld8(p.yb + row * D + ch, yb);
      float s1 = 0.f, s2 = 0.f, bs = 0.f;
#pragma unroll
      for (int e = 0; e < 8; ++e) { yf[e] += yb[e]; s1 += yf[e]; s2 += yf[e] * yf[e]; bs += r8[r][e] * k8[r][e] * rkw[e]; }
      s1 += __shfl_xor(s1, 1); s1 += __shfl_xor(s1, 2); s1 += __shfl_xor(s1, 4);
      s2 += __shfl_xor(s2, 1); s2 += __shfl_xor(s2, 2); s2 += __shfl_xor(s2, 4);
      bs += __shfl_xor(bs, 1); bs += __shfl_xor(bs, 2); bs += __shfl_xor(bs, 4);
      const float mean = s1 * (1.f / 64.f);
      const float var = fmaxf(s2 * (1.f / 64.f) - mean * mean, 0.f);
      const float rstd = rsqrtf(var + 64e-5f);
      float o[8];
#pragma unroll
      for (int e = 0; e < 8; ++e) {
        const float yn = (yf[e] - mean) * rstd;
        o[e] = (yn * gw8[e] + gb8[e] + bs * v8[r][e]) * G[ii * 65 + cg + e];
      }
      st8(p.abuf + row * D + 256 + ch, o);
    }
  }
  __syncthreads();
}
#ifndef GDN_LATE
#define GDN_LATE 100
#endif
constexpr int GDN_S0_ = NCH - GDN_LATE, GDN_N0_ = GDN_S0_ * NB * 8 * 2, GDN_N_ = NCH * NB * 8 * 2;
template <int DIR, bool LATEPART>
__device__ __forceinline__ void gdn_prep_all(const Params& p) {
  const int it_first = LATEPART ? GDN_N0_ + VBID_P(64) : VBID_P(0), it_end = LATEPART ? GDN_N_ : GDN_N0_, it_stride = LATEPART ? NVB - 128 : NVB;
  u32x4 rawq[7];
#define GDN_ISSUEQ(IT, TID) do { int r_ = (IT) >> 1; const int h_ = r_ % 8; r_ /= 8; const int b_ = r_ % NB, o_ = r_ / NB; \
    const int c_ = DIR ? (o_ < 4 ? 3 - o_ : 263 - o_) : o_; \
    const int rg_ = (TID) >> 4, tmin_ = DIR ? 60 - 4 * rg_ : 4 * rg_, pp0_ = c_ * 64 + tmin_; \
    const int lo_ = (c_ < 4) ? 0 : CTXL, hi_ = (c_ < 4) ? CTXL : PB; \
    const unsigned zoff_ = (unsigned)(tmin_ * GDN_IN + ((TID) & 15) * 8) * 2u; \
    const char* ub_ = (const char*)(p.zbuf + ((long)b_ * PB + c_ * 64) * GDN_IN + 128 * h_); \
    _Pragma("unroll") for (int j = 0; j < 7; ++j) { const int pt_ = pp0_ - 2 + j; \
      if (pt_ >= lo_ && pt_ < hi_) rawq[j] = *reinterpret_cast<const u32x4*>(ub_ + (long)(j - 2) * (GDN_IN * 2) + zoff_); \
      else rawq[j] = u32x4{0u, 0u, 0u, 0u}; } } while (0)
  { const int tid0 = opaque_tid(); GDN_ISSUEQ(min(it_first, it_end - 2), tid0); }
#pragma unroll 1
  for (int it = it_first; it < it_end; it += it_stride) {
  int b, c, h;
  { int r_ = it >> 1; h = r_ % 8; r_ /= 8; b = r_ % NB; const int o_ = r_ / NB; c = DIR ? (o_ < 4 ? 3 - o_ : 263 - o_) : o_; }
  u16* R1 = (u16*)smem;
  u16* R2 = (u16*)(smem + 18432);
  u16* Ls = (u16*)(smem + 36864);
  u16* As = (u16*)(smem + 46080);
  u16* Ut = (u16*)(smem + 55296);
  float* gc = (float*)(smem + 73728);
  float* bb = gc + 64;
  float* fac = gc + 128;
  const int tid = opaque_tid(), lane = tid & 63, wid = tid >> 6, fr = lane & 15, fq = lane >> 4;
  const int i = tid >> 2, sub = tid & 3;
  const int seg_lo = (c < 4) ? 0 : CTXL, seg_hi = (c < 4) ? CTXL : PB;
  const u16* z = p.zbuf;
  const float* cw = p.gdn_conv;
  {
    const int cg = (tid & 15) * 8, rg = tid >> 4;
    const int tmin = DIR ? 60 - 4 * rg : 4 * rg;
    const int pp0 = c * 64 + tmin;
    const unsigned zoff = (unsigned)(tmin * GDN_IN + cg) * 2u, woff = (unsigned)cg * 4u, soff = (unsigned)(tmin * GDN_IN) * 2u;
    const char* zrow = (const char*)(z + ((long)b * PB + c * 64) * GDN_IN);
    u32x4 raw[3][7];
#pragma unroll
    for (int j = 0; j < 7; ++j) raw[0][j] = rawq[j];
#pragma unroll
    for (int which = 1; which < 3; ++which) {
      const char* ub = zrow + (which * 1024 + 128 * h) * 2;
#pragma unroll
      for (int j = 0; j < 7; ++j) {
        const int pt = pp0 - 2 + j;
        if (pt >= seg_lo && pt < seg_hi) raw[which][j] = *reinterpret_cast<const u32x4*>(ub + (long)(j - 2) * (GDN_IN * 2) + zoff);
        else raw[which][j] = u32x4{0u, 0u, 0u, 0u};
      }
    }
    u16 braw[4], zraw[4];
#pragma unroll
    for (int r = 0; r < 4; ++r) {
      const int to = DIR ? 3 - r : r;
      braw[r] = *reinterpret_cast<const u16*>(zrow + (long)to * (GDN_IN * 2) + (4096 + DIR * 8 + h) * 2 + soff);
      zraw[r] = *reinterpret_cast<const u16*>(zrow + (long)to * (GDN_IN * 2) + (4096 + (2 + DIR) * 8 + h) * 2 + soff);
    }
    f32x4 wv[3][8];
#define GDN_LDW(W) do { const char* wb_ = (const char*)(cw + (W) * 1024 + 128 * h); _Pragma("unroll") for (int tap = 0; tap < 4; ++tap) { \
      wv[W][2 * tap] = *reinterpret_cast<const f32x4*>(wb_ + tap * 12288 + woff); \
      wv[W][2 * tap + 1] = *reinterpret_cast<const f32x4*>(wb_ + tap * 12288 + 16 + woff); } } while (0)
    GDN_LDW(0); GDN_LDW(1);
    __builtin_amdgcn_sched_barrier(0);
    float beta4[4];
#pragma unroll
    for (int r = 0; r < 4; ++r) beta4[r] = sigmoidf_(bf2f(braw[r]));
#pragma unroll
    for (int which = 0; which < 3; ++which) {
      float zr[7][8];
#pragma unroll
      for (int j = 0; j < 7; ++j) {
#pragma unroll
        for (int q = 0; q < 4; ++q) { zr[j][2 * q] = __uint_as_float(raw[which][j][q] << 16); zr[j][2 * q + 1] = __uint_as_float(raw[which][j][q] & 0xffff0000u); }
      }
#pragma unroll
      for (int r = 0; r < 4; ++r) {
        const int to = DIR ? 3 - r : r;
        const int i = 4 * rg + r;
        float o[8], ss = 0.f;
#pragma unroll
        for (int e = 0; e < 8; ++e) {
          float a = zr[to][e] * wv[which][0 + (e >> 2)][e & 3] + zr[to + 1][e] * wv[which][2 + (e >> 2)][e & 3] +
                    zr[to + 2][e] * wv[which][4 + (e >> 2)][e & 3] + zr[to + 3][e] * wv[which][6 + (e >> 2)][e & 3];
          o[e] = siluf_(a); ss += o[e] * o[e];
        }
        if (which < 2) {
          ss += __shfl_xor(ss, 1); ss += __shfl_xor(ss, 2); ss += __shfl_xor(ss, 4); ss += __shfl_xor(ss, 8);
          const float sc = rsqrtf(ss + 1e-6f) * (which == 0 ? 0.08838834764831845f : 1.0f);
#pragma unroll
          for (int e = 0; e < 8; ++e) o[e] *= sc;
          st8((which == 0 ? R2 : R1) + i * 136 + cg, o);
        } else {
#pragma unroll
          for (int e = 0; e < 8; ++e) Ut[(cg + e) * 72 + 63 - i] = f2bf(o[e] * beta4[r]);
        }
      }
      __builtin_amdgcn_sched_barrier(0);
      if (which == 0) { GDN_LDW(2); }
    }
#undef GDN_LDW
    if ((tid & 15) == 0) {
#pragma unroll
      for (int r = 0; r < 4; ++r) {
        const int i = 4 * rg + r;
        float za = bf2f(zraw[r]);
        bb[i] = beta4[r];
        gc[i] = -__expf(p.gdn_a_log[DIR * 8 + h]) * softplusf_(za + p.gdn_dt_bias[DIR * 8 + h]);
      }
    }
  }
  __syncthreads();
  if (wid == 0) {
    float v = gc[lane];
#pragma unroll
    for (int o = 1; o < 64; o <<= 1) { float u = __shfl_up(v, o); if (lane >= o) v += u; }
    gc[lane] = v;
    fac[lane] = bb[lane] * __expf(v);
  }
  __syncthreads();
  u16* const outp = p.prep + ((long)((b * 8 + h) * 2 + DIR) * NCH + c) * GD_ITEM;
  {
    f32x4 a1[4], a2[4];
#pragma unroll
    for (int n = 0; n < 4; ++n) { a1[n] = f32x4{0.f, 0.f, 0.f, 0.f}; a2[n] = f32x4{0.f, 0.f, 0.f, 0.f}; }
    mm_strip<128, 4>(R1, 136, 16 * wid, R1, 136, 0, a1, lane);
    mm_strip<128, 4>(R2, 136, 16 * wid, R1, 136, 0, a2, lane);
#pragma unroll
    for (int nt = 0; nt < 4; ++nt) {
      const int s = 16 * nt + fr, t0 = 16 * wid + 4 * fq;
      float lv[4];
#pragma unroll
      for (int j = 0; j < 4; ++j) {
        const int t = t0 + j;
        float dec = s <= t ? __expf(gc[t] - gc[s]) : 0.f;
        lv[j] = s < t ? bb[t] * a1[nt][j] * dec : 0.f;
        As[t * 72 + s] = f2bf(a2[nt][j] * dec);
      }
      uint2 o; o.x = pack2(lv[3], lv[2]); o.y = pack2(lv[1], lv[0]);
      *reinterpret_cast<uint2*>(Ls + (63 - s) * 72 + 60 - t0) = o;
    }
#pragma unroll
    for (int nt = 0; nt < 4; ++nt) {
      int t = 16 * nt + fr;
      float eg = __expf(gc[t]);
      float o[8];
#pragma unroll
      for (int s2 = 0; s2 < 2; ++s2)
#pragma unroll
        for (int j = 0; j < 4; ++j) o[s2 * 4 + j] = bf2f(R2[t * 136 + 16 * (2 * wid + s2) + 4 * fq + j]) * eg;
      st8(outp + (((8 + nt) * 4 + wid) * 64 + lane) * 8, o);
    }
  }
  {
    bf16x8 bw[2][2], bu[2][2];
#pragma unroll
    for (int ks = 0; ks < 2; ++ks) {
      float f8[8];
#pragma unroll
      for (int j = 0; j < 8; ++j) f8[j] = fac[63 - (32 * ks + 8 * fq + j)];
#pragma unroll
      for (int ct = 0; ct < 2; ++ct) {
        const int ch = 16 * (2 * wid + ct) + fr;
        union { bf16x8 v; unsigned w[4]; } cv;
#pragma unroll
        for (int j2 = 0; j2 < 4; ++j2) {
          const int s0 = 63 - (32 * ks + 8 * fq + 2 * j2);
          cv.w[j2] = pack2(bf2f(R1[s0 * 136 + ch]) * f8[2 * j2], bf2f(R1[(s0 - 1) * 136 + ch]) * f8[2 * j2 + 1]);
        }
        bw[ct][ks] = cv.v;
        bu[ct][ks] = *reinterpret_cast<const bf16x8*>(Ut + ch * 72 + 32 * ks + 8 * fq);
      }
    }
    unsigned kreg[16];
    {
      const float eg = __expf(gc[63] - gc[i]);
#pragma unroll
      for (int e = 0; e < 16; ++e)
        kreg[e] = pack2(bf2f(R1[i * 136 + 32 * sub + 2 * e]) * eg, bf2f(R1[i * 136 + 32 * sub + 2 * e + 1]) * eg);
    }
    __syncthreads();
    if (wid == (half_id() ? 2 : 0)) {
      float xr[64];
      fwd_solve64<true>(xr, Ls, Ls + lane * 72, lane);
    }
    __syncthreads();
    {
      bf16x8 ta[4][2];
#pragma unroll
      for (int tt = 0; tt < 4; ++tt)
#pragma unroll
        for (int ks = 0; ks < 2; ++ks) ta[tt][ks] = *reinterpret_cast<const bf16x8*>(Ls + (16 * tt + fr) * 72 + 32 * ks + 8 * fq);
#pragma unroll
      for (int ct = 0; ct < 2; ++ct) {
        const int ch = 16 * (2 * wid + ct) + fr;
#pragma unroll
        for (int tt = 0; tt < 4; ++tt) {
          f32x4 aw = f32x4{0.f, 0.f, 0.f, 0.f}, au = aw;
          aw = MFMA16(ta[tt][0], bw[ct][0], aw); aw = MFMA16(ta[tt][1], bw[ct][1], aw);
          au = MFMA16(ta[tt][0], bu[ct][0], au); au = MFMA16(ta[tt][1], bu[ct][1], au);
          uint2 ow, ou;
          ow.x = pack2(aw[3], aw[2]); ow.y = pack2(aw[1], aw[0]);
          ou.x = pack2(au[3], au[2]); ou.y = pack2(au[1], au[0]);
          *reinterpret_cast<uint2*>(R2 + ch * 72 + 60 - 16 * tt - 4 * fq) = ow;
          *reinterpret_cast<uint2*>(Ut + ch * 72 + 60 - 16 * tt - 4 * fq) = ou;
        }
      }
    }
#pragma unroll
    for (int e = 0; e < 16; ++e) {
      R1[(32 * sub + 2 * e) * 72 + i] = (u16)(kreg[e] & 0xffffu);
      R1[(32 * sub + 2 * e + 1) * 72 + i] = (u16)(kreg[e] >> 16);
    }
  }
  __syncthreads();
  { const int tidn = opaque_tid(); GDN_ISSUEQ((it + it_stride < it_end ? it + it_stride : it), tidn); }
  {
    const float glast = __expf(gc[63]);
    {
      f32x4 m0[8], m1[8];
#pragma unroll
      for (int n = 0; n < 8; ++n) { m0[n] = f32x4{0.f, 0.f, 0.f, 0.f}; m1[n] = f32x4{0.f, 0.f, 0.f, 0.f}; }
      mm_strip<64, 8>(R2, 72, 16 * (2 * wid), R1, 72, 0, m0, lane);
      mm_strip<64, 8>(R2, 72, 16 * (2 * wid + 1), R1, 72, 0, m1, lane);
#pragma unroll
      for (int nt = 0; nt < 8; ++nt) {
        float o[8];
#pragma unroll
        for (int j = 0; j < 4; ++j) {
          int k0 = 16 * (2 * wid) + 4 * fq + j, k1 = k0 + 16, kp = 16 * nt + fr;
          o[j] = m0[nt][j] + (k0 == kp ? glast : 0.f);
          o[4 + j] = m1[nt][j] + (k1 == kp ? glast : 0.f);
        }
        st8(outp + ((nt * 4 + wid) * 64 + lane) * 8, o);
      }
    }
    {
      f32x4 q0[4], q1[4];
#pragma unroll
      for (int n = 0; n < 4; ++n) { q0[n] = f32x4{0.f, 0.f, 0.f, 0.f}; q1[n] = f32x4{0.f, 0.f, 0.f, 0.f}; }
      mm_strip<64, 4>(R2, 72, 16 * (2 * wid), As, 72, 0, q0, lane);
      mm_strip<64, 4>(R2, 72, 16 * (2 * wid + 1), As, 72, 0, q1, lane);
#pragma unroll
      for (int nt = 0; nt < 4; ++nt) {
        float o[8];
        ld8(outp + (((8 + nt) * 4 + wid) * 64 + lane) * 8, o);
#pragma unroll
        for (int j = 0; j < 4; ++j) { o[j] += q0[nt][j]; o[4 + j] += q1[nt][j]; }
        st8(outp + (((8 + nt) * 4 + wid) * 64 + lane) * 8, o);
      }
    }
    u16* cp = outp + 24576;
#pragma unroll
    for (int s2 = 0; s2 < 2; ++s2) {
      f32x4 an[8];
#pragma unroll
      for (int n = 0; n < 8; ++n) an[n] = f32x4{0.f, 0.f, 0.f, 0.f};
      mm_strip<64, 8>(R1, 72, 16 * (2 * wid + s2), Ut, 72, 0, an, lane);
#pragma unroll
      for (int nt = 0; nt < 8; ++nt) {
        uint2 o; o.x = pack2(-an[nt][0], -an[nt][1]); o.y = pack2(-an[nt][2], -an[nt][3]);
        *reinterpret_cast<uint2*>(cp + (((2 * wid + s2) * 8 + nt) * 64 + lane) * 4) = o;
      }
    }
    {
      f32x4 ao[8];
#pragma unroll
      for (int n = 0; n < 8; ++n) ao[n] = f32x4{0.f, 0.f, 0.f, 0.f};
      mm_strip<64, 8>(As, 72, 16 * wid, Ut, 72, 0, ao, lane);
#pragma unroll
      for (int nt = 0; nt < 8; ++nt) {
        uint2 o; o.x = pack2(-ao[nt][0], -ao[nt][1]); o.y = pack2(-ao[nt][2], -ao[nt][3]);
        *reinterpret_cast<uint2*>(cp + (((8 + wid) * 8 + nt) * 64 + lane) * 4) = o;
      }
    }
  }
  __syncthreads();
  }
#undef GDN_ISSUEQ
}

__device__ __forceinline__ void gdn_scan_block(const Params& p, int sid2) {
  const int tid = opaque_tid(), lane = tid & 63, fr = lane & 15, fq = lane >> 4;
  const int wid = __builtin_amdgcn_readfirstlane(tid >> 6);
  const int vhalf = sid2 & 1, sid = sid2 >> 1;
  const int d = sid & 1, bh = sid >> 1, b = bh / 8, h = bh % 8;
  const int wv = vhalf * 4 + wid;
  const char* base = (const char*)(p.prep + (long)sid * NCH * GD_ITEM);
  u16* obuf = d ? p.yb : p.yf;
  char* L = (char*)smem;
  const unsigned lo16 = lane * 16u, lo8 = lane * 8u;
  f32x4 st[8];
#pragma unroll
  for (int i = 0; i < 8; ++i) st[i] = f32x4{0.f, 0.f, 0.f, 0.f};
  auto chunk_of = [&](int step) { step = min(step, NCH - 1); return d == 0 ? step : (step < 4 ? 3 - step : 263 - step); };
  bf16x8 Ar[4][6];
  uint2 Cr[4][6];
#pragma unroll
  for (int u = 0; u < 3; ++u) {
    const char* it = base + (long)chunk_of(u >> 1) * (GD_ITEM * 2);
    const int half = u & 1;
    const char* pa = it + (half * 24 + wid * 6) * 1024;
    const char* pc = it + 49152 + ((half * 6) * 8 + wv) * 512;
#pragma unroll
    for (int e = 0; e < 6; ++e) Ar[u][e] = *reinterpret_cast<const bf16x8*>(pa + e * 1024 + lo16);
#pragma unroll
    for (int r = 0; r < 6; ++r) Cr[u][r] = *reinterpret_cast<const uint2*>(pc + r * 4096 + lo8);
  }
  __syncthreads();
  bf16x8 bfr[4];
#pragma unroll 1
  for (int P0 = 0; P0 < 2 * NCH; P0 += 8) {
#pragma unroll
    for (int u = 0; u < 8; ++u) {
      const int step = (P0 >> 1) + (u >> 1);
      const int half = u & 1;
      {
        const int Pn = P0 + u + 3;
        const char* it = base + (long)chunk_of(Pn >> 1) * (GD_ITEM * 2);
        const int hn = (u + 1) & 1;
        const char* pa = it + (hn * 24 + wid * 6) * 1024;
        const char* pc = it + 49152 + ((hn * 6) * 8 + wv) * 512;
#pragma unroll
        for (int e = 0; e < 6; ++e) Ar[(u + 3) % 4][e] = *reinterpret_cast<const bf16x8*>(pa + e * 1024 + lo16);
#pragma unroll
        for (int r = 0; r < 6; ++r) Cr[(u + 3) % 4][r] = *reinterpret_cast<const uint2*>(pc + r * 4096 + lo8);
      }
      char* Lb = L + half * 24576;
#pragma unroll
      for (int e = 0; e < 6; ++e) *reinterpret_cast<bf16x8*>(Lb + (wid * 6 + e) * 1024 + lo16) = Ar[u % 4][e];
      asm volatile("s_waitcnt lgkmcnt(0)" ::: "memory");
      __builtin_amdgcn_s_barrier();
      asm volatile("" ::: "memory");
      if (half == 0) {
#pragma unroll
        for (int ks = 0; ks < 4; ++ks) {
          union { bf16x8 v; unsigned w[4]; } cv;
          cv.w[0] = pack2(st[2 * ks][0], st[2 * ks][1]); cv.w[1] = pack2(st[2 * ks][2], st[2 * ks][3]);
          cv.w[2] = pack2(st[2 * ks + 1][0], st[2 * ks + 1][1]); cv.w[3] = pack2(st[2 * ks + 1][2], st[2 * ks + 1][3]);
          bfr[ks] = cv.v;
        }
      }
      const int c = chunk_of(step);
      u16* orow = obuf + ((long)b * PB + c * 64) * D + h * 128 + wv * 16 + fr;
#pragma unroll
      for (int r = 0; r < 6; ++r) {
        const int rt = half * 6 + r;
        f32x4 acc;
        acc[0] = __uint_as_float(Cr[u % 4][r].x << 16); acc[1] = __uint_as_float(Cr[u % 4][r].x & 0xffff0000u);
        acc[2] = __uint_as_float(Cr[u % 4][r].y << 16); acc[3] = __uint_as_float(Cr[u % 4][r].y & 0xffff0000u);
#pragma unroll
        for (int ks = 0; ks < 4; ++ks) {
          bf16x8 a = *reinterpret_cast<const bf16x8*>(Lb + (r * 4 + ks) * 1024 + lo16);
          acc = MFMA16(a, bfr[ks], acc);
        }
        if (rt < 8) st[rt] = acc;
        else {
#pragma unroll
          for (int j = 0; j < 4; ++j) {
            int t = 16 * (rt - 8) + 4 * fq + j;
            int tau = d ? 63 - t : t;
            orow[(long)tau * D] = f2bf(acc[j]);
          }
        }
        if (r & 1) __builtin_amdgcn_sched_barrier(0);
      }
    }
  }
  __syncthreads();
}

__device__ __forceinline__ void gdn_scan_loader(const Params& p, int sid2, int s_begin, int s_end) {
  const int tid = opaque_tid(), lane = tid & 63;
  const int wid = __builtin_amdgcn_readfirstlane(tid >> 6);
  const int vhalf = sid2 & 1, sid = sid2 >> 1, d = sid & 1, bh = sid >> 1, b = bh / 8, h = bh % 8;
  u16* obuf = d ? p.yb : p.yf;
  const int t = tid >> 2, seg = tid & 3;
  const int tau = d ? 63 - t : t;
  const char* base = (const char*)(p.prep + (long)sid * NCH * GD_ITEM);
  char* L = (char*)smem_raw;
  const unsigned lo16 = lane * 16u;
  auto chunk_of = [&](int step) { step = min(step, NCH - 1); return d == 0 ? step : (step < 4 ? 3 - step : 263 - step); };
  auto copy = [&](int step) {
    const u16* Yb = (const u16*)(smem_raw + 49152) + (step & 1) * 4608 + t * 72 + seg * 16;
    const uint4 v0 = *reinterpret_cast<const uint4*>(Yb), v1 = *reinterpret_cast<const uint4*>(Yb + 8);
    const int cc = d == 0 ? step : (step < 4 ? 3 - step : 263 - step);
    u16* dst = obuf + ((long)b * PB + cc * 64 + tau) * D + h * 128 + vhalf * 64 + seg * 16;
    *reinterpret_cast<uint4*>(dst) = v0; *reinterpret_cast<uint4*>(dst + 8) = v1;
  };
  const int PB0 = 2 * s_begin, PE = 2 * s_end;
  bf16x8 Ar[8][6];
#pragma unroll
  for (int u = 0; u < 8; ++u) {
    const char* pa = base + (long)chunk_of(s_begin + (u >> 1)) * (GD_ITEM * 2) + ((u & 1) * 24 + wid * 6) * 1024;
#pragma unroll
    for (int e = 0; e < 6; ++e) Ar[u][e] = *reinterpret_cast<const bf16x8*>(pa + e * 1024 + lo16);
  }
  __syncthreads();
#pragma unroll
  for (int e = 0; e < 6; ++e) *reinterpret_cast<bf16x8*>(L + (wid * 6 + e) * 1024 + lo16) = Ar[0][e];
  {
    const char* pa = base + (long)chunk_of(s_begin + 4) * (GD_ITEM * 2) + (0 * 24 + wid * 6) * 1024;
#pragma unroll
    for (int e = 0; e < 6; ++e) Ar[0][e] = *reinterpret_cast<const bf16x8*>(pa + e * 1024 + lo16);
  }
  asm volatile("s_waitcnt lgkmcnt(0)" ::: "memory");
  __builtin_amdgcn_s_barrier();
#pragma unroll 1
  for (int P0 = PB0; P0 < PE; P0 += 8) {
#pragma unroll
    for (int u = 0; u < 8; ++u) {
      const int Pw = P0 + u + 1;
      if (Pw < PE) {
        char* Lb = L + ((u + 1) & 1) * 24576;
#pragma unroll
        for (int e = 0; e < 6; ++e) *reinterpret_cast<bf16x8*>(Lb + (wid * 6 + e) * 1024 + lo16) = Ar[(u + 1) % 8][e];
      }
      {
        const int Pn = P0 + u + 9;
        const char* pa = base + (long)chunk_of(Pn >> 1) * (GD_ITEM * 2) + (((u + 1) & 1) * 24 + wid * 6) * 1024;
#pragma unroll
        for (int e = 0; e < 6; ++e) Ar[(u + 1) % 8][e] = *reinterpret_cast<const bf16x8*>(pa + e * 1024 + lo16);
      }
      if ((u & 1) == 0 && P0 + u >= PB0 + 2) copy(((P0 + u) >> 1) - 1);
      asm volatile("s_waitcnt lgkmcnt(0)" ::: "memory");
      __builtin_amdgcn_s_barrier();
      asm volatile("" ::: "memory");
    }
  }
  copy(s_end - 1);
  __syncthreads();
}

__device__ __forceinline__ void gdn_scan_compute(const Params& p, int sid2, int s_begin, int s_end) {
  const int tid = opaque_tid(), lane = tid & 63, fr = lane & 15, fq = lane >> 4;
  const int wid = __builtin_amdgcn_readfirstlane(tid >> 6);
  const int vhalf = sid2 & 1, sid = sid2 >> 1;
  const int d = sid & 1, bh = sid >> 1, b = bh / 8, h = bh % 8;
  const int wv = vhalf * 4 + wid;
  const char* base = (const char*)(p.prep + (long)sid * NCH * GD_ITEM);
  u16* obuf = d ? p.yb : p.yf;
  const char* L = (const char*)smem_raw;
  const unsigned lo16 = lane * 16u, lo8 = lane * 8u;
  const int PB0 = 2 * s_begin, PE = 2 * s_end;
  f32x4* stsave = (f32x4*)(smem_raw + 98304) + tid * 8;
  f32x4 st[8];
#pragma unroll
  for (int i = 0; i < 8; ++i) st[i] = s_begin > 0 ? stsave[i] : f32x4{0.f, 0.f, 0.f, 0.f};
  auto chunk_of = [&](int step) { step = min(step, NCH - 1); return d == 0 ? step : (step < 4 ? 3 - step : 263 - step); };
  uint2 Cr[4][6];
#pragma unroll
  for (int u = 0; u < 3; ++u) {
    const char* pc = base + (long)chunk_of(s_begin + (u >> 1)) * (GD_ITEM * 2) + 49152 + (((u & 1) * 6) * 8 + wv) * 512;
#pragma unroll
    for (int r = 0; r < 6; ++r) Cr[u][r] = *reinterpret_cast<const uint2*>(pc + r * 4096 + lo8);
  }
  __syncthreads();
  __builtin_amdgcn_s_barrier();
  asm volatile("" ::: "memory");
  bf16x8 bfr[4];
#pragma unroll 1
  for (int P0 = PB0; P0 < PE; P0 += 8) {
#pragma unroll
    for (int u = 0; u < 8; ++u) {
      const int step = (P0 >> 1) + (u >> 1);
      const int half = u & 1;
      {
        const int Pn = P0 + u + 3;
        const char* pc = base + (long)chunk_of(Pn >> 1) * (GD_ITEM * 2) + 49152 + ((((u + 1) & 1) * 6) * 8 + wv) * 512;
#pragma unroll
        for (int r = 0; r < 6; ++r) Cr[(u + 3) % 4][r] = *reinterpret_cast<const uint2*>(pc + r * 4096 + lo8);
      }
      const char* Lb = L + half * 24576;
      if (half == 0) {
#pragma unroll
        for (int ks = 0; ks < 4; ++ks) {
          union { bf16x8 v; unsigned w[4]; } cv;
          cv.w[0] = pack2(st[2 * ks][0], st[2 * ks][1]); cv.w[1] = pack2(st[2 * ks][2], st[2 * ks][3]);
          cv.w[2] = pack2(st[2 * ks + 1][0], st[2 * ks + 1][1]); cv.w[3] = pack2(st[2 * ks + 1][2], st[2 * ks + 1][3]);
          bfr[ks] = cv.v;
        }
      }
      const int c = chunk_of(step);
      u16* Yb = (u16*)(smem_raw + 49152) + (step & 1) * 4608;
      (void)c;
      bf16x8 fa[8], fb[8];
#pragma unroll
      for (int q = 0; q < 8; ++q) fa[q] = *reinterpret_cast<const bf16x8*>(Lb + q * 1024 + lo16);
#pragma unroll
      for (int k = 0; k < 3; ++k) {
        if (k == 0) {
#pragma unroll
          for (int q = 0; q < 8; ++q) fb[q] = *reinterpret_cast<const bf16x8*>(Lb + (8 + q) * 1024 + lo16);
        } else if (k == 1) {
#pragma unroll
          for (int q = 0; q < 8; ++q) fa[q] = *reinterpret_cast<const bf16x8*>(Lb + (16 + q) * 1024 + lo16);
        }
#pragma unroll
        for (int rr = 0; rr < 2; ++rr) {
          const int r = 2 * k + rr, rt = half * 6 + r;
          f32x4 acc;
          acc[0] = __uint_as_float(Cr[u % 4][r].x << 16); acc[1] = __uint_as_float(Cr[u % 4][r].x & 0xffff0000u);
          acc[2] = __uint_as_float(Cr[u % 4][r].y << 16); acc[3] = __uint_as_float(Cr[u % 4][r].y & 0xffff0000u);
#pragma unroll
          for (int ks = 0; ks < 4; ++ks) acc = MFMA16((k == 1 ? fb : fa)[rr * 4 + ks], bfr[ks], acc);
          if (rt < 8) st[rt] = acc;
          else {
#pragma unroll
            for (int j = 0; j < 4; ++j) {
              int t = 16 * (rt - 8) + 4 * fq + j;
              Yb[t * 72 + wid * 16 + fr] = f2bf(acc[j]);
            }
          }
        }
        __builtin_amdgcn_sched_barrier(0);
      }
      asm volatile("s_waitcnt lgkmcnt(0)" ::: "memory");
      __builtin_amdgcn_s_barrier();
      asm volatile("" ::: "memory");
    }
  }
  if (s_end < NCH) {
#pragma unroll
    for (int i = 0; i < 8; ++i) stsave[i] = st[i];
  }
  __syncthreads();
}

__device__ __forceinline__ void phase_gdn_out(const Params& p) {
  const int tid_ = opaque_tid(); const int lane = tid_ & 63, wid = tid_ >> 6;
  for (int row = VBID * 4 + wid; row < T; row += NVB * 4) {
#pragma unroll
    for (int i = 0; i < 4; ++i) {
      int col = (i * 64 + lane) * 4;
      uint2 a = *reinterpret_cast<const uint2*>(p.yf + (long)row * D + col);
      uint2 bq = *reinterpret_cast<const uint2*>(p.yb + (long)row * D + col);
      uint2 gz = *reinterpret_cast<const uint2*>(p.zbuf + (long)row * GDN_IN + 3072 + col);
      float o[4], gt[4];
      o[0] = __uint_as_float(a.x << 16) + __uint_as_float(bq.x << 16);
      o[1] = __uint_as_float(a.x & 0xffff0000u) + __uint_as_float(bq.x & 0xffff0000u);
      o[2] = __uint_as_float(a.y << 16) + __uint_as_float(bq.y << 16);
      o[3] = __uint_as_float(a.y & 0xffff0000u) + __uint_as_float(bq.y & 0xffff0000u);
      gt[0] = __uint_as_float(gz.x << 16); gt[1] = __uint_as_float(gz.x & 0xffff0000u);
      gt[2] = __uint_as_float(gz.y << 16); gt[3] = __uint_as_float(gz.y & 0xffff0000u);
      float ss = o[0] * o[0] + o[1] * o[1] + o[2] * o[2] + o[3] * o[3];
#pragma unroll
      for (int of = 16; of > 0; of >>= 1) ss += __shfl_xor(ss, of);
      float rstd = rsqrtf(ss * (1.f / 128.f) + 1e-6f);
      float r[4];
#pragma unroll
      for (int e = 0; e < 4; ++e) r[e] = o[e] * rstd * p.gdn_norm_g[(col & 127) + e] * siluf_(gt[e]);
      uint2 w; w.x = pack2(r[0], r[1]); w.y = pack2(r[2], r[3]);
      *reinterpret_cast<uint2*>(p.abuf + (long)row * D + col) = w;
    }
  }
}

__device__ __forceinline__ void phase_post_mixer(const Params& p, int layer, bool dry = false) {
  constexpr int FS = 1026;
  u16* const xdst = dry ? p.yf : p.xs;
  float* frow = (float*)smem;
  float* part = frow + 16 * FS;
  int* hist = (int*)(part + 4 * 16 * 32);
  const int tid = opaque_tid(), lane = tid & 63, fr = lane & 15, fq = lane >> 4;
  const int wid = __builtin_amdgcn_readfirstlane(tid >> 6);
  if (tid < 32) hist[tid] = 0;
  __syncthreads();
  const float* rw = p.router_w + (long)layer * 1024 * 32;
  const float* g1 = p.norm_g + (long)(layer * 4 + 1) * 1024;
  const float* g2 = p.norm_g + (long)(layer * 4 + 2) * 1024;
  float wreg0[64], wreg1[64];
  {
    const float* wb = rw + (long)(wid * 256 + fq) * 32 + fr;
#pragma unroll
    for (int s_ = 0; s_ < 64; ++s_) { wreg0[s_] = wb[(long)(4 * s_) * 32]; wreg1[s_] = wb[(long)(4 * s_) * 32 + 16]; }
  }
  for (int trip = 0; trip < (layer == 0 ? 5 : 4); ++trip) {
    int row0, nvalid = 16;
    if (layer == 0) {
      if (trip < 4) row0 = (VBID + trip * NVB) * 16; else { row0 = 4 * NVB * 16 + VBID; nvalid = 1; }
    } else {
      const int g = VBID + trip * NVB;
      row0 = (g >> 10) * PB + CTXL + (g & 1023) * 16;
    }
    const int b = row0 / PB, pp0 = row0 % PB;
    const bool isctx = pp0 < CTXL;
    const int mrow = isctx ? 2 : b;
    const float* gate = modp(p, layer, mrow, 2);
    const float* sh = modp(p, layer, mrow, 3);
    const float* sc = modp(p, layer, mrow, 4);
#pragma unroll 1
    for (int rr = 0; rr < 4; ++rr) {
      const int lr = wid * 4 + rr, row = row0 + lr, pp = pp0 + lr;
      if (lr >= nvalid) continue;
      float ss = 0.f;
      float4 tv[4];
#pragma unroll
      for (int i = 0; i < 4; ++i) {
        tv[i] = ld4bf(p.tmp + (long)row * D + (i * 64 + lane) * 4);
        ss += tv[i].x * tv[i].x + tv[i].y * tv[i].y + tv[i].z * tv[i].z + tv[i].w * tv[i].w;
      }
      float4 lv[4];
#pragma unroll
      for (int i = 0; i < 4; ++i) {
        const int col = (i * 64 + lane) * 4;
        if (layer == 0) {
          const float* src0 = isctx ? p.ctx + ((long)b * CTXL + pp) * D : p.x + ((long)b * SEQ + (pp - CTXL)) * D;
          lv[i] = *reinterpret_cast<const float4*>(src0 + col);
        } else lv[i] = ld4bf(p.xs + (long)row * D + col);
      }
      ss = wave_sum(ss);
      const float rstd = rsqrtf(ss * (1.f / 1024.f) + 1e-6f);
      float ss2 = 0.f;
#pragma unroll
      for (int i = 0; i < 4; ++i) {
        const int col = (i * 64 + lane) * 4;
        const float4 gg = *reinterpret_cast<const float4*>(g1 + col);
        const float4 gt = *reinterpret_cast<const float4*>(gate + col);
        lv[i].x += gt.x * (tv[i].x * rstd * gg.x); lv[i].y += gt.y * (tv[i].y * rstd * gg.y);
        lv[i].z += gt.z * (tv[i].z * rstd * gg.z); lv[i].w += gt.w * (tv[i].w * rstd * gg.w);
        st4bf(xdst + (long)row * D + col, lv[i]);
        ss2 += lv[i].x * lv[i].x + lv[i].y * lv[i].y + lv[i].z * lv[i].z + lv[i].w * lv[i].w;
      }
      ss2 = wave_sum(ss2);
      const float rstd2 = rsqrtf(ss2 * (1.f / 1024.f) + 1e-6f);
#pragma unroll
      for (int i = 0; i < 4; ++i) {
        const int col = (i * 64 + lane) * 4;
        const float4 g2v = *reinterpret_cast<const float4*>(g2 + col);
        const float4 s4 = *reinterpret_cast<const float4*>(sh + col);
        const float4 c4 = *reinterpret_cast<const float4*>(sc + col);
        float4 f;
        f.x = lv[i].x * rstd2 * g2v.x * (1.f + c4.x) + s4.x; f.y = lv[i].y * rstd2 * g2v.y * (1.f + c4.y) + s4.y;
        f.z = lv[i].z * rstd2 * g2v.z * (1.f + c4.z) + s4.z; f.w = lv[i].w * rstd2 * g2v.w * (1.f + c4.w) + s4.w;
        st4bf(p.abuf + (long)row * D + col, f);
        float* fd = frow + lr * FS + col;
        fd[0] = f.x; fd[1] = f.y; fd[2] = f.z; fd[3] = f.w;
      }
    }
    __syncthreads();
    {
      f32x4 acc0 = f32x4{0.f, 0.f, 0.f, 0.f}, acc1 = acc0;
      const float* fa = frow + fr * FS + wid * 256 + fq;
#pragma unroll
      for (int s = 0; s < 64; ++s) {
        const float a = fa[4 * s];
        acc0 = __builtin_amdgcn_mfma_f32_16x16x4f32(a, wreg0[s], acc0, 0, 0, 0);
        acc1 = __builtin_amdgcn_mfma_f32_16x16x4f32(a, wreg1[s], acc1, 0, 0, 0);
      }
#pragma unroll
      for (int j = 0; j < 4; ++j) {
        part[(wid * 16 + 4 * fq + j) * 32 + fr] = acc0[j];
        part[(wid * 16 + 4 * fq + j) * 32 + 16 + fr] = acc1[j];
      }
    }
    __syncthreads();
#pragma unroll 1
    for (int rr = 0; rr < 4; ++rr) {
      const int lr = wid * 4 + rr, row = row0 + lr;
      if (lr >= nvalid) continue;
      float logit = -3.0e38f;
      if (lane < 32)
        logit = part[(0 * 16 + lr) * 32 + lane] + part[(1 * 16 + lr) * 32 + lane] + part[(2 * 16 + lr) * 32 + lane] +
                part[(3 * 16 + lr) * 32 + lane] + p.router_b[layer * 32 + lane];
      float tv4[4]; int ti4[4];
#pragma unroll
      for (int k = 0; k < 4; ++k) {
        float bv = logit; int bi = lane;
#pragma unroll
        for (int of = 32; of > 0; of >>= 1) {
          float ov = __shfl_xor(bv, of); int oi = __shfl_xor(bi, of);
          if (ov > bv || (ov == bv && oi < bi)) { bv = ov; bi = oi; }
        }
        tv4[k] = bv; ti4[k] = bi;
        if (lane == bi) logit = -3.0e38f;
      }
      if (lane == 0) {
        float m = tv4[0];
        float e0 = 1.f, e1 = __expf(tv4[1] - m), e2 = __expf(tv4[2] - m), e3 = __expf(tv4[3] - m);
        float inv = 1.f / (e0 + e1 + e2 + e3);
        *reinterpret_cast<int4*>(p.tok_e + (long)row * 4) = make_int4(ti4[0], ti4[1], ti4[2], ti4[3]);
        *reinterpret_cast<float4*>(p.tok_gw + (long)row * 4) = make_float4(e0 * inv, e1 * inv, e2 * inv, e3 * inv);
        if (!dry) { atomicAdd(hist + ti4[0], 1); atomicAdd(hist + ti4[1], 1); atomicAdd(hist + ti4[2], 1); atomicAdd(hist + ti4[3], 1); }
      }
    }
    __syncthreads();
  }
  __syncthreads();
  if (!dry && tid < 32 && hist[tid]) atomicAdd(p.cnt + CNTI(layer, 0, tid), hist[tid]);
}

__device__ __forceinline__ void phase_moe_scatter(const Params& p, int layer) {
  int* base = (int*)smem;
  int* lcnt = base + 32;
  int* lbase = base + 64;
  const int tid = opaque_tid();
  if (tid == 0) {
    int run = 0;
    for (int e = 0; e < NE; ++e) { base[e] = run; run += p.cnt[CNTI(layer, 0, e)]; }
  }
  if (tid < 32) lcnt[tid] = 0;
  __syncthreads();
  int e_[4], r_[4]; long id_[4];
#pragma unroll
  for (int k = 0; k < 4; ++k) {
    const long idx = (long)VBID * NTH + tid + (long)k * NVB * NTH;
    id_[k] = -1; e_[k] = 0; r_[k] = 0;
    if (idx < (long)T * 4) {
      const int tok = (int)(idx >> 2);
      if (!(layer == 1 && (tok % PB) < CTXL)) {
        id_[k] = idx;
        e_[k] = p.tok_e[idx];
        r_[k] = atomicAdd(lcnt + e_[k], 1);
      }
    }
  }
  __syncthreads();
  if (tid < 32) lbase[tid] = lcnt[tid] ? atomicAdd(p.cnt + CNTI(layer, 1, tid), lcnt[tid]) : 0;
  __syncthreads();
#pragma unroll
  for (int k = 0; k < 4; ++k) {
    if (id_[k] >= 0) {
      const int slot = base[e_[k]] + lbase[e_[k]] + r_[k];
      p.slot_tok[slot] = (int)(id_[k] >> 2);
      p.slot_gw[slot] = p.tok_gw[id_[k]];
      p.tok_slot[id_[k]] = slot;
    }
  }
  __syncthreads();
}

struct MoeTab { int tstart[33]; int base[33]; };

__device__ __forceinline__ void moe_build_tab(const Params& p, int layer, MoeTab* tab) {
  __syncthreads();
  if ((threadIdx.x & 255) == 0) {
    int run = 0, trun = 0;
    for (int e = 0; e < NE; ++e) {
      int cnt = p.cnt[CNTI(layer, 0, e)];
      tab->base[e] = run; tab->tstart[e] = trun;
      run += cnt; trun += (cnt + 127) >> 7;
    }
    tab->base[32] = run; tab->tstart[32] = trun;
  }
  __syncthreads();
}

__device__ __forceinline__ void phase_moe_gemm1(const Params& p, int layer) {
  MoeTab* tab = (MoeTab*)(smem + 73728);
  moe_build_tab(p, layer, tab);
  const int ntiles = tab->tstart[32];
  const int tid = opaque_tid(), wid = tid >> 6, lane = tid & 63, wr = wid >> 1, wc = wid & 1, fr = lane & 15, fq = lane >> 4;
  for (int item = VBID; item < ntiles * 8; item += NVB) {
    const int ti = item >> 3, nt = item & 7;
    int e = 0;
    for (int q = 1; q < NE; ++q) if (ti >= tab->tstart[q]) e = q;
    const int mt = ti - tab->tstart[e];
    const int cnt = tab->base[e + 1] - tab->base[e];
    const int valid = min(128, cnt - mt * 128);
    const int slot0 = tab->base[e] + mt * 128;
    const u16* Bt = p.MoeInT + (long)(layer * 32 + e) * 2048 * 1024;
    f32x4 acc[4][8];
    gemm_tile(p.abuf, D, Bt, D, D,
              [&](int r) { return p.slot_tok[slot0 + min(r, valid - 1)]; },
              [&](int r) { int wcc = r >> 7, n = (r >> 4) & 7, f = r & 15;
                           return (n < 4 ? 0 : 1024) + nt * 128 + wcc * 64 + (n & 3) * 16 + f; },
              acc);
    const float* bi = p.moe_b_in + (long)(layer * 32 + e) * 2048;
#pragma unroll
    for (int m = 0; m < 4; ++m) {
      const int r = wr * 64 + m * 16 + fr;
#pragma unroll
      for (int n = 0; n < 4; ++n) {
        const int ca = nt * 128 + wc * 64 + n * 16 + fq * 4;
        const float4 bg = *reinterpret_cast<const float4*>(bi + ca);
        const float4 bl = *reinterpret_cast<const float4*>(bi + 1024 + ca);
        const float bgv[4] = {bg.x, bg.y, bg.z, bg.w}, blv[4] = {bl.x, bl.y, bl.z, bl.w};
        float v[4];
#pragma unroll
        for (int j = 0; j < 4; ++j) {
          float glu = fminf(acc[m][n][j] + bgv[j], 7.0f);
          float lin = fminf(fmaxf(acc[m][n + 4][j] + blv[j], -7.0f), 7.0f);
          v[j] = glu * sigmoidf_(1.702f * glu) * (lin + 1.0f);
        }
        if (r < valid) {
          uint2 o; o.x = pack2(v[0], v[1]); o.y = pack2(v[2], v[3]);
          *reinterpret_cast<uint2*>(p.act + (long)(slot0 + r) * D + ca) = o;
        }
      }
    }
  }
}

__device__ __forceinline__ void phase_moe_gemm2(const Params& p, int layer) {
  MoeTab* tab = (MoeTab*)(smem + 73728);
  moe_build_tab(p, layer, tab);
  const int ntiles = tab->tstart[32];
  const int tid = opaque_tid(), wid = tid >> 6, lane = tid & 63, wr = wid >> 1, wc = wid & 1, fr = lane & 15, fq = lane >> 4;
  for (int item = VBID; item < ntiles * 4; item += NVB) {
    const int ti = item >> 2, nt = item & 3;
    int e = 0;
    for (int q = 1; q < NE; ++q) if (ti >= tab->tstart[q]) e = q;
    const int mt = ti - tab->tstart[e];
    const int cnt = tab->base[e + 1] - tab->base[e];
    const int valid = min(128, cnt - mt * 128);
    const int slot0 = tab->base[e] + mt * 128;
    const u16* Bt = p.MoeOutT + (long)(layer * 32 + e) * 1024 * 1024;
    f32x4 acc[4][8];
    gemm_tile(p.act, D, Bt, D, D,
              [&](int r) { return slot0 + min(r, valid - 1); },
              [&](int r) { return nt * 256 + r; },
              acc);
    const float* bo = p.moe_b_out + (long)(layer * 32 + e) * 1024;
#pragma unroll
    for (int m = 0; m < 4; ++m) {
      const int r = wr * 64 + m * 16 + fr;
      const float gw = r < valid ? p.slot_gw[slot0 + r] : 0.f;
#pragma unroll
      for (int n = 0; n < 8; ++n) {
        const int cc = nt * 256 + wc * 128 + n * 16 + fq * 4;
        const float4 bv = *reinterpret_cast<const float4*>(bo + cc);
        if (r < valid) {
          uint2 o;
          o.x = pack2((acc[m][n][0] + bv.x) * gw, (acc[m][n][1] + bv.y) * gw);
          o.y = pack2((acc[m][n][2] + bv.z) * gw, (acc[m][n][3] + bv.w) * gw);
          *reinterpret_cast<uint2*>(p.oslot + (long)(slot0 + r) * D + cc) = o;
        }
      }
    }
  }
}

__device__ __forceinline__ void phase_moe_combine(const Params& p, int layer, bool dry = false) {
  u16* const xdst = dry ? p.yf : p.xs;
  const int tid_ = opaque_tid(); const int lane = tid_ & 63, wid = tid_ >> 6;
  const float* g3 = p.norm_g + (long)(layer * 4 + 3) * 1024;
  const float* g0n = p.norm_g + (long)((layer + 1) * 4 + 0) * 1024;
  for (int row0 = VBID * 4 + wid; row0 < T; row0 += NVB * 8) {
    int rows[2]; bool act[2]; int bb[2], ppp[2], mrow[2];
#pragma unroll
    for (int q = 0; q < 2; ++q) {
      rows[q] = row0 + q * NVB * 4;
      act[q] = rows[q] < T;
      const int rr = act[q] ? rows[q] : row0;
      bb[q] = rr / PB; ppp[q] = rr % PB;
      if (layer == 1 && ppp[q] < CTXL) act[q] = false;
      mrow[q] = ppp[q] < CTXL ? 2 : bb[q];
      rows[q] = rr;
    }
    if (!act[0] && !act[1]) continue;
    int4 sl[2];
#pragma unroll
    for (int q = 0; q < 2; ++q) sl[q] = *reinterpret_cast<const int4*>(p.tok_slot + (long)rows[q] * 4);
    float y[2][16];
    float4 xv[2][4];
#pragma unroll
    for (int q = 0; q < 2; ++q) {
#pragma unroll
      for (int i = 0; i < 16; ++i) y[q][i] = 0.f;
      const int sls[4] = {sl[q].x, sl[q].y, sl[q].z, sl[q].w};
#pragma unroll
      for (int k = 0; k < 4; ++k) {
#pragma unroll
        for (int i = 0; i < 4; ++i) {
          uint2 a = *reinterpret_cast<const uint2*>(p.oslot + (long)sls[k] * D + (i * 64 + lane) * 4);
          y[q][i * 4 + 0] += __uint_as_float(a.x << 16); y[q][i * 4 + 1] += __uint_as_float(a.x & 0xffff0000u);
          y[q][i * 4 + 2] += __uint_as_float(a.y << 16); y[q][i * 4 + 3] += __uint_as_float(a.y & 0xffff0000u);
        }
      }
#pragma unroll
      for (int i = 0; i < 4; ++i) xv[q][i] = ld4bf(p.xs + (long)rows[q] * D + (i * 64 + lane) * 4);
    }
#pragma unroll
    for (int q = 0; q < 2; ++q) {
      if (!act[q]) continue;
      const int row = rows[q];
      float ss = 0.f;
#pragma unroll
      for (int i = 0; i < 16; ++i) ss += y[q][i] * y[q][i];
      ss = wave_sum(ss);
      const float rstd = rsqrtf(ss * (1.f / 1024.f) + 1e-6f);
      float lat[16];
      float ss2 = 0.f;
      const float* gate = modp(p, layer, mrow[q], 5);
#pragma unroll
      for (int i = 0; i < 4; ++i) {
        const int col = (i * 64 + lane) * 4;
        const float4 gg = *reinterpret_cast<const float4*>(g3 + col);
        const float4 gt = *reinterpret_cast<const float4*>(gate + col);
        lat[i * 4 + 0] = xv[q][i].x + gt.x * (y[q][i * 4 + 0] * rstd * gg.x);
        lat[i * 4 + 1] = xv[q][i].y + gt.y * (y[q][i * 4 + 1] * rstd * gg.y);
        lat[i * 4 + 2] = xv[q][i].z + gt.z * (y[q][i * 4 + 2] * rstd * gg.z);
        lat[i * 4 + 3] = xv[q][i].w + gt.w * (y[q][i * 4 + 3] * rstd * gg.w);
#pragma unroll
        for (int e = 0; e < 4; ++e) ss2 += lat[i * 4 + e] * lat[i * 4 + e];
        const float4 ov = make_float4(lat[i * 4 + 0], lat[i * 4 + 1], lat[i * 4 + 2], lat[i * 4 + 3]);
        if (layer == 0) st4bf(xdst + (long)row * D + col, ov);
        else *reinterpret_cast<float4*>(p.out + ((long)bb[q] * SEQ + (ppp[q] - CTXL)) * D + col) = ov;
      }
      if (layer == 0) {
        ss2 = wave_sum(ss2);
        const float rstd2 = rsqrtf(ss2 * (1.f / 1024.f) + 1e-6f);
        const float* sh = modp(p, 1, mrow[q], 0);
        const float* sc = modp(p, 1, mrow[q], 1);
#pragma unroll
        for (int i = 0; i < 4; ++i) {
          const int col = (i * 64 + lane) * 4;
          const float4 gg = *reinterpret_cast<const float4*>(g0n + col);
          const float4 s4 = *reinterpret_cast<const float4*>(sh + col);
          const float4 c4 = *reinterpret_cast<const float4*>(sc + col);
          const float h0 = lat[i * 4 + 0] * rstd2 * gg.x * (1.f + c4.x) + s4.x;
          const float h1 = lat[i * 4 + 1] * rstd2 * gg.y * (1.f + c4.y) + s4.y;
          const float h2 = lat[i * 4 + 2] * rstd2 * gg.z * (1.f + c4.z) + s4.z;
          const float h3 = lat[i * 4 + 3] * rstd2 * gg.w * (1.f + c4.w) + s4.w;
          uint2 o; o.x = pack2(h0, h1); o.y = pack2(h2, h3);
          *reinterpret_cast<uint2*>(p.abuf + (long)row * D + col) = o;
        }
      }
    }
  }
}
namespace g8 {
constexpr int BK = 64, HTB = 128 * BK * 2;
__device__ __forceinline__ int lds_byte(int r, int c) { const int st = (r >> 4) * 2 + (c >> 5), rr = r & 15, cc = c & 31, ob = rr * 64 + cc * 2; return st * 1024 + (ob ^ (((ob >> 9) & 1) << 5)); }
__device__ __forceinline__ int perm32(int rho) { const int n = rho >> 4, i = rho & 15; return 8 * (i >> 2) + 4 * n + (i & 3); }
__device__ __forceinline__ void stage_rc(int b, int& R, int& C) { const int st = b / 1024, sb = b % 1024, swz = sb ^ (((sb >> 9) & 1) << 5); R = (st >> 1) * 16 + swz / 64; C = (st & 1) * 32 + (swz % 64) / 2; }

__device__ __forceinline__ const char* uni(const char* p) { unsigned long long v = (unsigned long long)p; unsigned lo = __builtin_amdgcn_readfirstlane((unsigned)v), hi = __builtin_amdgcn_readfirstlane((unsigned)(v >> 32)); return (const char*)(((unsigned long long)hi << 32) | lo); }
struct Unit { const char* b0; int i0, i1, i2, i3; };

template <class Sched, class RowOf, class Epi>
__device__ __forceinline__ void gemm_phase(const u16* __restrict__ Aptr, int K, const Sched& S, const RowOf& rowof, const Epi& E) {
  LAS unsigned char* lds = (LAS unsigned char*)smem_raw;
  int tid_ = threadIdx.x; asm volatile("" : "+v"(tid_));
  const int tid = tid_, wid = __builtin_amdgcn_readfirstlane(tid >> 6), lane = tid & 63, wr = wid >> 2, wc = wid & 3, fr = lane & 15, fq = lane >> 4;
  const int nt = K / BK;
  unsigned voffB[2];
#pragma unroll
  for (int i = 0; i < 2; ++i) { int R_, C_; stage_rc(tid * 16 + i * 8192, R_, C_); const int Rb = (R_ & ~31) + perm32(R_ & 31); voffB[i] = (unsigned)(Rb * K + C_) * 2u; }
  const size_t kstep = (size_t)(BK * 2);
  const unsigned ldsw = (unsigned)wid * 1024u;
  const int aoff = lds_byte(wr * 64 + fr, fq * 8), boff = lds_byte(wc * 32 + fr, fq * 8);
#define G8_SA(b, h) (((b) * 2 + (h)) * HTB)
#define G8_SB(b, h) ((4 + (b) * 2 + (h)) * HTB)
#define G8_STAGE(bufoff, gbase, voff) do { _Pragma("unroll") for (int _i = 0; _i < 2; ++_i) \
    __builtin_amdgcn_global_load_lds((const unsigned*)(uni((const char*)(gbase)) + (voff)[_i]), (LAS unsigned*)(lds + (bufoff) + ldsw + _i * 8192), 16, 0, 0); } while (0)
#define G8_STAGEB(bufoff, gbase) do { _Pragma("unroll") for (int _i = 0; _i < 2; ++_i) \
    __builtin_amdgcn_global_load_lds((const unsigned*)(uni((const char*)(gbase)) + _i * bstep + voffB), (LAS unsigned*)(lds + (bufoff) + ldsw + _i * 8192), 16, 0, 0); } while (0)
#define G8_LDA(dst, b, h) do { _Pragma("unroll") for (int m = 0; m < 4; ++m) _Pragma("unroll") for (int k = 0; k < 2; ++k) dst[m][k] = *(const LAS bf16x8*)(lds + G8_SA(b, h) + aoff + m * 2048 + k * 1024); } while (0)
#define G8_LDB(dst, b, h) do { _Pragma("unroll") for (int n = 0; n < 2; ++n) _Pragma("unroll") for (int k = 0; k < 2; ++k) dst[n][k] = *(const LAS bf16x8*)(lds + G8_SB(b, h) + boff + n * 2048 + k * 1024); } while (0)
#define G8_MMA(ai, bj, At, Bt) do { __builtin_amdgcn_s_setprio(1); _Pragma("unroll") for (int m = 0; m < 4; ++m) _Pragma("unroll") for (int n = 0; n < 2; ++n) _Pragma("unroll") for (int k = 0; k < 2; ++k) \
    acc[ai][bj][m][n] = __builtin_amdgcn_mfma_f32_16x16x32_bf16(Bt[n][k], At[m][k], acc[ai][bj][m][n], 0, 0, 0); __builtin_amdgcn_s_setprio(0); } while (0)
#define G8_WAIT_V(n) asm volatile("s_waitcnt vmcnt(" #n ")" ::: "memory")
#define G8_WAIT_L(n) asm volatile("s_waitcnt lgkmcnt(" #n ")" ::: "memory")
#define G8_BAR __builtin_amdgcn_s_barrier()
#define G8_SCHED __builtin_amdgcn_sched_barrier(0)
  Unit cur, nxt, nn; int ui = 0;
  if (!S.next(0, cur)) return;
  f32x4 acc[2][2][4][2];
#pragma unroll
  for (int a = 0; a < 2; ++a)
#pragma unroll
    for (int b = 0; b < 2; ++b)
#pragma unroll
      for (int m = 0; m < 4; ++m)
#pragma unroll
        for (int n = 0; n < 2; ++n) acc[a][b][m][n] = f32x4{0.f, 0.f, 0.f, 0.f};
  bf16x8 At[4][2], B0[2][2], B1[2][2];
  const char* Ab = (const char*)Aptr;
  unsigned gc0[2], gc1[2], gn0[2], gn1[2];
  bool has_next = S.next(1, nxt);
#pragma unroll
  for (int i = 0; i < 2; ++i) {
    int R_, C_; stage_rc(tid * 16 + i * 8192, R_, C_);
    gc0[i] = (unsigned)(((long)rowof(cur, R_) * K + C_) * 2);
    gc1[i] = (unsigned)(((long)rowof(cur, 128 + R_) * K + C_) * 2);
    gn0[i] = gc0[i]; gn1[i] = gc1[i];
    if (has_next) {
      gn0[i] = (unsigned)(((long)rowof(nxt, R_) * K + C_) * 2);
      gn1[i] = (unsigned)(((long)rowof(nxt, 128 + R_) * K + C_) * 2);
    }
  }
  const long b1d = S.b1delta;
  const char* cB0 = cur.b0;
#define cB1 (cB0 + b1d)
#define nB1 (nB0 + b1d)
  __syncthreads();
  G8_STAGE(G8_SB(0, 0), cB0, voffB); G8_STAGE(G8_SA(0, 0), Ab, gc0); G8_STAGE(G8_SB(0, 1), cB1, voffB); G8_STAGE(G8_SA(0, 1), Ab, gc1);
  if (wr == 1) G8_BAR;
  G8_WAIT_V(4); G8_BAR;
  G8_STAGE(G8_SB(1, 0), cB0 + kstep, voffB); G8_STAGE(G8_SA(1, 0), Ab + kstep, gc0); G8_STAGE(G8_SB(1, 1), cB1 + kstep, voffB);
  G8_WAIT_V(6); G8_BAR;
  for (;;) {
    const char* nB0 = has_next ? nxt.b0 : cB0;
    for (int t = 0; t < nt; t += 2) {
      const bool last = (t == nt - 2);
      const bool first = (t == 0) && (ui > 0);
      const char* a1 = Ab + (size_t)(t + 1) * kstep;
      const char* a2 = last ? Ab : Ab + (size_t)(t + 2) * kstep;
      const char* b20 = last ? nB0 : cB0 + (size_t)(t + 2) * kstep; const char* b21 = last ? nB1 : cB1 + (size_t)(t + 2) * kstep;
      const char* a3 = a2 + kstep; const char* b30 = b20 + kstep; const char* b31 = b21 + kstep;
      G8_LDB(B0, 0, 0); G8_SCHED; G8_LDA(At, 0, 0); if (!first) G8_STAGE(G8_SA(1, 1), a1, gc1);
      G8_WAIT_L(8); G8_BAR; G8_WAIT_L(0); G8_MMA(0, 0, At, B0); G8_BAR; G8_SCHED;
      G8_LDB(B1, 0, 1); G8_STAGE(G8_SB(0, 0), b20, voffB);
      G8_BAR; G8_WAIT_L(0); G8_MMA(0, 1, At, B1); G8_BAR;
      G8_LDA(At, 0, 1); G8_STAGE(G8_SA(0, 0), a2, (last ? gn0 : gc0));
      G8_BAR; G8_WAIT_L(0); G8_MMA(1, 0, At, B0); G8_BAR; G8_SCHED;
      G8_STAGE(G8_SB(0, 1), b21, voffB);
      if (first) { if (Epi::NST == 16) G8_WAIT_V(22); else G8_WAIT_V(14); } else G8_WAIT_V(6);
      G8_BAR; G8_MMA(1, 1, At, B1); G8_BAR;
      G8_LDB(B0, 1, 0); G8_SCHED; G8_LDA(At, 1, 0); G8_STAGE(G8_SA(0, 1), a2, (last ? gn1 : gc1));
      G8_WAIT_L(8); G8_BAR; G8_WAIT_L(0); G8_MMA(0, 0, At, B0); G8_BAR; G8_SCHED;
      G8_LDB(B1, 1, 1); G8_STAGE(G8_SB(1, 0), b30, voffB);
      G8_BAR; G8_WAIT_L(0); G8_MMA(0, 1, At, B1); G8_BAR;
      G8_LDA(At, 1, 1); G8_STAGE(G8_SA(1, 0), a3, (last ? gn0 : gc0));
      G8_BAR; G8_WAIT_L(0); G8_MMA(1, 0, At, B0); G8_BAR; G8_SCHED;
      G8_STAGE(G8_SB(1, 1), b31, voffB);
      G8_WAIT_V(6); G8_BAR; G8_MMA(1, 1, At, B1); G8_BAR;
    }
    G8_SCHED;
    typename Epi::Pre epre;
    E.load(epre, cur, wr, wc, fr, fq);
    G8_SCHED;
    G8_STAGE(G8_SA(1, 1), Ab + kstep, gn1);
    bool has_nn = false;
    if (has_next) has_nn = S.next(ui + 2, nn);
    int rq[4] = {0, 0, 0, 0};
    if (RowOf::GATHER && has_nn) {
#pragma unroll
      for (int i = 0; i < 2; ++i) {
        int R_, C_; stage_rc(tid * 16 + i * 8192, R_, C_);
        const int* q0 = rowof.addr(nn, R_); const int* q1 = rowof.addr(nn, 128 + R_);
        asm volatile("global_load_dword %0, %1, off" : "=v"(rq[i]) : "v"(q0) : "memory");
        asm volatile("global_load_dword %0, %1, off" : "=v"(rq[2 + i]) : "v"(q1) : "memory");
      }
    }
    G8_SCHED;
    E(acc, cur, epre, wr, wc, fr, fq);
    G8_SCHED;
#ifdef G8_EPI2
    E(acc, cur, epre, wr, wc, fr, fq);
    G8_SCHED;
#endif
    if (!has_next) break;
#pragma unroll
    for (int a = 0; a < 2; ++a)
#pragma unroll
      for (int b = 0; b < 2; ++b)
#pragma unroll
        for (int m = 0; m < 4; ++m)
#pragma unroll
          for (int n = 0; n < 2; ++n) acc[a][b][m][n] = f32x4{0.f, 0.f, 0.f, 0.f};
    cur = nxt; cB0 = nB0; ++ui;
#pragma unroll
    for (int i = 0; i < 2; ++i) { gc0[i] = gn0[i]; gc1[i] = gn1[i]; }
    if (has_nn) {
      if (RowOf::GATHER) {
        if (Epi::NST == 16) asm volatile("s_waitcnt vmcnt(16)" : "+v"(rq[0]), "+v"(rq[1]), "+v"(rq[2]), "+v"(rq[3]) :: "memory");
        else asm volatile("s_waitcnt vmcnt(8)" : "+v"(rq[0]), "+v"(rq[1]), "+v"(rq[2]), "+v"(rq[3]) :: "memory");
      }
#pragma unroll
      for (int i = 0; i < 2; ++i) {
        int R_, C_; stage_rc(tid * 16 + i * 8192, R_, C_);
        const int r0 = RowOf::GATHER ? rq[i] : rowof(nn, R_), r1 = RowOf::GATHER ? rq[2 + i] : rowof(nn, 128 + R_);
        gn0[i] = (unsigned)(((long)r0 * K + C_) * 2);
        gn1[i] = (unsigned)(((long)r1 * K + C_) * 2);
      }
    }
    nxt = nn; has_next = has_nn;
  }
  G8_WAIT_V(0);
  if (wr == 0) G8_BAR;
  G8_BAR;
#undef cB1
#undef nB1
#undef G8_SA
#undef G8_SB
#undef G8_STAGE
#undef G8_STAGEB
#undef G8_LDA
#undef G8_LDB
#undef G8_MMA
#undef G8_WAIT_V
#undef G8_WAIT_L
#undef G8_BAR
#undef G8_SCHED
}
}
struct DenseSched {
  const u16* Bt; int ntn, nunits, G, c, K, lat_only;
  long b1delta;
  __device__ __forceinline__ bool next(int i, g8::Unit& u) const {
    const long L = (long)i * G + c;
    if (L >= nunits) return false;
    const int nM = lat_only ? T / 256 - 2 : T / 256, nN = ntn, nwg = nunits;
    int wgid = (int)L;
    { const int q = nwg / 8, r = nwg % 8, xcd = wgid % 8, off = wgid / 8; wgid = (xcd < r ? xcd * (q + 1) : r * (q + 1) + (xcd - r) * q) + off; }
    const int nig = 8 * nN, gid = wgid / nig, fm = gid * 8, gsz = (nM - fm) < 8 ? (nM - fm) : 8;
    int pm = fm + ((wgid % nig) % gsz); const int pn = (wgid % nig) / gsz;
    if (lat_only) pm = pm < 64 ? pm + 1 : pm + 2;
    u.b0 = (const char*)(Bt + (long)(pn * 256) * K);
    u.i0 = pm * 256; u.i1 = pn * 256; u.i2 = 0; u.i3 = 0;
    return true;
  }
};
struct DenseRow { static constexpr bool GATHER = false;
  __device__ __forceinline__ int operator()(const g8::Unit& u, int r) const { return u.i0 + r; }
  __device__ __forceinline__ const int* addr(const g8::Unit&, int) const { return nullptr; } };
struct DenseEpi {
  static constexpr int NST = 16;
  u16* z; u16* tmp; u16* trash; int N, mode;
  struct Pre {};
  __device__ __forceinline__ void load(Pre&, const g8::Unit&, int, int, int, int) const {}
  __device__ __forceinline__ void operator()(const f32x4 (&acc)[2][2][4][2], const g8::Unit& u, const Pre&, int wr, int wc, int fr, int fq) const {
#pragma unroll
    for (int ai = 0; ai < 2; ++ai)
#pragma unroll
      for (int m = 0; m < 4; ++m) {
        const long row = u.i0 + ai * 128 + wr * 64 + m * 16 + fr;
#pragma unroll
        for (int bj = 0; bj < 2; ++bj) {
          const int col = u.i1 + bj * 128 + wc * 32 + fq * 8;
          const f32x4 v0 = acc[ai][bj][m][0], v1 = acc[ai][bj][m][1];
          uint4 o; o.x = pack2(v0[0], v0[1]); o.y = pack2(v0[2], v0[3]); o.z = pack2(v1[0], v1[1]); o.w = pack2(v1[2], v1[3]);
          u16* dst = mode == 0 ? (col < N ? z + row * N + col : trash + ((row & 255) * 1024 + (col & 1023))) : tmp + row * D + col;
          *reinterpret_cast<uint4*>(dst) = o;
        }
      }
  }
};
__device__ __forceinline__ void phase_gemm_dense8(const Params& p, const u16* Bt, int Npad, int N, int mode, int lat_only = 0) {
  DenseSched S; S.Bt = Bt; S.ntn = Npad / 256; S.lat_only = lat_only; S.nunits = (lat_only ? T / 256 - 2 : T / 256) * S.ntn; S.G = gridDim.x; S.c = blockIdx.x; S.K = D; S.b1delta = (long)128 * D * 2;
  DenseEpi E; E.z = p.zbuf; E.tmp = p.tmp; E.trash = p.trash; E.N = N; E.mode = mode;
  g8::gemm_phase(p.abuf, D, S, DenseRow(), E);
}

struct MoeTab8 { int tstart[33]; int base[33]; };
__device__ __forceinline__ MoeTab8* moe_tab8(const Params& p, int layer) {
  MoeTab8* tab = (MoeTab8*)(smem_raw + 131072 + 1024);
  __syncthreads();
  if (threadIdx.x == 0) {
    int run = 0, trun = 0;
    for (int e = 0; e < NE; ++e) {
      int cnt = p.cnt[CNTI(layer, 0, e)];
      tab->base[e] = run; tab->tstart[e] = trun;
      run += cnt; trun += (cnt + 255) >> 8;
    }
    tab->base[32] = run; tab->tstart[32] = trun;
  }
  __syncthreads();
  return tab;
}
struct MoeSched {
  const MoeTab8* tab; const u16* W; int NU, G, c, which;
  long b1delta;
  __device__ __forceinline__ bool next(int i, g8::Unit& u) const {
    const long L = (long)i * G + c;
    const int ntiles = __builtin_amdgcn_readfirstlane(tab->tstart[32]);
    const int nun = ntiles * NU;
    if (L >= (long)nun) return false;
    int wg = (int)L;
    { const int q = nun / 8, r = nun % 8, xcd = wg % 8, off = wg / 8; wg = (xcd < r ? xcd * (q + 1) : r * (q + 1) + (xcd - r) * q) + off; }
    const int ti = wg / NU, nu = wg % NU;
    int e = min(NE - 1, (int)(((long)ti * NE) / max(ntiles, 1)));
#pragma unroll 1
    while (e > 0 && ti < __builtin_amdgcn_readfirstlane(tab->tstart[e])) --e;
#pragma unroll 1
    while (e < NE - 1 && ti >= __builtin_amdgcn_readfirstlane(tab->tstart[e + 1])) ++e;
    const int mt = ti - __builtin_amdgcn_readfirstlane(tab->tstart[e]);
    const int be = __builtin_amdgcn_readfirstlane(tab->base[e]);
    const int cnt = __builtin_amdgcn_readfirstlane(tab->base[e + 1]) - be;
    u.i0 = be + mt * 256;
    u.i1 = min(256, cnt - mt * 256);
    u.i2 = e; u.i3 = nu;
    if (which == 0) {
      const u16* We = W + (long)e * 2048 * 1024;
      u.b0 = (const char*)(We + (long)(nu * 128) * 1024);
    } else {
      const u16* We = W + (long)e * 1024 * 1024;
      u.b0 = (const char*)(We + (long)(nu * 256) * 1024);
    }
    return true;
  }
};
struct Moe1Row { const int* slot_tok; static constexpr bool GATHER = true;
  __device__ __forceinline__ int operator()(const g8::Unit& u, int r) const { return slot_tok[u.i0 + min(r, u.i1 - 1)]; }
  __device__ __forceinline__ const int* addr(const g8::Unit& u, int r) const { return slot_tok + (u.i0 + min(r, u.i1 - 1)); } };
struct Moe2Row { static constexpr bool GATHER = false;
  __device__ __forceinline__ int operator()(const g8::Unit& u, int r) const { return u.i0 + min(r, u.i1 - 1); }
  __device__ __forceinline__ const int* addr(const g8::Unit&, int) const { return nullptr; } };
struct Moe1Epi {
  static constexpr int NST = 8;
  u16* act; u16* trash; const float* b_in;
  struct Pre { float4 g0, g1, l0, l1; };
  __device__ __forceinline__ void load(Pre& q, const g8::Unit& u, int wr, int wc, int fr, int fq) const {
    const float* bi = b_in + (long)u.i2 * 2048;
    const int ca = u.i3 * 128 + wc * 32 + fq * 8;
    q.g0 = *reinterpret_cast<const float4*>(bi + ca); q.g1 = *reinterpret_cast<const float4*>(bi + ca + 4);
    q.l0 = *reinterpret_cast<const float4*>(bi + 1024 + ca); q.l1 = *reinterpret_cast<const float4*>(bi + 1024 + ca + 4);
  }
  __device__ __forceinline__ void operator()(const f32x4 (&acc)[2][2][4][2], const g8::Unit& u, const Pre& q, int wr, int wc, int fr, int fq) const {
    const int ca = u.i3 * 128 + wc * 32 + fq * 8;
    const fl2_t bg2[4] = {{q.g0.x, q.g0.y}, {q.g0.z, q.g0.w}, {q.g1.x, q.g1.y}, {q.g1.z, q.g1.w}};
    const fl2_t bl2[4] = {{q.l0.x, q.l0.y}, {q.l0.z, q.l0.w}, {q.l1.x, q.l1.y}, {q.l1.z, q.l1.w}};
    const fl2_t one2 = {1.0f, 1.0f}, sc2 = {-2.4554669595929157f, -2.4554669595929157f};
#pragma unroll
    for (int ai = 0; ai < 2; ++ai)
#pragma unroll
      for (int m = 0; m < 4; ++m) {
        const int r = ai * 128 + wr * 64 + m * 16 + fr;
        uint4 o;
        unsigned ow[4];
#pragma unroll
        for (int n = 0; n < 2; ++n)
#pragma unroll
          for (int jp = 0; jp < 2; ++jp) {
            fl2_t g = fl2_t{acc[ai][0][m][n][2 * jp], acc[ai][0][m][n][2 * jp + 1]} + bg2[n * 2 + jp];
            fl2_t l = fl2_t{acc[ai][1][m][n][2 * jp], acc[ai][1][m][n][2 * jp + 1]} + bl2[n * 2 + jp];
            g.x = fminf(g.x, 7.0f); g.y = fminf(g.y, 7.0f);
            l.x = fminf(fmaxf(l.x, -7.0f), 7.0f); l.y = fminf(fmaxf(l.y, -7.0f), 7.0f);
            fl2_t e = g * sc2;
            e.x = __builtin_amdgcn_exp2f(e.x); e.y = __builtin_amdgcn_exp2f(e.y);
            e = e + one2;
            fl2_t s = {__builtin_amdgcn_rcpf(e.x), __builtin_amdgcn_rcpf(e.y)};
            const fl2_t v = (g * s) * (l + one2);
            ow[n * 2 + jp] = __builtin_bit_cast(unsigned, __builtin_convertvector(v, bf2_t));
          }
        o.x = ow[0]; o.y = ow[1]; o.z = ow[2]; o.w = ow[3];
        *reinterpret_cast<uint4*>(r < u.i1 ? act + (long)(u.i0 + r) * D + ca : trash + (r * 1024 + (ca & 1023))) = o;
      }
  }
};
struct Moe2Epi {
  static constexpr int NST = 16;
  u16* oslot; u16* trash; const float* b_out; const float* slot_gw;
  struct Pre { float4 b[2][2]; float gw[8]; };
  __device__ __forceinline__ void load(Pre& q, const g8::Unit& u, int wr, int wc, int fr, int fq) const {
    const float* bo = b_out + (long)u.i2 * 1024;
#pragma unroll
    for (int bj = 0; bj < 2; ++bj) {
      const int cc = u.i3 * 256 + bj * 128 + wc * 32 + fq * 8;
      q.b[bj][0] = *reinterpret_cast<const float4*>(bo + cc); q.b[bj][1] = *reinterpret_cast<const float4*>(bo + cc + 4);
    }
#pragma unroll
    for (int ai = 0; ai < 2; ++ai)
#pragma unroll
      for (int m = 0; m < 4; ++m) q.gw[ai * 4 + m] = slot_gw[u.i0 + min(ai * 128 + wr * 64 + m * 16 + fr, u.i1 - 1)];
  }
  __device__ __forceinline__ void operator()(const f32x4 (&acc)[2][2][4][2], const g8::Unit& u, const Pre& q, int wr, int wc, int fr, int fq) const {
#pragma unroll
    for (int ai = 0; ai < 2; ++ai)
#pragma unroll
      for (int m = 0; m < 4; ++m) {
        const int r = ai * 128 + wr * 64 + m * 16 + fr;
        const bool ok = r < u.i1;
        const float gw = q.gw[ai * 4 + m];
#pragma unroll
        for (int bj = 0; bj < 2; ++bj) {
          const int cc = u.i3 * 256 + bj * 128 + wc * 32 + fq * 8;
          const float4 b0 = q.b[bj][0], b1 = q.b[bj][1];
          const f32x4 v0 = acc[ai][bj][m][0], v1 = acc[ai][bj][m][1];
          const fl2_t g2 = {gw, gw};
          const fl2_t o0 = (fl2_t{v0[0], v0[1]} + fl2_t{b0.x, b0.y}) * g2, o1 = (fl2_t{v0[2], v0[3]} + fl2_t{b0.z, b0.w}) * g2;
          const fl2_t o2 = (fl2_t{v1[0], v1[1]} + fl2_t{b1.x, b1.y}) * g2, o3 = (fl2_t{v1[2], v1[3]} + fl2_t{b1.z, b1.w}) * g2;
          uint4 o;
          o.x = __builtin_bit_cast(unsigned, __builtin_convertvector(o0, bf2_t)); o.y = __builtin_bit_cast(unsigned, __builtin_convertvector(o1, bf2_t));
          o.z = __builtin_bit_cast(unsigned, __builtin_convertvector(o2, bf2_t)); o.w = __builtin_bit_cast(unsigned, __builtin_convertvector(o3, bf2_t));
          *reinterpret_cast<uint4*>(ok ? oslot + (long)(u.i0 + r) * D + cc : trash + (r * 1024 + cc)) = o;
        }
      }
  }
};
__device__ __forceinline__ void phase_moe_gemm1_8(const Params& p, int layer) {
  const MoeTab8* tab = moe_tab8(p, layer);
  MoeSched S; S.tab = tab; S.W = p.MoeInT + (long)layer * 32 * 2048 * 1024; S.NU = 8; S.G = gridDim.x; S.c = blockIdx.x; S.which = 0; S.b1delta = (long)1024 * 1024 * 2;
  Moe1Row R; R.slot_tok = p.slot_tok;
  Moe1Epi E; E.act = p.act; E.trash = p.trash; E.b_in = p.moe_b_in + (long)layer * 32 * 2048;
  g8::gemm_phase(p.abuf, D, S, R, E);
}
__device__ __forceinline__ void phase_moe_gemm2_8(const Params& p, int layer) {
  const MoeTab8* tab = moe_tab8(p, layer);
  MoeSched S; S.tab = tab; S.W = p.MoeOutT + (long)layer * 32 * 1024 * 1024; S.NU = 4; S.G = gridDim.x; S.c = blockIdx.x; S.which = 1; S.b1delta = (long)128 * 1024 * 2;
  Moe2Epi E; E.oslot = p.oslot; E.trash = p.trash; E.b_out = p.moe_b_out + (long)layer * 32 * 1024; E.slot_gw = p.slot_gw;
  g8::gemm_phase(p.act, D, S, Moe2Row(), E);
}
__device__ __forceinline__ void phase_gemm_dense(const Params& p, const u16* Bt, int Npad, int N, int mode) {
  const int ntn = Npad / 256;
  const int tiles = (T / 128) * ntn;
  const int tid = opaque_tid(), wid = tid >> 6, lane = tid & 63, wr = wid >> 1, wc = wid & 1, fr = lane & 15, fq = lane >> 4;
  for (int t = VBID; t < tiles; t += NVB) {
    const int mt = t / ntn, nt = t % ntn;
    f32x4 acc[4][8];
    gemm_tile(p.abuf, D, Bt, D, D, [&](int r) { return mt * 128 + r; }, [&](int r) { return nt * 256 + r; }, acc);
#pragma unroll
    for (int m = 0; m < 4; ++m)
#pragma unroll
      for (int n = 0; n < 8; ++n) {
        const long row = mt * 128 + wr * 64 + m * 16 + fr;
        const int col = nt * 256 + wc * 128 + n * 16 + fq * 4;
        if (mode == 0) {
          if (col < N) {
            uint2 o; o.x = pack2(acc[m][n][0], acc[m][n][1]); o.y = pack2(acc[m][n][2], acc[m][n][3]);
            *reinterpret_cast<uint2*>(p.zbuf + row * N + col) = o;
          }
        } else {
          { uint2 o; o.x = pack2(acc[m][n][0], acc[m][n][1]); o.y = pack2(acc[m][n][2], acc[m][n][3]); *reinterpret_cast<uint2*>(p.tmp + row * D + col) = o; }
        }
      }
  }
}

#ifndef WSLP_G
#define WSLP_G 0
#endif
#ifndef WSLP_R
#define WSLP_R 0
#endif
#ifndef RW_LATE
#define RW_LATE 1
#endif
#ifndef RW_WF
#define RW_WF 4
#endif
#ifndef GDN_WF
#define GDN_WF 0
#endif
#ifndef GDN_LATE
#define GDN_LATE 100
#endif
#ifndef REP_MOE
#define REP_MOE 1
#endif
#ifndef REP_DENSE
#define REP_DENSE 1
#endif
#ifndef REP_PREP
#define REP_PREP 1
#endif
#ifndef REP_SCAN
#define REP_SCAN 1
#endif
#ifndef REP_W
#define REP_W 1
#endif
#ifndef PREP_SKEW
#define PREP_SKEW 0
#endif
#ifndef REP_PREP_R
#define REP_PREP_R 1
#endif
#ifndef REP_PREP_G
#define REP_PREP_G 1
#endif
#ifndef REP_POST
#define REP_POST 1
#endif
#ifndef REP_COMB
#define REP_COMB 1
#endif
#ifndef REP_ROW
#define REP_ROW 1
#endif
#ifndef REP_POOL
#define REP_POOL 1
#endif
__global__ void __launch_bounds__(512, 2) mega(Params p) {
  cg::grid_group grid = cg::this_grid();
  volatile LAS unsigned* xbst = (volatile LAS unsigned*)(smem_raw + LDS_BYTES - 16);
  if (threadIdx.x == 0) { xbst[0] = 0u; xbst[1] = 0u; xbst[2] = 0u; xbst[3] = 0u; }
  __syncthreads();
  const XcdBarrier xb = xcd_barrier_post(p.bar, xbst);
  for (int rep = 0; rep < REP_W; ++rep) phase_weights(p, 0, p.early_tiles, VBID, NVB);
  phase_mods_partial(p);
  if (p.total_tiles < 0) grid.sync();
  xcd_barrier(xb);
  phase_mods_reduce(p);
  xcd_barrier(xb);
  for (int rep = 0; rep < REP_ROW; ++rep) phase_norm_in(p, 0, true);
  xcd_barrier(xb);
  for (int rep = 0; rep < REP_DENSE; ++rep) phase_gemm_dense8(p, p.WabT, AB_PAD, AB_IN, 0);
  xcd_barrier(xb);
  constexpr int RW_S0 = RW_LATE ? RW_CUT : NCH;
  static_assert(RW_S0 * NB * 12 * 2 <= RW_N0_ && RW_S0 % 5 == 0, "every item of the scan's first part must be prepared in the prep phase");
  for (int rep = 0; rep < REP_PREP_R; ++rep) { int bxp = blockIdx.x; asm volatile("" : "+s"(bxp)); if (bxp & 1) rwkv_prep_all<1, false>(p); else rwkv_prep_all<0, false>(p); }
  xcd_barrier(xb);
  {
#define RW_WSPLIT (p.early_tiles + ((int)(((long)(p.mid_tiles - p.early_tiles) * RW_WF) / 5) & ~15))
#pragma unroll 1
    for (int part = 0; part < (RW_LATE ? 2 : 1); ++part) {
      if (blockIdx.x < 48) {
        const int s_begin = part ? RW_S0 : 0, s_end = part ? NCH : RW_S0;
        if (half_id() == 0) rwkv_scan_block(p, blockIdx.x, s_begin, s_end); else rwkv_scan_copy(p, blockIdx.x, s_begin, s_end);
      } else if (part == 0) {
        if (RW_LATE) { int bxp = blockIdx.x; asm volatile("" : "+s"(bxp)); if (bxp & 1) rwkv_prep_all<1, true>(p); else rwkv_prep_all<0, true>(p); }
        for (int rep = 0; rep < REP_POOL; ++rep)
        for (int it = VBID - 96; it < NB * 260 * 4; it += NVB - 96) {
          int g = it & 3, r = it >> 2;
          int rb = r % 260, b = r / 260;
          pool_item(p, b, rb, g);
        }
        phase_weights<WSLP_R>(p, p.early_tiles, RW_LATE ? RW_WSPLIT : p.mid_tiles, VBID - 96, NVB - 96);
      } else {
        phase_weights<WSLP_R>(p, RW_WSPLIT, p.mid_tiles, VBID - 96, NVB - 96);
      }
      xcd_barrier(xb);
    }
  }
  for (int rep = 0; rep < REP_ROW; ++rep)
  for (int it = VBID; it < NB * NCH * 12; it += NVB) {
    int h = it % 12, r = it / 12;
    int c = r % NCH, b = r / NCH;
    rwkv_out_item(p, b, c, h);
  }
  xcd_barrier(xb);
  for (int rep = 0; rep < REP_DENSE; ++rep) phase_gemm_dense8(p, p.WoutT, 1024, 1024, 1);
  xcd_barrier(xb);
  for (int rep = 1; rep < REP_POST; ++rep) phase_post_mixer(p, 0, true);
  phase_post_mixer(p, 0);
  xcd_barrier(xb);
  phase_moe_scatter(p, 0);
  xcd_barrier(xb);
  for (int rep = 0; rep < REP_MOE; ++rep) { phase_moe_gemm1_8(p, 0);
  xcd_barrier(xb);
  phase_moe_gemm2_8(p, 0); if (rep + 1 < REP_MOE) xcd_barrier(xb); }
  xcd_barrier(xb);
  for (int rep = 1; rep < REP_COMB; ++rep) phase_moe_combine(p, 0, true);
  phase_moe_combine(p, 0);
  xcd_barrier(xb);
  for (int rep = 0; rep < REP_DENSE; ++rep) phase_gemm_dense8(p, p.WgdnT, GDN_PAD, GDN_IN, 0);
  xcd_barrier(xb);
  constexpr int GDN_S0 = GDN_S0_;
  for (int rep = 0; rep < REP_PREP_G; ++rep) { int bxp = blockIdx.x; asm volatile("" : "+s"(bxp)); if (bxp & 1) gdn_prep_all<1, false>(p); else gdn_prep_all<0, false>(p); }
  xcd_barrier(xb);
  {
    const int bx = blockIdx.x, sid2 = (((bx & 7) + 8 * (bx >> 4)) << 1) | ((bx >> 3) & 1);
#define GDN_WSPLIT (p.mid_tiles + ((int)(((long)(p.total_tiles - p.mid_tiles) * GDN_WF) / 5) & ~15))
#pragma unroll 1
    for (int part = 0; part < (GDN_LATE ? 2 : 1); ++part) {
      if (blockIdx.x < 64) {
        const int s_begin = part ? GDN_S0 : 0, s_end = part ? NCH : GDN_S0;
        if (half_id() == 0) gdn_scan_compute(p, sid2, s_begin, s_end); else gdn_scan_loader(p, sid2, s_begin, s_end);
      } else if (part == 0) {
        { int bxp = blockIdx.x; asm volatile("" : "+s"(bxp)); if (bxp & 1) gdn_prep_all<1, true>(p); else gdn_prep_all<0, true>(p); }
        phase_weights<WSLP_G>(p, p.mid_tiles, GDN_LATE ? GDN_WSPLIT : p.total_tiles, VBID - 128, NVB - 128);
      } else {
        phase_weights<WSLP_G>(p, GDN_WSPLIT, p.total_tiles, VBID - 128, NVB - 128);
      }
      xcd_barrier(xb);
    }
  }
  for (int rep = 0; rep < REP_ROW; ++rep) phase_gdn_out(p);
  xcd_barrier(xb);
  for (int rep = 0; rep < REP_DENSE; ++rep) phase_gemm_dense8(p, p.WoutT + 1024 * 1024, 1024, 1024, 1, 1);
  xcd_barrier(xb);
  for (int rep = 1; rep < REP_POST; ++rep) phase_post_mixer(p, 1, true);
  phase_post_mixer(p, 1);
  xcd_barrier(xb);
  phase_moe_scatter(p, 1);
  xcd_barrier(xb);
  for (int rep = 0; rep < REP_MOE; ++rep) { phase_moe_gemm1_8(p, 1);
  xcd_barrier(xb);
  phase_moe_gemm2_8(p, 1); if (rep + 1 < REP_MOE) xcd_barrier(xb); }
  xcd_barrier(xb);
  for (int rep = 1; rep < REP_COMB; ++rep) phase_moe_combine(p, 1, true);
  phase_moe_combine(p, 1);
}

extern "C" void kernel_launch(void* const* d_in, const int* in_sizes, int n_in, void* d_out, int out_size, void* d_ws,
                              size_t ws_size, hipStream_t stream) {
  static int grid_blocks = 0;
  if (!grid_blocks) {
    int dev = 0, cus = 0, per_cu = 0;
    (void)hipGetDevice(&dev);
    (void)hipDeviceGetAttribute(&cus, hipDeviceAttributeMultiprocessorCount, dev);
    (void)hipFuncSetAttribute((const void*)mega, hipFuncAttributeMaxDynamicSharedMemorySize, (int)LDS_BYTES);
    (void)hipOccupancyMaxActiveBlocksPerMultiprocessor(&per_cu, mega, 512, LDS_BYTES);
    if (per_cu > 1) per_cu = 1;
    if (per_cu < 1) per_cu = 1;
    grid_blocks = cus * per_cu;
  }
  Params p;
  memset(&p, 0, sizeof(p));
  const float** fp = (const float**)&p.x;
  for (int i = 0; i < 33; ++i) fp[i] = (const float*)d_in[i];
  p.out = (float*)d_out;
  char* ws = (char*)d_ws;
  size_t off = 0;
  auto take = [&](size_t bytes) { char* r = ws + off; off += (bytes + 255) & ~(size_t)255; return r; };
  p.cnt = (int*)take(32768);
  p.bar = (unsigned*)take((size_t)XCD_BAR_WORDS * 4);
  p.modpart = (float*)take((size_t)8 * 2 * 3 * 6144 * 4);
  p.mods = (float*)take((size_t)2 * 3 * 6144 * 4);
  p.WabT = (u16*)take((size_t)AB_PAD * 1024 * 2);
  p.WoutT = (u16*)take((size_t)2 * 1024 * 1024 * 2);
  p.WgdnT = (u16*)take((size_t)GDN_PAD * 1024 * 2);
  p.MoeInT = (u16*)take((size_t)64 * 2048 * 1024 * 2);
  p.MoeOutT = (u16*)take((size_t)64 * 1024 * 1024 * 2);
  p.WupT = (u16*)take((size_t)2 * 768 * 64 * 2);
  p.AupT = (u16*)take((size_t)2 * 768 * 64 * 2);
  p.GupT = (u16*)take((size_t)768 * 128 * 2);
  p.PoolT = (u16*)take((size_t)4 * 64 * 64 * 2);
  p.xs = (u16*)take((size_t)T * D * 2);
  p.abuf = (u16*)take((size_t)T * D * 2);
  p.zbuf = (u16*)take((size_t)T * GDN_IN * 2);
  p.tmp = p.zbuf;
  p.oslot = p.zbuf;
  p.prep = (u16*)take((size_t)NB * 8 * 2 * NCH * GD_ITEM * 2);
  p.act = p.prep;
  p.yf = (u16*)take((size_t)T * D * 2);
  p.yb = (u16*)take((size_t)T * D * 2);
  p.tok_e = (int*)take((size_t)T * 4 * 4);
  p.tok_gw = (float*)take((size_t)T * 4 * 4);
  p.tok_slot = (int*)take((size_t)T * 4 * 4);
  p.slot_tok = (int*)take((size_t)T * 4 * 4);
  p.slot_gw = (float*)take((size_t)T * 4 * 4);
  p.trash = (u16*)take((size_t)256 * 1024 * 2);
  if (off > ws_size) { fprintf(stderr, "workspace too small: need %zu have %zu\n", off, ws_size); return; }
  int ts = 0;
  auto fam = [&](int i, const float* src, u16* dst, int nmat, int K, int N, int Npad) {
    TFam& F = p.fam[i];
    F.src = src; F.dst = dst; F.nmat = nmat; F.K = K; F.N = N; F.Npad = Npad;
    F.sstride = (long)K * N; F.dstride = (long)Npad * K;
    F.tiles_per_mat = (K / 64) * (Npad / 64); F.tile_start = ts;
    ts += nmat * F.tiles_per_mat;
  };
  fam(0, p.ab_w_in, p.WabT, 1, 1024, AB_IN, AB_PAD);
  fam(1, p.w_out, p.WoutT, 2, 1024, 1024, 1024);
  fam(2, p.gdn_w_in, p.WgdnT, 1, 1024, GDN_IN, GDN_PAD);
  fam(3, p.rwkv_w_up, p.WupT, 2, 64, 768, 768);
  fam(4, p.rwkv_a_up, p.AupT, 2, 64, 768, 768);
  fam(5, p.rwkv_g_up, p.GupT, 1, 128, 768, 768);
  fam(6, p.pool_w, p.PoolT, 4, 64, 64, 64);
  p.early_tiles = ts;
  fam(7, p.moe_w_in, p.MoeInT, 32, 1024, 2048, 2048);
  fam(8, p.moe_w_out, p.MoeOutT, 32, 1024, 1024, 1024);
  p.mid_tiles = ts;
  fam(9, p.moe_w_in + (size_t)32 * 1024 * 2048, p.MoeInT + (size_t)32 * 2048 * 1024, 32, 1024, 2048, 2048);
  fam(10, p.moe_w_out + (size_t)32 * 1024 * 1024, p.MoeOutT + (size_t)32 * 1024 * 1024, 32, 1024, 1024, 1024);
  p.total_tiles = ts;
  (void)hipMemsetAsync(p.cnt, 0, 32768 + ((XCD_BAR_WORDS * 4 + 255) & ~255), stream);
  void* args[] = {&p};
  hipError_t e = hipLaunchCooperativeKernel((void*)mega, dim3(grid_blocks), dim3(512), args, LDS_BYTES, stream);
  if (e != hipSuccess) fprintf(stderr, "coop launch failed: %s (grid %d)\n", hipGetErrorString(e), grid_blocks);
}
```

```cpp
#include <hip/hip_runtime.h>
#include <hip/hip_cooperative_groups.h>
#include <cstdio>
#include <cstdint>
#include <cstring>
namespace cg = cooperative_groups;

typedef unsigned short u16;
using bf16x8 = __attribute__((ext_vector_type(8))) short;
using f32x4 = __attribute__((ext_vector_type(4))) float;
using u16x4 = __attribute__((ext_vector_type(4))) unsigned short;
#define MFMA16(a, b, c) __builtin_amdgcn_mfma_f32_16x16x32_bf16(a, b, c, 0, 0, 0)

constexpr int D = 1024, NB = 2, SEQ = 16384, CTXL = 256, PB = SEQ + CTXL, T = NB * PB, NCH = PB / 64;
constexpr int AB_IN = 2944, AB_PAD = 3072, GDN_IN = 4128, GDN_PAD = 4352, RWKV_IN = 2688;
constexpr int NE = 32, TOPK = 4;
constexpr int NTH = 256;
constexpr int LDS_HALF = 75776;
constexpr size_t LDS_BYTES = 2 * LDS_HALF;
constexpr int MB = 9216;
constexpr int RW_ITEM = 16384;
constexpr int GD_ITEM = 49152;

#define CNTI(layer, which, e) ((((layer) * 2 + (which)) * 32 + (e)) * 64)

struct TFam { const float* src; u16* dst; long sstride, dstride; int nmat, K, N, Npad, tiles_per_mat, tile_start; };

struct Params {
  const float *x, *c, *ctx, *c_ctx, *ada_w, *ada_b, *norm_g, *w_out, *ab_w_in, *ab_mu, *pool_w, *pool_scale,
      *rwkv_w0, *rwkv_w_up, *rwkv_a0, *rwkv_a_up, *rwkv_g_up, *rwkv_k_k, *rwkv_k_a, *rwkv_r_k, *rwkv_gn_w, *rwkv_gn_b,
      *gdn_w_in, *gdn_conv, *gdn_a_log, *gdn_dt_bias, *gdn_norm_g, *router_w, *router_b, *moe_w_in, *moe_b_in,
      *moe_w_out, *moe_b_out;
  float* out;
  int* cnt;
  unsigned* bar;
  float* modpart;
  float* mods;
  u16 *WabT, *WoutT, *WgdnT, *MoeInT, *MoeOutT, *WupT, *AupT, *GupT, *PoolT;
  u16* xs;
  u16* abuf;
  u16* zbuf;
  u16* tmp;
  u16* prep;
  u16 *yf, *yb;
  u16* act;
  u16* oslot;
  int* tok_e;
  float* tok_gw;
  int* tok_slot;
  int* slot_tok;
  float* slot_gw;
  u16* trash;
  TFam fam[11];
  int total_tiles;
  int early_tiles;
  int mid_tiles;
  int pad1;
};

typedef __bf16 bf2_t __attribute__((ext_vector_type(2)));
typedef float fl2_t __attribute__((ext_vector_type(2)));
__device__ __forceinline__ unsigned pack2(float a, float b) {
  fl2_t f = {a, b};
  bf2_t h = __builtin_convertvector(f, bf2_t);
  return __builtin_bit_cast(unsigned, h);
}
__device__ __forceinline__ u16 f2bf(float f) { return (u16)(pack2(f, 0.f) & 0xffffu); }
__device__ __forceinline__ float bf2f(u16 h) { return __uint_as_float(((unsigned)h) << 16); }
__device__ __forceinline__ float sigmoidf_(float x) { return __builtin_amdgcn_rcpf(1.0f + __expf(-x)); }
__device__ __forceinline__ float siluf_(float x) { return x * __builtin_amdgcn_rcpf(1.0f + __expf(-x)); }
__device__ __forceinline__ float softplusf_(float y) { return fmaxf(y, 0.0f) + __logf(1.0f + __expf(-fabsf(y))); }
__device__ __forceinline__ float tanhf_(float x) { return 2.0f * __builtin_amdgcn_rcpf(1.0f + __expf(-2.0f * x)) - 1.0f; }
typedef __bf16 bf2v_t __attribute__((ext_vector_type(2)));
__device__ __forceinline__ float dot2bf(unsigned a, unsigned b, float c) {
  return __builtin_amdgcn_fdot2_f32_bf16(__builtin_bit_cast(bf2v_t, a), __builtin_bit_cast(bf2v_t, b), c, false);
}
__device__ __forceinline__ float wave_sum(float v) {
#pragma unroll
  for (int o = 32; o > 0; o >>= 1) v += __shfl_xor(v, o);
  return v;
}
__device__ __forceinline__ float4 ld4bf(const u16* p) {
  uint2 a = *reinterpret_cast<const uint2*>(p);
  return make_float4(__uint_as_float(a.x << 16), __uint_as_float(a.x & 0xffff0000u), __uint_as_float(a.y << 16), __uint_as_float(a.y & 0xffff0000u));
}
__device__ __forceinline__ void st4bf(u16* p, float4 v) { uint2 o; o.x = pack2(v.x, v.y); o.y = pack2(v.z, v.w); *reinterpret_cast<uint2*>(p) = o; }
__device__ __forceinline__ void ld8(const u16* p, float* o) {
  uint4 v = *reinterpret_cast<const uint4*>(p);
  o[0] = __uint_as_float(v.x << 16); o[1] = __uint_as_float(v.x & 0xffff0000u);
  o[2] = __uint_as_float(v.y << 16); o[3] = __uint_as_float(v.y & 0xffff0000u);
  o[4] = __uint_as_float(v.z << 16); o[5] = __uint_as_float(v.z & 0xffff0000u);
  o[6] = __uint_as_float(v.w << 16); o[7] = __uint_as_float(v.w & 0xffff0000u);
}
__device__ __forceinline__ void st8(u16* p, const float* v) {
  uint4 o;
  o.x = pack2(v[0], v[1]); o.y = pack2(v[2], v[3]); o.z = pack2(v[4], v[5]); o.w = pack2(v[6], v[7]);
  *reinterpret_cast<uint4*>(p) = o;
}

extern __shared__ __attribute__((aligned(16))) unsigned char smem_raw[];
__device__ __forceinline__ int half_id() { return __builtin_amdgcn_readfirstlane((int)(threadIdx.x >> 8)); }
#define smem (smem_raw + half_id() * LDS_HALF)
#define VBID ((int)(blockIdx.x * 2 + half_id()))
#define NVB ((int)(gridDim.x * 2))
__device__ __forceinline__ int opaque_tid() { int t = threadIdx.x; asm volatile("" : "+v"(t)); return t & 255; }


#define XB_TMO      128
#define XB_XCNT(j)  (256  + 64 * (j))
#define XB_XSUB(j)  (1280 + 64 * (j))
#define XB_XGEN(j)  (2304 + 64 * (j))
#define XB_TOP      3328
#define XB_TOPGEN   3392
#define XCD_BAR_WORDS 3456
#define XB_SPIN_CAP (1u << 22)
#ifndef REP_BAR
#define REP_BAR 1
#endif
#define LAS __attribute__((address_space(3)))
__device__ __forceinline__ unsigned xb_ld(unsigned* p) { return __hip_atomic_load(p, __ATOMIC_RELAXED, __HIP_MEMORY_SCOPE_AGENT); }
__device__ __forceinline__ unsigned xb_add(unsigned* p, unsigned v) { return __hip_atomic_fetch_add(p, v, __ATOMIC_RELAXED, __HIP_MEMORY_SCOPE_AGENT); }
__device__ __forceinline__ unsigned xb_xcc_id() { return (unsigned)__builtin_amdgcn_s_getreg((3 << 11) | 20) & 0xFu; }
#define XB_SPIN(cond, bar) do { unsigned _sp = 0; while (cond) { __builtin_amdgcn_s_sleep(1); \
    if ((++_sp & 255u) == 0u) { if (xb_ld(&(bar)[XB_TMO])) break; if (_sp > XB_SPIN_CAP) { atomicAdd(&(bar)[XB_TMO], 1u); break; } } } } while (0)
struct XcdBarrier { unsigned* bar; unsigned x; volatile LAS unsigned* st; };
__device__ __forceinline__ XcdBarrier xcd_barrier_post(unsigned* bar, volatile LAS unsigned* st) {
  XcdBarrier b; b.bar = bar; b.x = xb_xcc_id(); b.st = st;
  if (threadIdx.x == 0) (void)xb_add(&bar[XB_XCNT(b.x)], 1u);
  return b;
}
__device__ __forceinline__ void xcd_barrier_complete(unsigned* bar, unsigned x, unsigned& nloc, unsigned& nx) {
  const unsigned G = gridDim.x * gridDim.y * gridDim.z;
  unsigned sum, cnt, mine, sp = 0u;
  for (;;) {
    sum = 0u; cnt = 0u; mine = 0u;
#pragma unroll
    for (unsigned j = 0; j < 16; ++j) { const unsigned c = xb_ld(&bar[XB_XCNT(j)]); sum += c; cnt += (c > 0u) ? 1u : 0u; mine = (j == x) ? c : mine; }
    if (sum == G) break;
    __builtin_amdgcn_s_sleep(1);
    if ((++sp & 255u) == 0u) { if (xb_ld(&bar[XB_TMO])) break; if (sp > XB_SPIN_CAP) { atomicAdd(&bar[XB_TMO], 1u); break; } }
  }
  nloc = mine > 0u ? mine : 1u; nx = cnt > 0u ? cnt : 1u;
}
__device__ __forceinline__ void xcd_barrier1(const XcdBarrier& b) {
  asm volatile("s_waitcnt vmcnt(0)" ::: "memory");
  __syncthreads();
  if (threadIdx.x == 0) {
    unsigned* bar = b.bar;
    const unsigned bx = xb_xcc_id();
    __builtin_amdgcn_s_waitcnt(0);
    unsigned nloc = b.st[0], nx = b.st[1];
    if (nloc == 0u) { xcd_barrier_complete(bar, bx, nloc, nx); b.st[0] = nloc; b.st[1] = nx; }
    const unsigned old = xb_add(&bar[XB_XSUB(bx)], 1u);
    const unsigned gen = old / nloc;
    if (old + 1u == (gen + 1u) * nloc) {
      __builtin_amdgcn_fence(__ATOMIC_RELEASE, "agent");
      asm volatile("s_waitcnt vmcnt(0)" ::: "memory");
      const unsigned og = xb_add(&bar[XB_TOP], 1u);
      const unsigned tg = og / nx;
      if (og + 1u == (tg + 1u) * nx) xb_add(&bar[XB_TOPGEN], 1u);
      else XB_SPIN(xb_ld(&bar[XB_TOPGEN]) == tg, bar);
      __builtin_amdgcn_fence(__ATOMIC_ACQUIRE, "agent");
      xb_add(&bar[XB_XGEN(bx)], 1u);
      asm volatile("s_waitcnt vmcnt(0)" ::: "memory");
    } else {
      XB_SPIN(xb_ld(&bar[XB_XGEN(bx)]) == gen, bar);
      __builtin_amdgcn_fence(__ATOMIC_ACQUIRE, "agent");
      asm volatile("s_waitcnt vmcnt(0)" ::: "memory");
    }
  }
  __syncthreads();
}

__device__ __forceinline__ void xcd_barrier(const XcdBarrier& b) { for (int r = 0; r < REP_BAR; ++r) xcd_barrier1(b); }

template <int SLP = 0>
__device__ __forceinline__ void phase_weights(const Params& p, int t_begin, int t_end, int blk, int nblk) {
  float* tl = (float*)smem;
  const int tid = opaque_tid();
  for (int w = t_begin + blk; w < t_end; w += nblk) {
    int f = 0;
#pragma unroll
    for (int i = 1; i < 11; ++i) if (w >= p.fam[i].tile_start) f = i;
    const TFam& F = p.fam[f];
    int loc = w - F.tile_start;
    int mat = loc / F.tiles_per_mat, tt = loc % F.tiles_per_mat;
    int ntn = F.Npad / 64;
    int k0 = (tt / ntn) * 64, n0 = (tt % ntn) * 64;
    const float* src = F.src + (long)mat * F.sstride;
    u16* dst = F.dst + (long)mat * F.dstride;
#pragma unroll
    for (int i = 0; i < 4; ++i) {
      int k = (tid >> 4) + 16 * i, n4 = (tid & 15) * 4;
      float4 v = make_float4(0.f, 0.f, 0.f, 0.f);
      if (n0 + n4 < F.N) v = *reinterpret_cast<const float4*>(src + (long)(k0 + k) * F.N + n0 + n4);
      tl[k * 65 + n4 + 0] = v.x; tl[k * 65 + n4 + 1] = v.y; tl[k * 65 + n4 + 2] = v.z; tl[k * 65 + n4 + 3] = v.w;
    }
    __syncthreads();
    {
      int n = tid >> 2, kq = (tid & 3) * 16;
      float v[16];
#pragma unroll
      for (int i = 0; i < 16; ++i) v[i] = tl[(kq + i) * 65 + n];
      u16* d = dst + (long)(n0 + n) * F.K + k0 + kq;
      st8(d, v); st8(d + 8, v + 8);
    }
    if (SLP) __builtin_amdgcn_s_sleep(SLP);
    __syncthreads();
  }
}

__device__ __forceinline__ void phase_mods_partial(const Params& p) {
  float* sl = (float*)smem;
  const int tid = opaque_tid();
  for (int it = VBID; it < 384; it += NVB) {
    int ks = it / 48, cb = it % 48;
    int o = cb * 256 + tid;
    int layer = o / 6144, col = o % 6144;
    __syncthreads();
    if (tid < 128) {
      int k = ks * 128 + tid;
      sl[tid] = siluf_(p.c[k]); sl[128 + tid] = siluf_(p.c[1024 + k]); sl[256 + tid] = siluf_(p.c_ctx[k]);
    }
    __syncthreads();
    const float* w = p.ada_w + (long)layer * 1024 * 6144 + (long)(ks * 128) * 6144 + col;
    float s0 = 0.f, s1 = 0.f, s2 = 0.f;
#pragma unroll 8
    for (int k = 0; k < 128; ++k) {
      float wv = w[(long)k * 6144];
      s0 += sl[k] * wv; s1 += sl[128 + k] * wv; s2 += sl[256 + k] * wv;
    }
    float* dst = p.modpart + ((long)(ks * 2 + layer) * 3) * 6144 + col;
    dst[0] = s0; dst[6144] = s1; dst[2 * 6144] = s2;
  }
  __syncthreads();
}

__device__ __forceinline__ void phase_mods_reduce(const Params& p) {
  for (int o = VBID * NTH + (int)(threadIdx.x & 255); o < 2 * 3 * 6144; o += NVB * NTH) {
    int layer = o / (3 * 6144), rem = o % (3 * 6144), col = rem % 6144;
    float s = p.ada_b[layer * 6144 + col];
#pragma unroll
    for (int ks = 0; ks < 8; ++ks) s += p.modpart[(long)(ks * 2 + layer) * 3 * 6144 + rem];
    p.mods[o] = s;
  }
}

__device__ __forceinline__ const float* modp(const Params& p, int layer, int mrow, int which) {
  return p.mods + ((long)(layer * 3 + mrow) * 6 + which) * 1024;
}

__device__ __forceinline__ void phase_norm_in(const Params& p, int layer, bool first) {
  const int tid_ = opaque_tid(); const int lane = tid_ & 63, wid = tid_ >> 6;
  const float* g = p.norm_g + (long)(layer * 4 + 0) * 1024;
  for (int row0 = VBID * 4 + wid; row0 < T; row0 += NVB * 8) {
    float4 v[2][4];
    int rows[2], mrows[2]; bool act[2];
#pragma unroll
    for (int q = 0; q < 2; ++q) {
      const int rq = row0 + q * NVB * 4;
      act[q] = rq < T;
      const int row = act[q] ? rq : row0;
      rows[q] = row;
      const int b = row / PB, pp = row % PB;
      mrows[q] = pp < CTXL ? 2 : b;
      const float* src;
      if (first) src = pp < CTXL ? p.ctx + ((long)b * CTXL + pp) * D : p.x + ((long)b * SEQ + (pp - CTXL)) * D;
      else src = (const float*)p.xs + (long)row * D;
#pragma unroll
      for (int i = 0; i < 4; ++i) v[q][i] = reinterpret_cast<const float4*>(src)[i * 64 + lane];
    }
    float ss[2];
#pragma unroll
    for (int q = 0; q < 2; ++q) {
      ss[q] = 0.f;
#pragma unroll
      for (int i = 0; i < 4; ++i) ss[q] += v[q][i].x * v[q][i].x + v[q][i].y * v[q][i].y + v[q][i].z * v[q][i].z + v[q][i].w * v[q][i].w;
    }
#pragma unroll
    for (int o = 32; o > 0; o >>= 1) { ss[0] += __shfl_xor(ss[0], o); ss[1] += __shfl_xor(ss[1], o); }
#pragma unroll
    for (int q = 0; q < 2; ++q) {
      if (!act[q]) continue;
      const int row = rows[q];
      const float rstd = rsqrtf(ss[q] * (1.0f / 1024.0f) + 1e-6f);
      const float* sh = modp(p, layer, mrows[q], 0);
      const float* sc = modp(p, layer, mrows[q], 1);
#pragma unroll
      for (int i = 0; i < 4; ++i) {
        int col = (i * 64 + lane) * 4;
        float4 gg = *reinterpret_cast<const float4*>(g + col);
        float4 s4 = *reinterpret_cast<const float4*>(sh + col);
        float4 c4 = *reinterpret_cast<const float4*>(sc + col);
        float h0 = v[q][i].x * rstd * gg.x * (1.f + c4.x) + s4.x;
        float h1 = v[q][i].y * rstd * gg.y * (1.f + c4.y) + s4.y;
        float h2 = v[q][i].z * rstd * gg.z * (1.f + c4.z) + s4.z;
        float h3 = v[q][i].w * rstd * gg.w * (1.f + c4.w) + s4.w;
        uint2 o; o.x = pack2(h0, h1); o.y = pack2(h2, h3);
        *reinterpret_cast<uint2*>(p.abuf + (long)row * D + col) = o;
      }
    }
  }
}

#ifndef GP_DS
#define GP_DS 0
#endif
#ifndef GP_MFMA
#define GP_MFMA 0
#endif
__device__ __forceinline__ int swz4(int row) { return (0x78 >> (((row >> 2) & 3) * 2)) & 3; }
template <typename AMap, typename BMap>
__device__ __forceinline__ void gemm_tile(const u16* __restrict__ A, long lda, const u16* __restrict__ Bt, long ldb, int K,
                                          AMap amap, BMap bmap, f32x4 (&acc)[4][8]) {
  char* S = (char*)smem;
  const int tid = opaque_tid(), lane = tid & 63, fr = lane & 15, fq = lane >> 4;
  const int wid = __builtin_amdgcn_readfirstlane(tid >> 6), wr = wid >> 1, wc = wid & 1;
  const u16* pa[2];
  const u16* pb[4];
#pragma unroll
  for (int i = 0; i < 2; ++i) {
    const int q = i * 256 + tid, r = q >> 2, kc = (q & 3) ^ swz4(r);
    pa[i] = A + (long)amap(r) * lda + kc * 8;
  }
#pragma unroll
  for (int i = 0; i < 4; ++i) {
    const int q = i * 256 + tid, r = q >> 2, kc = (q & 3) ^ swz4(r);
    pb[i] = Bt + (long)bmap(r) * ldb + kc * 8;
  }
#pragma unroll
  for (int m = 0; m < 4; ++m)
#pragma unroll
    for (int n = 0; n < 8; ++n) acc[m][n] = f32x4{0.f, 0.f, 0.f, 0.f};
  const int nk = K / 32;
  int offA[4], offB[8];
#pragma unroll
  for (int m = 0; m < 4; ++m) { const int ra = wr * 64 + m * 16 + fr; offA[m] = ra * 64 + ((fq ^ swz4(ra)) << 4); }
#pragma unroll
  for (int n = 0; n < 8; ++n) { const int rb = wc * 128 + n * 16 + fr; offB[n] = 8192 + rb * 64 + ((fq ^ swz4(rb)) << 4); }
  __syncthreads();
#pragma unroll
  for (int t = 0; t < 2; ++t) {
    char* st = S + t * 24576;
#pragma unroll
    for (int i = 0; i < 2; ++i) __builtin_amdgcn_global_load_lds((const unsigned*)(pa[i] + t * 32), (LAS unsigned*)(st + (i * 256 + tid) * 16), 16, 0, 0);
#pragma unroll
    for (int i = 0; i < 4; ++i) __builtin_amdgcn_global_load_lds((const unsigned*)(pb[i] + t * 32), (LAS unsigned*)(st + 8192 + (i * 256 + tid) * 16), 16, 0, 0);
  }
  int cs = 0;
  for (int kt = 0; kt < nk; ++kt) {
    if (kt + 1 < nk) asm volatile("s_waitcnt vmcnt(6)" ::: "memory");
    else asm volatile("s_waitcnt vmcnt(0)" ::: "memory");
    __builtin_amdgcn_s_barrier();
    asm volatile("" ::: "memory");
    char* cur = S + cs * 24576;
    if (kt + 2 < nk) {
      int ns = cs + 2; if (ns >= 3) ns -= 3;
      char* nx = S + ns * 24576;
#pragma unroll
      for (int i = 0; i < 2; ++i) __builtin_amdgcn_global_load_lds((const unsigned*)(pa[i] + (kt + 2) * 32), (LAS unsigned*)(nx + (i * 256 + tid) * 16), 16, 0, 0);
#pragma unroll
      for (int i = 0; i < 4; ++i) __builtin_amdgcn_global_load_lds((const unsigned*)(pb[i] + (kt + 2) * 32), (LAS unsigned*)(nx + 8192 + (i * 256 + tid) * 16), 16, 0, 0);
    }
#if GP_NOBAR2
#endif
    bf16x8 af[4], bfr[8];
#pragma unroll
    for (int m = 0; m < 4; ++m) af[m] = *reinterpret_cast<const bf16x8*>(cur + offA[m]);
#pragma unroll
    for (int n = 0; n < 8; ++n) bfr[n] = *reinterpret_cast<const bf16x8*>(cur + offB[n]);
#if GP_DS
    {
      bf16x8 t2[4];
#pragma unroll
      for (int rr = 0; rr < 3; ++rr) {
#pragma unroll
        for (int m = 0; m < 4; ++m) t2[m] = *reinterpret_cast<const volatile bf16x8*>(cur + offB[m + (rr & 1) * 4]);
#pragma unroll
        for (int m = 0; m < 4; ++m) asm volatile("" :: "v"(t2[m]));
      }
    }
#endif
#pragma unroll
    for (int m = 0; m < 4; ++m)
#pragma unroll
      for (int n = 0; n < 8; ++n) acc[m][n] = MFMA16(bfr[n], af[m], acc[m][n]);
#if GP_MFMA
    {
      f32x4 d2[8];
#pragma unroll
      for (int n = 0; n < 8; ++n) d2[n] = f32x4{0.f, 0.f, 0.f, 0.f};
#pragma unroll
      for (int m = 0; m < 4; ++m)
#pragma unroll
        for (int n = 0; n < 8; ++n) d2[n] = MFMA16(bfr[n], af[m], d2[n]);
#pragma unroll
      for (int n = 0; n < 8; ++n) asm volatile("" :: "v"(d2[n]));
    }
#endif
    cs = cs + 1; if (cs >= 3) cs = 0;
  }
  __syncthreads();
}
#ifndef RP_A
#define RP_A 1
#endif
#ifndef RP_B
#define RP_B 1
#endif
#ifndef RP_C
#define RP_C 1
#endif
#ifndef RP_D
#define RP_D 1
#endif
template <int KK, int NT>
__device__ __forceinline__ void mm_strip(const u16* A, int lda, int arow0, const u16* Bt, int ldb, int brow0, f32x4* acc, int lane) {
  const int fr = lane & 15, fq = lane >> 4;
#pragma unroll
  for (int ks = 0; ks < KK / 32; ++ks) {
    bf16x8 a = *reinterpret_cast<const bf16x8*>(A + (arow0 + fr) * lda + ks * 32 + fq * 8);
#pragma unroll
    for (int nt = 0; nt < NT; ++nt) {
      bf16x8 b = *reinterpret_cast<const bf16x8*>(Bt + (brow0 + nt * 16 + fr) * ldb + ks * 32 + fq * 8);
      acc[nt] = MFMA16(a, b, acc[nt]);
    }
  }
}

template <int t>
__device__ __forceinline__ void solve_load_row(uint4 (&r)[8], const u16* Ls) {
  constexpr int nb = ((t + 1) / 2 + 3) / 4;
#pragma unroll
  for (int q = 0; q < nb; ++q) r[q] = *reinterpret_cast<const uint4*>(Ls + t * 72 + q * 8);
}
template <int t, bool IDENT>
__device__ __forceinline__ void solve_rows(float (&x)[64], unsigned (&xp)[32], const u16* Ls, int lane, uint4 (&r0)[8], uint4 (&r1)[8], uint4 (&r2)[8]) {
  if constexpr (t + 2 < 64) solve_load_row<t + 2>(r2, Ls);
  __builtin_amdgcn_sched_barrier(0);
  constexpr int npair = (t + 1) / 2, nb = (npair + 3) / 4;
  float sa[2] = {0.f, 0.f};
#pragma unroll
  for (int q = 0; q < nb; ++q) {
    const unsigned w[4] = {r0[q].x, r0[q].y, r0[q].z, r0[q].w};
#pragma unroll
    for (int e = 0; e < 4; ++e)
      if (q * 4 + e < npair) sa[e & 1] = dot2bf(w[e], xp[q * 4 + e], sa[e & 1]);
  }
  const float xt = (IDENT ? (lane == t ? 1.f : 0.f) : x[t]) - (sa[0] + sa[1]);
  x[t] = xt;
  if constexpr (t & 1) xp[t >> 1] = pack2(x[t - 1], xt);
  else xp[t >> 1] = pack2(xt, 0.f);
  if constexpr (t + 1 < 64) solve_rows<t + 1, IDENT>(x, xp, Ls, lane, r1, r2, r0);
}
template <bool IDENT = false>
__device__ __forceinline__ void fwd_solve64(float (&x)[64], const u16* Ls, u16* dst, int lane = 0) {
  unsigned xp[32];
  uint4 r0[8], r1[8], r2[8];
  solve_load_row<1>(r0, Ls);
  solve_load_row<2>(r1, Ls);
  if (IDENT) x[0] = (lane == 0) ? 1.f : 0.f;
  xp[0] = pack2(x[0], 0.f);
  solve_rows<1, IDENT>(x, xp, Ls, lane, r0, r1, r2);
#pragma unroll
  for (int q = 0; q < 8; ++q) {
    uint4 o;
    o.x = xp[4 * q + 0] ^ 0x80008000u; o.y = xp[4 * q + 1] ^ 0x80008000u;
    o.z = xp[4 * q + 2] ^ 0x80008000u; o.w = xp[4 * q + 3] ^ 0x80008000u;
    *reinterpret_cast<uint4*>(dst + 8 * q) = o;
  }
}

__device__ __forceinline__ void load_mixed8(const u16* pz, bool hp, bool hn, const float* m0, float* out) {
  float c[8], pv[8], nx[8];
  ld8(pz, c);
  if (hp) ld8(pz - AB_IN, pv);
  else {
#pragma unroll
    for (int e = 0; e < 8; ++e) pv[e] = 0.f;
  }
  if (hn) ld8(pz + AB_IN, nx);
  else {
#pragma unroll
    for (int e = 0; e < 8; ++e) nx[e] = 0.f;
  }
  const float4 a0 = *reinterpret_cast<const float4*>(m0), a1 = *reinterpret_cast<const float4*>(m0 + 4);
  const float4 b0 = *reinterpret_cast<const float4*>(m0 + RWKV_IN), b1 = *reinterpret_cast<const float4*>(m0 + RWKV_IN + 4);
  const float ma[8] = {a0.x, a0.y, a0.z, a0.w, a1.x, a1.y, a1.z, a1.w};
  const float mb[8] = {b0.x, b0.y, b0.z, b0.w, b1.x, b1.y, b1.z, b1.w};
#pragma unroll
  for (int e = 0; e < 8; ++e) out[e] = c[e] + ma[e] * (pv[e] - c[e]) + mb[e] * (nx[e] - c[e]);
}
__device__ __forceinline__ void load_mixed16(const u16* zb, long row, int pp, int col, const float* mu, float* out) {
  const u16* pz = zb + row * AB_IN + col;
  const bool hp = !(pp == 0 || pp == CTXL), hn = !(pp == CTXL - 1 || pp == PB - 1);
  load_mixed8(pz, hp, hn, mu + (col - 256), out);
  __builtin_amdgcn_sched_barrier(0);
  load_mixed8(pz + 8, hp, hn, mu + (col - 256) + 8, out + 8);
  __builtin_amdgcn_sched_barrier(0);
}

template <int DIR>
__device__ __forceinline__ void load_mixed_2x8(const u16* zb, int b, int c, int rp, int col, const float* mu, float (&out)[2][8]) {
  const int tmin = DIR ? 62 - 2 * rp : 2 * rp;
  const int pp0 = c * 64 + tmin;
  const int seg_lo = (c < 4) ? 0 : CTXL, seg_hi = (c < 4) ? CTXL : PB;
  const u16* pz = zb + ((long)b * PB + pp0) * AB_IN + col;
  float zr[4][8];
#pragma unroll
  for (int j = 0; j < 4; ++j) {
    const int pt = pp0 - 1 + j;
    if (pt >= seg_lo && pt < seg_hi) ld8(pz + (long)(j - 1) * AB_IN, zr[j]);
    else {
#pragma unroll
      for (int e = 0; e < 8; ++e) zr[j][e] = 0.f;
    }
  }
  const float* m0 = mu + (col - 256);
  const float4 a0 = *reinterpret_cast<const float4*>(m0), a1 = *reinterpret_cast<const float4*>(m0 + 4);
  const float4 b0 = *reinterpret_cast<const float4*>(m0 + RWKV_IN), b1 = *reinterpret_cast<const float4*>(m0 + RWKV_IN + 4);
  const float ma[8] = {a0.x, a0.y, a0.z, a0.w, a1.x, a1.y, a1.z, a1.w};
  const float mb[8] = {b0.x, b0.y, b0.z, b0.w, b1.x, b1.y, b1.z, b1.w};
#pragma unroll
  for (int r = 0; r < 2; ++r) {
    const int to = DIR ? 1 - r : r;
#pragma unroll
    for (int e = 0; e < 8; ++e) {
      const float cc = zr[to + 1][e];
      out[r][e] = cc + ma[e] * (zr[to][e] - cc) + mb[e] * (zr[to + 2][e] - cc);
    }
  }
}

using u32x4 = __attribute__((ext_vector_type(4))) unsigned;
__device__ __forceinline__ void load_raw4(const char* ub, unsigned loff, int c, int tmin, u32x4 (&raw)[4]) {
  const int pp0 = c * 64 + tmin;
  const int seg_lo = (c < 4) ? 0 : CTXL, seg_hi = (c < 4) ? CTXL : PB;
#pragma unroll
  for (int j = 0; j < 4; ++j) {
    const int pt = pp0 - 1 + j;
    if (pt >= seg_lo && pt < seg_hi) raw[j] = *reinterpret_cast<const u32x4*>(ub + (long)(j - 1) * (AB_IN * 2) + loff);
    else raw[j] = u32x4{0u, 0u, 0u, 0u};
  }
}
template <int DIR>
__device__ __forceinline__ void mix_raw_2x8(const u32x4 (&raw)[4], int col, const float* mu, float (&out)[2][8]) {
  float zr[4][8];
#pragma unroll
  for (int j = 0; j < 4; ++j) {
#pragma unroll
    for (int q = 0; q < 4; ++q) { zr[j][2 * q] = __uint_as_float(raw[j][q] << 16); zr[j][2 * q + 1] = __uint_as_float(raw[j][q] & 0xffff0000u); }
  }
  const float* m0 = mu + (col - 256);
  const float4 a0 = *reinterpret_cast<const float4*>(m0), a1 = *reinterpret_cast<const float4*>(m0 + 4);
  const float4 b0 = *reinterpret_cast<const float4*>(m0 + RWKV_IN), b1 = *reinterpret_cast<const float4*>(m0 + RWKV_IN + 4);
  const float ma[8] = {a0.x, a0.y, a0.z, a0.w, a1.x, a1.y, a1.z, a1.w};
  const float mb[8] = {b0.x, b0.y, b0.z, b0.w, b1.x, b1.y, b1.z, b1.w};
#pragma unroll
  for (int r = 0; r < 2; ++r) {
    const int to = DIR ? 1 - r : r;
#pragma unroll
    for (int e = 0; e < 8; ++e) {
      const float cc = zr[to + 1][e];
      out[r][e] = cc + ma[e] * (zr[to][e] - cc) + mb[e] * (zr[to + 2][e] - cc);
    }
  }
}

#ifndef RW_LATE
#define RW_LATE 1
#endif
#ifndef RW_R0
#define RW_R0 22
#endif
#ifndef RW_CUT
#define RW_CUT 230
#endif
constexpr int RW_N0_ = RW_LATE ? RW_R0 * 512 : NB * NCH * 12 * 2;
template <int DIR, bool LATEPART>
__device__ __forceinline__ void rwkv_prep_all(const Params& p) {
  constexpr int RWN_ = NB * NCH * 12 * 2;
  const int it_first = LATEPART ? RW_N0_ + VBID - 96 : VBID, it_end = LATEPART ? RWN_ : RW_N0_, it_stride = LATEPART ? NVB - 96 : NVB;
  const u16* z = p.zbuf;
  const float* mu = p.ab_mu;
  u32x4 rwd[4], rad[4], rk[4], rr[4], rv[4], swv[2], sav[2];
#define RWKV_ZB(B_, C_, COL) ((const char*)(z + ((long)(B_) * PB + (C_) * 64) * AB_IN + (COL)))
#define RWKV_ISSUE(IT, TID) do { int r_ = (IT) >> 1; const int h_ = r_ % 12; r_ /= 12; const int b_ = r_ % NB, o_ = r_ / NB; \
    const int c_ = DIR ? (o_ < 4 ? 3 - o_ : 263 - o_) : o_; \
    const int rp_ = (TID) >> 3, tmin_ = DIR ? 62 - 2 * rp_ : 2 * rp_; \
    const unsigned zoff_ = (unsigned)(tmin_ * AB_IN + ((TID) & 7) * 8) * 2u, woff_ = (unsigned)(((TID) >> 2) * 64 + ((TID) & 3) * 16) * 2u; \
    load_raw4(RWKV_ZB(b_, c_, 2688 + DIR * 64), zoff_, c_, tmin_, rwd); \
    load_raw4(RWKV_ZB(b_, c_, 2816 + DIR * 64), zoff_, c_, tmin_, rad); \
    const char* sw_ = (const char*)(p.WupT + ((long)DIR * 768 + 64 * h_) * 64); \
    const char* sa_ = (const char*)(p.AupT + ((long)DIR * 768 + 64 * h_) * 64); \
    swv[0] = *reinterpret_cast<const u32x4*>(sw_ + woff_); swv[1] = *reinterpret_cast<const u32x4*>(sw_ + 16 + woff_); \
    sav[0] = *reinterpret_cast<const u32x4*>(sa_ + woff_); sav[1] = *reinterpret_cast<const u32x4*>(sa_ + 16 + woff_); } while (0)
  { const int tid0 = opaque_tid(); RWKV_ISSUE(min(it_first, it_end - 2), tid0); }
#pragma unroll 1
  for (int it = it_first; it < it_end; it += it_stride) {
  u16* buf[8];
#pragma unroll
  for (int i = 0; i < 8; ++i) buf[i] = (u16*)(smem + i * MB);
  float* LW = (float*)(smem + 5 * MB);
  u16* AA = buf[7];
  float* gC = (float*)(smem + 8 * MB);
  const int tid = opaque_tid(), lane = tid & 63, wid = tid >> 6, fr = lane & 15, fq = lane >> 4;
  const int i = tid >> 2, sub = tid & 3, cj = sub * 16;
  const int cg8 = (tid & 7) * 8, rp = tid >> 3;
  const int tmin = DIR ? 62 - 2 * rp : 2 * rp;
  const unsigned zoff = (unsigned)(tmin * AB_IN + cg8) * 2u;
  int b, c, h;
  { int r_ = it >> 1; h = r_ % 12; r_ /= 12; b = r_ % NB; const int o_ = r_ / NB; c = DIR ? (o_ < 4 ? 3 - o_ : 263 - o_) : o_; }
  load_raw4(RWKV_ZB(b, c, 1024 + 64 * h), zoff, c, tmin, rk);
  load_raw4(RWKV_ZB(b, c, 256 + 64 * h), zoff, c, tmin, rr);
  load_raw4(RWKV_ZB(b, c, 1792 + 64 * h), zoff, c, tmin, rv);
  {
    {
      const int cg = cg8;
      float wd[2][8], ad[2][8];
      mix_raw_2x8<DIR>(rwd, 2688 + DIR * 64 + cg, mu, wd);
      mix_raw_2x8<DIR>(rad, 2816 + DIR * 64 + cg, mu, ad);
#pragma unroll
      for (int r = 0; r < 2; ++r) {
#pragma unroll
        for (int e = 0; e < 8; ++e) wd[r][e] = tanhf_(wd[r][e]);
        st8(buf[0] + (2 * rp + r) * 72 + cg, wd[r]);
        st8(buf[1] + (2 * rp + r) * 72 + cg, ad[r]);
      }
    }
    *reinterpret_cast<u32x4*>(buf[2] + i * 72 + cj) = swv[0];
    *reinterpret_cast<u32x4*>(buf[2] + i * 72 + cj + 8) = swv[1];
    *reinterpret_cast<u32x4*>(buf[3] + i * 72 + cj) = sav[0];
    *reinterpret_cast<u32x4*>(buf[3] + i * 72 + cj + 8) = sav[1];
  }
  __syncthreads();
  {
    f32x4 aw[4], aa[4];
#pragma unroll
    for (int n = 0; n < 4; ++n) { aw[n] = f32x4{0.f, 0.f, 0.f, 0.f}; aa[n] = f32x4{0.f, 0.f, 0.f, 0.f}; }
    mm_strip<64, 4>(buf[0], 72, 16 * wid, buf[2], 72, 0, aw, lane);
    mm_strip<64, 4>(buf[1], 72, 16 * wid, buf[3], 72, 0, aa, lane);
    float* stot = gC + 64;
    float cum[4][4];
#pragma unroll
    for (int nt = 0; nt < 4; ++nt) {
      const int col = 16 * nt + fr, ch = 64 * h + col;
      const float w0v = p.rwkv_w0[DIR * 768 + ch], a0v = p.rwkv_a0[DIR * 768 + ch];
      float run = 0.f;
#pragma unroll
      for (int j = 0; j < 4; ++j) {
        const int t = 16 * wid + 4 * fq + j;
        const float xw = w0v + aw[nt][j];
        const float wlog = -softplusf_(-xw) - 0.5f;
        run += -__expf(wlog);
        cum[nt][j] = run;
        AA[t * 72 + col] = f2bf(sigmoidf_(a0v + aa[nt][j]));
      }
      const float s1 = __shfl_up(run, 16), s2 = __shfl_up(run, 32), s3 = __shfl_up(run, 48);
      const float excl = (fq >= 1 ? s1 : 0.f) + (fq >= 2 ? s2 : 0.f) + (fq >= 3 ? s3 : 0.f);
#pragma unroll
      for (int j = 0; j < 4; ++j) cum[nt][j] += excl;
      if (fq == 3) stot[wid * 64 + col] = cum[nt][3];
    }
    __syncthreads();
#pragma unroll
    for (int nt = 0; nt < 4; ++nt) {
      const int col = 16 * nt + fr;
      float off = 0.f;
#pragma unroll
      for (int w2 = 0; w2 < 3; ++w2) off += (w2 < wid) ? stot[w2 * 64 + col] : 0.f;
#pragma unroll
      for (int j = 0; j < 4; ++j) LW[(16 * wid + 4 * fq + j) * 65 + col] = cum[nt][j] + off;
      if (wid == 3 && fq == 3) gC[col] = __expf(cum[nt][3] + off);
    }
  }
  __syncthreads();
  {
    const int cg = cg8;
    float k8[2][8], Lg[2][8];
    mix_raw_2x8<DIR>(rk, 1024 + 64 * h + cg, mu, k8);
#pragma unroll
    for (int r = 0; r < 2; ++r) {
      const int ii = 2 * rp + r;
      float kk[8], ss = 0.f;
#pragma unroll
      for (int e = 0; e < 8; ++e) { kk[e] = k8[r][e] * p.rwkv_k_k[64 * h + cg + e]; ss += kk[e] * kk[e]; }
      ss += __shfl_xor(ss, 1); ss += __shfl_xor(ss, 2); ss += __shfl_xor(ss, 4);
      const float inv = rsqrtf(ss + 1e-6f);
      float Ah[8], Bh[8], Kh[8];
#pragma unroll
      for (int e = 0; e < 8; ++e) {
        const int col = cg + e;
        Lg[r][e] = LW[ii * 65 + col];
        const float Lgm1 = ii > 0 ? LW[(ii - 1) * 65 + col] : 0.f;
        const float a = bf2f(AA[ii * 72 + col]);
        const float kkn = kk[e] * inv;
        const float einv = __expf(-Lg[r][e]);
        const float kt = k8[r][e] * (1.f + (a - 1.f) * p.rwkv_k_a[64 * h + col]);
        Ah[e] = __expf(Lgm1) * kkn;
        Bh[e] = kkn * a * einv;
        Kh[e] = kt * einv;
      }
      st8(buf[0] + ii * 72 + cg, Ah);
      st8(buf[1] + ii * 72 + cg, Bh);
      st8(buf[2] + ii * 72 + cg, Kh);
    }
    __builtin_amdgcn_sched_barrier(0);
    {
      float r8[2][8];
      mix_raw_2x8<DIR>(rr, 256 + 64 * h + cg, mu, r8);
#pragma unroll
      for (int r = 0; r < 2; ++r) {
#pragma unroll
        for (int e = 0; e < 8; ++e) r8[r][e] *= __expf(Lg[r][e]);
        st8(buf[3] + (2 * rp + r) * 72 + cg, r8[r]);
      }
    }
    __builtin_amdgcn_sched_barrier(0);
    {
      float v8[2][8];
      mix_raw_2x8<DIR>(rv, 1792 + 64 * h + cg, mu, v8);
#pragma unroll
      for (int r = 0; r < 2; ++r)
#pragma unroll
        for (int e = 0; e < 8; ++e) buf[4][(cg + e) * 72 + 2 * rp + r] = f2bf(v8[r][e]);
    }
  }
  __syncthreads();
  {
    f32x4 a1[4], a2[4];
#pragma unroll
    for (int n = 0; n < 4; ++n) { a1[n] = f32x4{0.f, 0.f, 0.f, 0.f}; a2[n] = f32x4{0.f, 0.f, 0.f, 0.f}; }
    mm_strip<64, 4>(buf[0], 72, 16 * wid, buf[1], 72, 0, a1, lane);
    mm_strip<64, 4>(buf[0], 72, 16 * wid, buf[2], 72, 0, a2, lane);
#pragma unroll
    for (int nt = 0; nt < 4; ++nt)
#pragma unroll
      for (int j = 0; j < 4; ++j) {
        int t = 16 * wid + 4 * fq + j, s = 16 * nt + fr;
        buf[5][t * 72 + s] = f2bf(s < t ? a1[nt][j] : 0.f);
        buf[6][t * 72 + s] = f2bf(s < t ? a2[nt][j] : 0.f);
      }
  }
  __syncthreads();
  {
    f32x4 a1[4];
#pragma unroll
    for (int n = 0; n < 4; ++n) a1[n] = f32x4{0.f, 0.f, 0.f, 0.f};
    mm_strip<64, 4>(buf[6], 72, 16 * wid, buf[4], 72, 0, a1, lane);
#pragma unroll
    for (int nt = 0; nt < 4; ++nt)
#pragma unroll
      for (int j = 0; j < 4; ++j) {
        int t = 16 * wid + 4 * fq + j, v = 16 * nt + fr;
        buf[7][v * 72 + t] = f2bf(a1[nt][j]);
      }
  }
  __syncthreads();
  {
    float xr[64];
    const int st = tid ^ (half_id() << 7);
    if (st < 64) {
#pragma unroll
      for (int t = 0; t < 64; ++t) xr[t] = bf2f(buf[0][t * 72 + st]);
    } else if (st < 128) {
#pragma unroll
      for (int t = 0; t < 64; t += 8) ld8(buf[7] + (st - 64) * 72 + t, xr + t);
    }
    __syncthreads();
    if (st < 128) {
      u16* dst = st < 64 ? buf[0] + st * 72 : buf[7] + (st - 64) * 72;
      fwd_solve64(xr, buf[5], dst);
    }
  }
  { const int tidn = opaque_tid(); RWKV_ISSUE((it + it_stride < it_end ? it + it_stride : it), tidn); }
  __syncthreads();
  {
    unsigned bgp[8], kgp[8];
    {
      float bs[16], ks_[16];
      ld8(buf[1] + i * 72 + cj, bs); ld8(buf[1] + i * 72 + cj + 8, bs + 8);
      ld8(buf[2] + i * 72 + cj, ks_); ld8(buf[2] + i * 72 + cj + 8, ks_ + 8);
#pragma unroll
      for (int e = 0; e < 8; ++e) {
        float g0 = gC[cj + 2 * e], g1 = gC[cj + 2 * e + 1];
        bgp[e] = pack2(bs[2 * e] * g0, bs[2 * e + 1] * g1);
        kgp[e] = pack2(ks_[2 * e] * g0, ks_[2 * e + 1] * g1);
      }
    }
    f32x4 a1[4], a2[4];
#pragma unroll
    for (int n = 0; n < 4; ++n) { a1[n] = f32x4{0.f, 0.f, 0.f, 0.f}; a2[n] = f32x4{0.f, 0.f, 0.f, 0.f}; }
    mm_strip<64, 4>(buf[3], 72, 16 * wid, buf[2], 72, 0, a1, lane);
    mm_strip<64, 4>(buf[3], 72, 16 * wid, buf[1], 72, 0, a2, lane);
    __syncthreads();
#pragma unroll
    for (int nt = 0; nt < 4; ++nt)
#pragma unroll
      for (int j = 0; j < 4; ++j) {
        int t = 16 * wid + 4 * fq + j, s = 16 * nt + fr;
        buf[5][t * 72 + s] = f2bf(s <= t ? a1[nt][j] : 0.f);
        buf[6][t * 72 + s] = f2bf(s <= t ? a2[nt][j] : 0.f);
      }
#pragma unroll
    for (int e = 0; e < 8; ++e) {
      buf[1][(cj + 2 * e) * 72 + i] = (u16)(bgp[e] & 0xffffu);
      buf[1][(cj + 2 * e + 1) * 72 + i] = (u16)(bgp[e] >> 16);
      buf[2][(cj + 2 * e) * 72 + i] = (u16)(kgp[e] & 0xffffu);
      buf[2][(cj + 2 * e + 1) * 72 + i] = (u16)(kgp[e] >> 16);
    }
  }
  __syncthreads();
  {
    u16* outp = p.prep + ((long)((b * 12 + h) * 2 + DIR) * NCH + c) * RW_ITEM;
    const int pq = wid & 1, ntp = (wid >> 1) * 2;
#pragma unroll
    for (int nn = 0; nn < 2; ++nn) {
      const int nt = ntp + nn;
      f32x4 m0 = f32x4{0.f, 0.f, 0.f, 0.f}, m1 = m0, q0 = m0, q1 = m0;
      mm_strip<64, 1>(buf[0], 72, 16 * (2 * pq), buf[1], 72, 16 * nt, &m0, lane);
      mm_strip<64, 1>(buf[0], 72, 16 * (2 * pq + 1), buf[1], 72, 16 * nt, &m1, lane);
      mm_strip<64, 1>(buf[0], 72, 16 * (2 * pq), buf[6], 72, 16 * nt, &q0, lane);
      mm_strip<64, 1>(buf[0], 72, 16 * (2 * pq + 1), buf[6], 72, 16 * nt, &q1, lane);
      float o[8], oq[8];
#pragma unroll
      for (int j = 0; j < 4; ++j) {
        int k0 = 16 * (2 * pq) + 4 * fq + j, k1 = k0 + 16, kp = 16 * nt + fr;
        o[j] = m0[j] + (k0 == kp ? gC[kp] : 0.f);
        o[4 + j] = m1[j] + (k1 == kp ? gC[kp] : 0.f);
        oq[j] = q0[j] + bf2f(buf[3][kp * 72 + k0]);
        oq[4 + j] = q1[j] + bf2f(buf[3][kp * 72 + k1]);
      }
      st8(outp + ((nt * 2 + pq) * 64 + lane) * 8, o);
      st8(outp + (((4 + nt) * 2 + pq) * 64 + lane) * 8, oq);
    }
    f32x4 an[4], ay[4];
#pragma unroll
    for (int n = 0; n < 4; ++n) { an[n] = f32x4{0.f, 0.f, 0.f, 0.f}; ay[n] = f32x4{0.f, 0.f, 0.f, 0.f}; }
    mm_strip<64, 4>(buf[2], 72, 16 * wid, buf[4], 72, 0, an, lane);
    mm_strip<64, 4>(buf[1], 72, 16 * wid, buf[7], 72, 0, an, lane);
    mm_strip<64, 4>(buf[5], 72, 16 * wid, buf[4], 72, 0, ay, lane);
    mm_strip<64, 4>(buf[6], 72, 16 * wid, buf[7], 72, 0, ay, lane);
#pragma unroll
    for (int nt = 0; nt < 4; ++nt) {
      uint2 o1, o2;
      o1.x = pack2(an[nt][0], an[nt][1]); o1.y = pack2(an[nt][2], an[nt][3]);
      o2.x = pack2(ay[nt][0], ay[nt][1]); o2.y = pack2(ay[nt][2], ay[nt][3]);
      *reinterpret_cast<uint2*>(outp + 8192 + ((wid * 4 + nt) * 64 + lane) * 4) = o1;
      *reinterpret_cast<uint2*>(outp + 8192 + (((4 + wid) * 4 + nt) * 64 + lane) * 4) = o2;
    }
  }
  __syncthreads();
  }
#undef RWKV_ISSUE
#undef RWKV_ZB
}

__device__ __forceinline__ void pool_item(const Params& p, int b, int rb, int g) {
  float* vs = (float*)smem;
  u16* As = (u16*)(smem + 16640);
  u16* Bs = (u16*)(smem + 16640 + MB);
  const int tid = opaque_tid(), lane = tid & 63, wid = tid >> 6, fr = lane & 15, fq = lane >> 4;
  const int w = 2 << g, hw = w >> 1;
  const u16* z = p.zbuf;
  const bool isctx = rb >= 256;
  {
    int n = tid >> 2, part = (tid & 3) * 16;
    const u16* s = p.PoolT + ((long)g * 64 + n) * 64 + part;
    *reinterpret_cast<uint4*>(Bs + n * 72 + part) = *reinterpret_cast<const uint4*>(s);
    *reinterpret_cast<uint4*>(Bs + n * 72 + part + 8) = *reinterpret_cast<const uint4*>(s + 8);
  }
  const int cg = (tid & 7) * 8, cl = tid >> 3;
  if (!isctx) {
    const int r_lo = max(rb - hw, 0), r_hi = min(rb + hw, 256);
#pragma unroll
    for (int k = 0; k < 2; ++k) {
      const int col = cl + 32 * k;
      float a8[8];
#pragma unroll
      for (int e = 0; e < 8; ++e) a8[e] = 0.f;
      for (int rr = r_lo; rr < r_hi; ++rr) {
        float v8[8];
        ld8(z + ((long)b * PB + CTXL + rr * 64 + col) * AB_IN + g * 64 + cg, v8);
#pragma unroll
        for (int e = 0; e < 8; ++e) a8[e] += v8[e];
      }
#pragma unroll
      for (int e = 0; e < 8; ++e) vs[col * 65 + cg + e] = a8[e];
    }
    __syncthreads();
#pragma unroll
    for (int k = 0; k < 2; ++k) {
      const int col = cl + 32 * k;
      const int c_lo = max(col - hw, 0), c_hi = min(col + hw, 64);
      float a8[8], pg[8], o8[8];
#pragma unroll
      for (int e = 0; e < 8; ++e) a8[e] = 0.f;
      for (int cc = c_lo; cc < c_hi; ++cc) {
#pragma unroll
        for (int e = 0; e < 8; ++e) a8[e] += vs[cc * 65 + cg + e];
      }
      const float rc = __builtin_amdgcn_rcpf((float)((r_hi - r_lo) * (c_hi - c_lo)));
      ld8(z + ((long)b * PB + CTXL + rb * 64 + col) * AB_IN + g * 64 + cg, pg);
#pragma unroll
      for (int e = 0; e < 8; ++e) o8[e] = a8[e] * rc - pg[e];
      st8(As + col * 72 + cg, o8);
    }
  } else {
    const int t0 = (rb - 256) * 64;
#pragma unroll
    for (int k = 0; k < 2; ++k) {
      const int col = cl + 32 * k, t = t0 + col;
      const int lo = max(t - hw, 0), hi = min(t + hw, CTXL);
      float a8[8], pg[8], o8[8];
#pragma unroll
      for (int e = 0; e < 8; ++e) a8[e] = 0.f;
      for (int tt = lo; tt < hi; ++tt) {
        float v8[8];
        ld8(z + ((long)b * PB + tt) * AB_IN + g * 64 + cg, v8);
#pragma unroll
        for (int e = 0; e < 8; ++e) a8[e] += v8[e];
      }
      const float rc = __builtin_amdgcn_rcpf((float)(hi - lo));
      ld8(z + ((long)b * PB + t) * AB_IN + g * 64 + cg, pg);
#pragma unroll
      for (int e = 0; e < 8; ++e) o8[e] = a8[e] * rc - pg[e];
      st8(As + col * 72 + cg, o8);
    }
  }
  __syncthreads();
  {
    f32x4 acc[4];
#pragma unroll
    for (int n = 0; n < 4; ++n) acc[n] = f32x4{0.f, 0.f, 0.f, 0.f};
    mm_strip<64, 4>(As, 72, 16 * wid, Bs, 72, 0, acc, lane);
    long row0 = isctx ? (long)b * PB + (rb - 256) * 64 : (long)b * PB + CTXL + rb * 64;
#pragma unroll
    for (int nt = 0; nt < 4; ++nt)
#pragma unroll
      for (int j = 0; j < 4; ++j) {
        int t = 16 * wid + 4 * fq + j, n = 16 * nt + fr;
        p.abuf[(row0 + t) * D + g * 64 + n] = f2bf(acc[nt][j] * p.pool_scale[g * 64 + n]);
      }
  }
  __syncthreads();
}

__device__ __forceinline__ void rwkv_scan_block(const Params& p, int sid, int s_begin, int s_end) {
  const int tid = opaque_tid(), lane = tid & 63, fr = lane & 15, fq = lane >> 4;
  const int wv = __builtin_amdgcn_readfirstlane(tid >> 6);
  const int d = sid & 1, bh = sid >> 1, b = bh / 12, h = bh % 12;
  const char* base = (const char*)(p.prep + (long)sid * NCH * RW_ITEM);
  char* L = (char*)smem;
  const unsigned lo16 = lane * 16u, lo8 = lane * 8u;
  f32x4* stsave = (f32x4*)(smem_raw + 98304) + tid * 4;
  f32x4 st[4];
#pragma unroll
  for (int i = 0; i < 4; ++i) st[i] = s_begin > 0 ? stsave[i] : f32x4{0.f, 0.f, 0.f, 0.f};
  auto chunk_of = [&](int step) { step = min(step, NCH - 1); return d == 0 ? step : (step < 4 ? 3 - step : 263 - step); };
  bf16x8 Ar[5][4];
  uint2 Cr[5][8];
#pragma unroll
  for (int u = 0; u < 4; ++u) {
    const char* it = base + (long)chunk_of(s_begin + u) * (RW_ITEM * 2);
    const char* pa = it + (wv * 4) * 1024;
    const char* pc = it + 16384 + wv * 512;
#pragma unroll
    for (int i = 0; i < 4; ++i) Ar[u][i] = *reinterpret_cast<const bf16x8*>(pa + i * 1024 + lo16);
#pragma unroll
    for (int rt = 0; rt < 8; ++rt) Cr[u][rt] = *reinterpret_cast<const uint2*>(pc + rt * 2048 + lo8);
  }
  __syncthreads();
#pragma unroll 1
  for (int s0 = s_begin; s0 < s_end; s0 += 5) {
#pragma unroll
    for (int u = 0; u < 5; ++u) {
      const int step = s0 + u;
      {
        const char* it = base + (long)chunk_of(step + 4) * (RW_ITEM * 2);
        const char* pa = it + (wv * 4) * 1024;
        const char* pc = it + 16384 + wv * 512;
#pragma unroll
        for (int i = 0; i < 4; ++i) Ar[(u + 4) % 5][i] = *reinterpret_cast<const bf16x8*>(pa + i * 1024 + lo16);
#pragma unroll
        for (int rt = 0; rt < 8; ++rt) Cr[(u + 4) % 5][rt] = *reinterpret_cast<const uint2*>(pc + rt * 2048 + lo8);
      }
      char* Lb = L + (step & 1) * 16384;
#pragma unroll
      for (int i = 0; i < 4; ++i) *reinterpret_cast<bf16x8*>(Lb + (wv * 4 + i) * 1024 + lo16) = Ar[u][i];
      asm volatile("s_waitcnt lgkmcnt(0)" ::: "memory");
      __builtin_amdgcn_s_barrier();
      asm volatile("" ::: "memory");
      bf16x8 bfr[2];
#pragma unroll
      for (int ks = 0; ks < 2; ++ks) {
        union { bf16x8 v; unsigned w[4]; } cv;
        cv.w[0] = pack2(st[2 * ks][0], st[2 * ks][1]); cv.w[1] = pack2(st[2 * ks][2], st[2 * ks][3]);
        cv.w[2] = pack2(st[2 * ks + 1][0], st[2 * ks + 1][1]); cv.w[3] = pack2(st[2 * ks + 1][2], st[2 * ks + 1][3]);
        bfr[ks] = cv.v;
      }
      const int c = chunk_of(step);
      u16* Yb = (u16*)(smem_raw + 32768) + (step & 1) * 4608;
#pragma unroll
      for (int rt = 0; rt < 8; ++rt) {
        f32x4 acc;
        acc[0] = __uint_as_float(Cr[u][rt].x << 16); acc[1] = __uint_as_float(Cr[u][rt].x & 0xffff0000u);
        acc[2] = __uint_as_float(Cr[u][rt].y << 16); acc[3] = __uint_as_float(Cr[u][rt].y & 0xffff0000u);
        bf16x8 a0 = *reinterpret_cast<const bf16x8*>(Lb + (rt * 2 + 0) * 1024 + lo16);
        bf16x8 a1 = *reinterpret_cast<const bf16x8*>(Lb + (rt * 2 + 1) * 1024 + lo16);
        acc = MFMA16(a0, bfr[0], acc);
        acc = MFMA16(a1, bfr[1], acc);
        if (rt < 4) st[rt] = acc;
        else {
#pragma unroll
          for (int j = 0; j < 4; ++j) {
            int t = 16 * (rt - 4) + 4 * fq + j;
            Yb[t * 72 + wv * 16 + fr] = f2bf(acc[j]);
          }
        }
      }
      __builtin_amdgcn_sched_barrier(0);
    }
  }
  if (s_end < NCH) {
#pragma unroll
    for (int i = 0; i < 4; ++i) stsave[i] = st[i];
  }
  __syncthreads();
}

__device__ __forceinline__ void rwkv_scan_copy(const Params& p, int sid, int s_begin, int s_end) {
  const int tid = opaque_tid();
  const int d = sid & 1, bh = sid >> 1, b = bh / 12, h = bh % 12;
  u16* ybuf = d ? p.yb : p.yf;
  const int t = tid >> 2, seg = tid & 3;
  const int tau = d ? 63 - t : t;
  auto chunk_of = [&](int step) { return d == 0 ? step : (step < 4 ? 3 - step : 263 - step); };
  auto copy = [&](int step) {
    const u16* Yb = (const u16*)(smem_raw + 32768) + (step & 1) * 4608 + t * 72 + seg * 16;
    const uint4 v0 = *reinterpret_cast<const uint4*>(Yb), v1 = *reinterpret_cast<const uint4*>(Yb + 8);
    u16* dst = ybuf + ((long)b * PB + chunk_of(step) * 64 + tau) * D + h * 64 + seg * 16;
    *reinterpret_cast<uint4*>(dst) = v0; *reinterpret_cast<uint4*>(dst + 8) = v1;
  };
  __syncthreads();
#pragma unroll 1
  for (int s_ = s_begin; s_ < s_end; ++s_) {
    __builtin_amdgcn_s_barrier();
    asm volatile("" ::: "memory");
    if (s_ > s_begin) copy(s_ - 1);
  }
  __syncthreads();
  copy(s_end - 1);
}

__device__ __forceinline__ void rwkv_out_item(const Params& p, int b, int c, int h) {
  u16* Ag = (u16*)smem;
  u16* Bg = (u16*)(smem + 17408);
  float* G = (float*)(smem + 2 * 17408);
  const int tid = opaque_tid(), lane = tid & 63, wid = tid >> 6, fr = lane & 15, fq = lane >> 4;
  const u16* z = p.zbuf;
  const float* mu = p.ab_mu;
  const char* zrow = (const char*)(z + ((long)b * PB + c * 64) * AB_IN);
  const int cgA = (tid & 15) * 8, cgB = (tid & 7) * 8, rpB = tid >> 3, chB = 64 * h + cgB;
  u32x4 rg[2][4], rr_[4], rk_[4], rv_[4], ryf[2], ryb[2];
#pragma unroll
  for (int q = 0; q < 2; ++q) {
    const int rp = (tid >> 4) + 16 * q;
    load_raw4(zrow + 2560 * 2, (unsigned)(2 * rp * AB_IN + cgA) * 2u, c, 2 * rp, rg[q]);
  }
  {
    const unsigned zo = (unsigned)(2 * rpB * AB_IN + cgB) * 2u;
    load_raw4(zrow + (256 + 64 * h) * 2, zo, c, 2 * rpB, rr_);
    load_raw4(zrow + (1024 + 64 * h) * 2, zo, c, 2 * rpB, rk_);
    load_raw4(zrow + (1792 + 64 * h) * 2, zo, c, 2 * rpB, rv_);
#pragma unroll
    for (int r = 0; r < 2; ++r) {
      const long row = (long)b * PB + c * 64 + 2 * rpB + r;
      ryf[r] = *reinterpret_cast<const u32x4*>(p.yf + row * D + chB);
      ryb[r] = *reinterpret_cast<const u32x4*>(p.yb + row * D + chB);
    }
  }
  float rkw[8], gw8[8], gb8[8];
  {
    const float4 a0 = *reinterpret_cast<const float4*>(p.rwkv_r_k + chB), a1 = *reinterpret_cast<const float4*>(p.rwkv_r_k + chB + 4);
    const float4 w0 = *reinterpret_cast<const float4*>(p.rwkv_gn_w + chB), w1 = *reinterpret_cast<const float4*>(p.rwkv_gn_w + chB + 4);
    const float4 b0 = *reinterpret_cast<const float4*>(p.rwkv_gn_b + chB), b1 = *reinterpret_cast<const float4*>(p.rwkv_gn_b + chB + 4);
    rkw[0] = a0.x; rkw[1] = a0.y; rkw[2] = a0.z; rkw[3] = a0.w; rkw[4] = a1.x; rkw[5] = a1.y; rkw[6] = a1.z; rkw[7] = a1.w;
    gw8[0] = w0.x; gw8[1] = w0.y; gw8[2] = w0.z; gw8[3] = w0.w; gw8[4] = w1.x; gw8[5] = w1.y; gw8[6] = w1.z; gw8[7] = w1.w;
    gb8[0] = b0.x; gb8[1] = b0.y; gb8[2] = b0.z; gb8[3] = b0.w; gb8[4] = b1.x; gb8[5] = b1.y; gb8[6] = b1.z; gb8[7] = b1.w;
  }
  {
    const int cg = cgA;
#pragma unroll
    for (int q = 0; q < 2; ++q) {
      const int rp = (tid >> 4) + 16 * q;
      float gd[2][8];
      mix_raw_2x8<0>(rg[q], 2560 + cg, mu, gd);
#pragma unroll
      for (int r = 0; r < 2; ++r) {
#pragma unroll
        for (int e = 0; e < 8; ++e) gd[r][e] = sigmoidf_(gd[r][e]);
        st8(Ag + (2 * rp + r) * 136 + cg, gd[r]);
      }
    }
    const int i = tid >> 2, sub = tid & 3;
    const u16* s = p.GupT + ((long)(64 * h + i)) * 128 + sub * 32;
#pragma unroll
    for (int e = 0; e < 32; e += 8) *reinterpret_cast<uint4*>(Bg + i * 136 + sub * 32 + e) = *reinterpret_cast<const uint4*>(s + e);
  }
  __syncthreads();
  {
    f32x4 acc[4];
#pragma unroll
    for (int n = 0; n < 4; ++n) acc[n] = f32x4{0.f, 0.f, 0.f, 0.f};
    mm_strip<128, 4>(Ag, 136, 16 * wid, Bg, 136, 0, acc, lane);
#pragma unroll
    for (int nt = 0; nt < 4; ++nt)
#pragma unroll
      for (int j = 0; j < 4; ++j) G[(16 * wid + 4 * fq + j) * 65 + 16 * nt + fr] = acc[nt][j];
  }
  __syncthreads();
  {
    const int cg = cgB, rp = rpB;
    const int ch = chB;
    float r8[2][8], k8[2][8], v8[2][8];
    mix_raw_2x8<0>(rr_, 256 + ch, mu, r8);
    mix_raw_2x8<0>(rk_, 1024 + ch, mu, k8);
    mix_raw_2x8<0>(rv_, 1792 + ch, mu, v8);
#pragma unroll
    for (int r = 0; r < 2; ++r) {
      const int ii = 2 * rp + r;
      const long row = (long)b * PB + c * 64 + ii;
      float yf[8], yb[8];
#pragma unroll
      for (int q = 0; q < 4; ++q) {
        yf[2 * q] = __uint_as_float(ryf[r][q] << 16); yf[2 * q + 1] = __uint_as_float(ryf[r][q] & 0xffff0000u);
        yb[2 * q] = __uint_as_float(ryb[r][q] << 16); yb[2 * q + 1] = __uint_as_float(ryb[r][q] & 0xffff0000u);
      }
      float s1 = 0.f, s2 = 0.f, bs = 0.f;
#pragma unroll
      for (int e = 0; e < 8; ++e) { yf[e] += yb[e]; s1 += yf[e]; s2 += yf[e] * yf[e]; bs += r8[r][e] * k8[r][e] * rkw[e]; }
      s1 += __shfl_xor(s1, 1); s1 += __shfl_xor(s1, 2); s1 += __shfl_xor(s1, 4);
      s2 += __shfl_xor(s2, 1); s2 += __shfl_xor(s2, 2); s2 += __shfl_xor(s2, 4);
      bs += __shfl_xor(bs, 1); bs += __shfl_xor(bs, 2); bs += __shfl_xor(bs, 4);
      const float mean = s1 * (1.f / 64.f);
      const float var = fmaxf(s2 * (1.f / 64.f) - mean * mean, 0.f);
      const float rstd = rsqrtf(var + 64e-5f);
      float o[8];
#pragma unroll
      for (int e = 0; e < 8; ++e) {
        const float yn = (yf[e] - mean) * rstd;
        o[e] = (yn * gw8[e] + gb8[e] + bs * v8[r][e]) * G[ii * 65 + cg + e];
      }
      st8(p.abuf + row * D + 256 + ch, o);
    }
  }
  __syncthreads();
}
#ifndef GDN_LATE
#define GDN_LATE 100
#endif
constexpr int GDN_S0_ = NCH - GDN_LATE, GDN_N0_ = GDN_S0_ * NB * 8 * 2, GDN_N_ = NCH * NB * 8 * 2;
template <int DIR, bool LATEPART>
__device__ __forceinline__ void gdn_prep_all(const Params& p) {
  const int it_first = LATEPART ? GDN_N0_ + VBID - 128 : VBID, it_end = LATEPART ? GDN_N_ : GDN_N0_, it_stride = LATEPART ? NVB - 128 : NVB;
  u32x4 rawq[7];
#define GDN_ISSUEQ(IT, TID) do { int r_ = (IT) >> 1; const int h_ = r_ % 8; r_ /= 8; const int b_ = r_ % NB, o_ = r_ / NB; \
    const int c_ = DIR ? (o_ < 4 ? 3 - o_ : 263 - o_) : o_; \
    const int rg_ = (TID) >> 4, tmin_ = DIR ? 60 - 4 * rg_ : 4 * rg_, pp0_ = c_ * 64 + tmin_; \
    const int lo_ = (c_ < 4) ? 0 : CTXL, hi_ = (c_ < 4) ? CTXL : PB; \
    const unsigned zoff_ = (unsigned)(tmin_ * GDN_IN + ((TID) & 15) * 8) * 2u; \
    const char* ub_ = (const char*)(p.zbuf + ((long)b_ * PB + c_ * 64) * GDN_IN + 128 * h_); \
    _Pragma("unroll") for (int j = 0; j < 7; ++j) { const int pt_ = pp0_ - 2 + j; \
      if (pt_ >= lo_ && pt_ < hi_) rawq[j] = *reinterpret_cast<const u32x4*>(ub_ + (long)(j - 2) * (GDN_IN * 2) + zoff_); \
      else rawq[j] = u32x4{0u, 0u, 0u, 0u}; } } while (0)
  { const int tid0 = opaque_tid(); GDN_ISSUEQ(min(it_first, it_end - 2), tid0); }
#pragma unroll 1
  for (int it = it_first; it < it_end; it += it_stride) {
  int b, c, h;
  { int r_ = it >> 1; h = r_ % 8; r_ /= 8; b = r_ % NB; const int o_ = r_ / NB; c = DIR ? (o_ < 4 ? 3 - o_ : 263 - o_) : o_; }
  u16* R1 = (u16*)smem;
  u16* R2 = (u16*)(smem + 18432);
  u16* Ls = (u16*)(smem + 36864);
  u16* As = (u16*)(smem + 46080);
  u16* Ut = (u16*)(smem + 55296);
  float* gc = (float*)(smem + 73728);
  float* bb = gc + 64;
  float* fac = gc + 128;
  const int tid = opaque_tid(), lane = tid & 63, wid = tid >> 6, fr = lane & 15, fq = lane >> 4;
  const int i = tid >> 2, sub = tid & 3;
  const int seg_lo = (c < 4) ? 0 : CTXL, seg_hi = (c < 4) ? CTXL : PB;
  const u16* z = p.zbuf;
  const float* cw = p.gdn_conv;
  {
    const int cg = (tid & 15) * 8, rg = tid >> 4;
    const int tmin = DIR ? 60 - 4 * rg : 4 * rg;
    const int pp0 = c * 64 + tmin;
    const unsigned zoff = (unsigned)(tmin * GDN_IN + cg) * 2u, woff = (unsigned)cg * 4u, soff = (unsigned)(tmin * GDN_IN) * 2u;
    const char* zrow = (const char*)(z + ((long)b * PB + c * 64) * GDN_IN);
    u32x4 raw[3][7];
#pragma unroll
    for (int j = 0; j < 7; ++j) raw[0][j] = rawq[j];
#pragma unroll
    for (int which = 1; which < 3; ++which) {
      const char* ub = zrow + (which * 1024 + 128 * h) * 2;
#pragma unroll
      for (int j = 0; j < 7; ++j) {
        const int pt = pp0 - 2 + j;
        if (pt >= seg_lo && pt < seg_hi) raw[which][j] = *reinterpret_cast<const u32x4*>(ub + (long)(j - 2) * (GDN_IN * 2) + zoff);
        else raw[which][j] = u32x4{0u, 0u, 0u, 0u};
      }
    }
    u16 braw[4], zraw[4];
#pragma unroll
    for (int r = 0; r < 4; ++r) {
      const int to = DIR ? 3 - r : r;
      braw[r] = *reinterpret_cast<const u16*>(zrow + (long)to * (GDN_IN * 2) + (4096 + DIR * 8 + h) * 2 + soff);
      zraw[r] = *reinterpret_cast<const u16*>(zrow + (long)to * (GDN_IN * 2) + (4096 + (2 + DIR) * 8 + h) * 2 + soff);
    }
    f32x4 wv[3][8];
#define GDN_LDW(W) do { const char* wb_ = (const char*)(cw + (W) * 1024 + 128 * h); _Pragma("unroll") for (int tap = 0; tap < 4; ++tap) { \
      wv[W][2 * tap] = *reinterpret_cast<const f32x4*>(wb_ + tap * 12288 + woff); \
      wv[W][2 * tap + 1] = *reinterpret_cast<const f32x4*>(wb_ + tap * 12288 + 16 + woff); } } while (0)
    GDN_LDW(0); GDN_LDW(1);
    __builtin_amdgcn_sched_barrier(0);
    float beta4[4];
#pragma unroll
    for (int r = 0; r < 4; ++r) beta4[r] = sigmoidf_(bf2f(braw[r]));
#pragma unroll
    for (int which = 0; which < 3; ++which) {
      float zr[7][8];
#pragma unroll
      for (int j = 0; j < 7; ++j) {
#pragma unroll
        for (int q = 0; q < 4; ++q) { zr[j][2 * q] = __uint_as_float(raw[which][j][q] << 16); zr[j][2 * q + 1] = __uint_as_float(raw[which][j][q] & 0xffff0000u); }
      }
#pragma unroll
      for (int r = 0; r < 4; ++r) {
        const int to = DIR ? 3 - r : r;
        const int i = 4 * rg + r;
        float o[8], ss = 0.f;
#pragma unroll
        for (int e = 0; e < 8; ++e) {
          float a = zr[to][e] * wv[which][0 + (e >> 2)][e & 3] + zr[to + 1][e] * wv[which][2 + (e >> 2)][e & 3] +
                    zr[to + 2][e] * wv[which][4 + (e >> 2)][e & 3] + zr[to + 3][e] * wv[which][6 + (e >> 2)][e & 3];
          o[e] = siluf_(a); ss += o[e] * o[e];
        }
        if (which < 2) {
          ss += __shfl_xor(ss, 1); ss += __shfl_xor(ss, 2); ss += __shfl_xor(ss, 4); ss += __shfl_xor(ss, 8);
          const float sc = rsqrtf(ss + 1e-6f) * (which == 0 ? 0.08838834764831845f : 1.0f);
#pragma unroll
          for (int e = 0; e < 8; ++e) o[e] *= sc;
          st8((which == 0 ? R2 : R1) + i * 136 + cg, o);
        } else {
#pragma unroll
          for (int e = 0; e < 8; ++e) Ut[(cg + e) * 72 + 63 - i] = f2bf(o[e] * beta4[r]);
        }
      }
      __builtin_amdgcn_sched_barrier(0);
      if (which == 0) { GDN_LDW(2); }
    }
#undef GDN_LDW
    if ((tid & 15) == 0) {
#pragma unroll
      for (int r = 0; r < 4; ++r) {
        const int i = 4 * rg + r;
        float za = bf2f(zraw[r]);
        bb[i] = beta4[r];
        gc[i] = -__expf(p.gdn_a_log[DIR * 8 + h]) * softplusf_(za + p.gdn_dt_bias[DIR * 8 + h]);
      }
    }
  }
  __syncthreads();
  if (wid == 0) {
    float v = gc[lane];
#pragma unroll
    for (int o = 1; o < 64; o <<= 1) { float u = __shfl_up(v, o); if (lane >= o) v += u; }
    gc[lane] = v;
    fac[lane] = bb[lane] * __expf(v);
  }
  __syncthreads();
  u16* const outp = p.prep + ((long)((b * 8 + h) * 2 + DIR) * NCH + c) * GD_ITEM;
  {
    f32x4 a1[4], a2[4];
#pragma unroll
    for (int n = 0; n < 4; ++n) { a1[n] = f32x4{0.f, 0.f, 0.f, 0.f}; a2[n] = f32x4{0.f, 0.f, 0.f, 0.f}; }
    mm_strip<128, 4>(R1, 136, 16 * wid, R1, 136, 0, a1, lane);
    mm_strip<128, 4>(R2, 136, 16 * wid, R1, 136, 0, a2, lane);
#pragma unroll
    for (int nt = 0; nt < 4; ++nt) {
      const int s = 16 * nt + fr, t0 = 16 * wid + 4 * fq;
      float lv[4];
#pragma unroll
      for (int j = 0; j < 4; ++j) {
        const int t = t0 + j;
        float dec = s <= t ? __expf(gc[t] - gc[s]) : 0.f;
        lv[j] = s < t ? bb[t] * a1[nt][j] * dec : 0.f;
        As[t * 72 + s] = f2bf(a2[nt][j] * dec);
      }
      uint2 o; o.x = pack2(lv[3], lv[2]); o.y = pack2(lv[1], lv[0]);
      *reinterpret_cast<uint2*>(Ls + (63 - s) * 72 + 60 - t0) = o;
    }
#pragma unroll
    for (int nt = 0; nt < 4; ++nt) {
      int t = 16 * nt + fr;
      float eg = __expf(gc[t]);
      float o[8];
#pragma unroll
      for (int s2 = 0; s2 < 2; ++s2)
#pragma unroll
        for (int j = 0; j < 4; ++j) o[s2 * 4 + j] = bf2f(R2[t * 136 + 16 * (2 * wid + s2) + 4 * fq + j]) * eg;
      st8(outp + (((8 + nt) * 4 + wid) * 64 + lane) * 8, o);
    }
  }
  {
    bf16x8 bw[2][2], bu[2][2];
#pragma unroll
    for (int ks = 0; ks < 2; ++ks) {
      float f8[8];
#pragma unroll
      for (int j = 0; j < 8; ++j) f8[j] = fac[63 - (32 * ks + 8 * fq + j)];
#pragma unroll
      for (int ct = 0; ct < 2; ++ct) {
        const int ch = 16 * (2 * wid + ct) + fr;
        union { bf16x8 v; unsigned w[4]; } cv;
#pragma unroll
        for (int j2 = 0; j2 < 4; ++j2) {
          const int s0 = 63 - (32 * ks + 8 * fq + 2 * j2);
          cv.w[j2] = pack2(bf2f(R1[s0 * 136 + ch]) * f8[2 * j2], bf2f(R1[(s0 - 1) * 136 + ch]) * f8[2 * j2 + 1]);
        }
        bw[ct][ks] = cv.v;
        bu[ct][ks] = *reinterpret_cast<const bf16x8*>(Ut + ch * 72 + 32 * ks + 8 * fq);
      }
    }
    unsigned kreg[16];
    {
      const float eg = __expf(gc[63] - gc[i]);
#pragma unroll
      for (int e = 0; e < 16; ++e)
        kreg[e] = pack2(bf2f(R1[i * 136 + 32 * sub + 2 * e]) * eg, bf2f(R1[i * 136 + 32 * sub + 2 * e + 1]) * eg);
    }
    __syncthreads();
    if (wid == (half_id() ? 2 : 0)) {
      float xr[64];
      fwd_solve64<true>(xr, Ls, Ls + lane * 72, lane);
    }
    __syncthreads();
    {
      bf16x8 ta[4][2];
#pragma unroll
      for (int tt = 0; tt < 4; ++tt)
#pragma unroll
        for (int ks = 0; ks < 2; ++ks) ta[tt][ks] = *reinterpret_cast<const bf16x8*>(Ls + (16 * tt + fr) * 72 + 32 * ks + 8 * fq);
#pragma unroll
      for (int ct = 0; ct < 2; ++ct) {
        const int ch = 16 * (2 * wid + ct) + fr;
#pragma unroll
        for (int tt = 0; tt < 4; ++tt) {
          f32x4 aw = f32x4{0.f, 0.f, 0.f, 0.f}, au = aw;
          aw = MFMA16(ta[tt][0], bw[ct][0], aw); aw = MFMA16(ta[tt][1], bw[ct][1], aw);
          au = MFMA16(ta[tt][0], bu[ct][0], au); au = MFMA16(ta[tt][1], bu[ct][1], au);
          uint2 ow, ou;
          ow.x = pack2(aw[3], aw[2]); ow.y = pack2(aw[1], aw[0]);
          ou.x = pack2(au[3], au[2]); ou.y = pack2(au[1], au[0]);
          *reinterpret_cast<uint2*>(R2 + ch * 72 + 60 - 16 * tt - 4 * fq) = ow;
          *reinterpret_cast<uint2*>(Ut + ch * 72 + 60 - 16 * tt - 4 * fq) = ou;
        }
      }
    }
#pragma unroll
    for (int e = 0; e < 16; ++e) {
      R1[(32 * sub + 2 * e) * 72 + i] = (u16)(kreg[e] & 0xffffu);
      R1[(32 * sub + 2 * e + 1) * 72 + i] = (u16)(kreg[e] >> 16);
    }
  }
  __syncthreads();
  { const int tidn = opaque_tid(); GDN_ISSUEQ((it + it_stride < it_end ? it + it_stride : it), tidn); }
  {
    const float glast = __expf(gc[63]);
    u32x4 qdr[4];
#pragma unroll
    for (int nt = 0; nt < 4; ++nt) qdr[nt] = *reinterpret_cast<const u32x4*>(outp + (((8 + nt) * 4 + wid) * 64 + lane) * 8);
    {
      f32x4 m0[8], m1[8];
#pragma unroll
      for (int n = 0; n < 8; ++n) { m0[n] = f32x4{0.f, 0.f, 0.f, 0.f}; m1[n] = f32x4{0.f, 0.f, 0.f, 0.f}; }
      mm_strip<64, 8>(R2, 72, 16 * (2 * wid), R1, 72, 0, m0, lane);
      mm_strip<64, 8>(R2, 72, 16 * (2 * wid + 1), R1, 72, 0, m1, lane);
#pragma unroll
      for (int nt = 0; nt < 8; ++nt) {
        float o[8];
#pragma unroll
        for (int j = 0; j < 4; ++j) {
          int k0 = 16 * (2 * wid) + 4 * fq + j, k1 = k0 + 16, kp = 16 * nt + fr;
          o[j] = m0[nt][j] + (k0 == kp ? glast : 0.f);
          o[4 + j] = m1[nt][j] + (k1 == kp ? glast : 0.f);
        }
        st8(outp + ((nt * 4 + wid) * 64 + lane) * 8, o);
      }
    }
    {
      f32x4 q0[4], q1[4];
#pragma unroll
      for (int n = 0; n < 4; ++n) { q0[n] = f32x4{0.f, 0.f, 0.f, 0.f}; q1[n] = f32x4{0.f, 0.f, 0.f, 0.f}; }
      mm_strip<64, 4>(R2, 72, 16 * (2 * wid), As, 72, 0, q0, lane);
      mm_strip<64, 4>(R2, 72, 16 * (2 * wid + 1), As, 72, 0, q1, lane);
#pragma unroll
      for (int nt = 0; nt < 4; ++nt) {
        float o[8];
#pragma unroll
        for (int q = 0; q < 4; ++q) { o[2 * q] = __uint_as_float(qdr[nt][q] << 16); o[2 * q + 1] = __uint_as_float(qdr[nt][q] & 0xffff0000u); }
#pragma unroll
        for (int j = 0; j < 4; ++j) { o[j] += q0[nt][j]; o[4 + j] += q1[nt][j]; }
        st8(outp + (((8 + nt) * 4 + wid) * 64 + lane) * 8, o);
      }
    }
    u16* cp = outp + 24576;
#pragma unroll
    for (int s2 = 0; s2 < 2; ++s2) {
      f32x4 an[8];
#pragma unroll
      for (int n = 0; n < 8; ++n) an[n] = f32x4{0.f, 0.f, 0.f, 0.f};
      mm_strip<64, 8>(R1, 72, 16 * (2 * wid + s2), Ut, 72, 0, an, lane);
#pragma unroll
      for (int nt = 0; nt < 8; ++nt) {
        uint2 o; o.x = pack2(-an[nt][0], -an[nt][1]); o.y = pack2(-an[nt][2], -an[nt][3]);
        *reinterpret_cast<uint2*>(cp + (((2 * wid + s2) * 8 + nt) * 64 + lane) * 4) = o;
      }
    }
    {
      f32x4 ao[8];
#pragma unroll
      for (int n = 0; n < 8; ++n) ao[n] = f32x4{0.f, 0.f, 0.f, 0.f};
      mm_strip<64, 8>(As, 72, 16 * wid, Ut, 72, 0, ao, lane);
#pragma unroll
      for (int nt = 0; nt < 8; ++nt) {
        uint2 o; o.x = pack2(-ao[nt][0], -ao[nt][1]); o.y = pack2(-ao[nt][2], -ao[nt][3]);
        *reinterpret_cast<uint2*>(cp + (((8 + wid) * 8 + nt) * 64 + lane) * 4) = o;
      }
    }
  }
  __syncthreads();
  }
#undef GDN_ISSUEQ
}

__device__ __forceinline__ void gdn_scan_block(const Params& p, int sid2) {
  const int tid = opaque_tid(), lane = tid & 63, fr = lane & 15, fq = lane >> 4;
  const int wid = __builtin_amdgcn_readfirstlane(tid >> 6);
  const int vhalf = sid2 & 1, sid = sid2 >> 1;
  const int d = sid & 1, bh = sid >> 1, b = bh / 8, h = bh % 8;
  const int wv = vhalf * 4 + wid;
  const char* base = (const char*)(p.prep + (long)sid * NCH * GD_ITEM);
  u16* obuf = d ? p.yb : p.yf;
  char* L = (char*)smem;
  const unsigned lo16 = lane * 16u, lo8 = lane * 8u;
  f32x4 st[8];
#pragma unroll
  for (int i = 0; i < 8; ++i) st[i] = f32x4{0.f, 0.f, 0.f, 0.f};
  auto chunk_of = [&](int step) { step = min(step, NCH - 1); return d == 0 ? step : (step < 4 ? 3 - step : 263 - step); };
  bf16x8 Ar[4][6];
  uint2 Cr[4][6];
#pragma unroll
  for (int u = 0; u < 3; ++u) {
    const char* it = base + (long)chunk_of(u >> 1) * (GD_ITEM * 2);
    const int half = u & 1;
    const char* pa = it + (half * 24 + wid * 6) * 1024;
    const char* pc = it + 49152 + ((half * 6) * 8 + wv) * 512;
#pragma unroll
    for (int e = 0; e < 6; ++e) Ar[u][e] = *reinterpret_cast<const bf16x8*>(pa + e * 1024 + lo16);
#pragma unroll
    for (int r = 0; r < 6; ++r) Cr[u][r] = *reinterpret_cast<const uint2*>(pc + r * 4096 + lo8);
  }
  __syncthreads();
  bf16x8 bfr[4];
#pragma unroll 1
  for (int P0 = 0; P0 < 2 * NCH; P0 += 8) {
#pragma unroll
    for (int u = 0; u < 8; ++u) {
      const int step = (P0 >> 1) + (u >> 1);
      const int half = u & 1;
      {
        const int Pn = P0 + u + 3;
        const char* it = base + (long)chunk_of(Pn >> 1) * (GD_ITEM * 2);
        const int hn = (u + 1) & 1;
        const char* pa = it + (hn * 24 + wid * 6) * 1024;
        const char* pc = it + 49152 + ((hn * 6) * 8 + wv) * 512;
#pragma unroll
        for (int e = 0; e < 6; ++e) Ar[(u + 3) % 4][e] = *reinterpret_cast<const bf16x8*>(pa + e * 1024 + lo16);
#pragma unroll
        for (int r = 0; r < 6; ++r) Cr[(u + 3) % 4][r] = *reinterpret_cast<const uint2*>(pc + r * 4096 + lo8);
      }
      char* Lb = L + half * 24576;
#pragma unroll
      for (int e = 0; e < 6; ++e) *reinterpret_cast<bf16x8*>(Lb + (wid * 6 + e) * 1024 + lo16) = Ar[u % 4][e];
      asm volatile("s_waitcnt lgkmcnt(0)" ::: "memory");
      __builtin_amdgcn_s_barrier();
      asm volatile("" ::: "memory");
      if (half == 0) {
#pragma unroll
        for (int ks = 0; ks < 4; ++ks) {
          union { bf16x8 v; unsigned w[4]; } cv;
          cv.w[0] = pack2(st[2 * ks][0], st[2 * ks][1]); cv.w[1] = pack2(st[2 * ks][2], st[2 * ks][3]);
          cv.w[2] = pack2(st[2 * ks + 1][0], st[2 * ks + 1][1]); cv.w[3] = pack2(st[2 * ks + 1][2], st[2 * ks + 1][3]);
          bfr[ks] = cv.v;
        }
      }
      const int c = chunk_of(step);
      u16* orow = obuf + ((long)b * PB + c * 64) * D + h * 128 + wv * 16 + fr;
#pragma unroll
      for (int r = 0; r < 6; ++r) {
        const int rt = half * 6 + r;
        f32x4 acc;
        acc[0] = __uint_as_float(Cr[u % 4][r].x << 16); acc[1] = __uint_as_float(Cr[u % 4][r].x & 0xffff0000u);
        acc[2] = __uint_as_float(Cr[u % 4][r].y << 16); acc[3] = __uint_as_float(Cr[u % 4][r].y & 0xffff0000u);
#pragma unroll
        for (int ks = 0; ks < 4; ++ks) {
          bf16x8 a = *reinterpret_cast<const bf16x8*>(Lb + (r * 4 + ks) * 1024 + lo16);
          acc = MFMA16(a, bfr[ks], acc);
        }
        if (rt < 8) st[rt] = acc;
        else {
#pragma unroll
          for (int j = 0; j < 4; ++j) {
            int t = 16 * (rt - 8) + 4 * fq + j;
            int tau = d ? 63 - t : t;
            orow[(long)tau * D] = f2bf(acc[j]);
          }
        }
        if (r & 1) __builtin_amdgcn_sched_barrier(0);
      }
    }
  }
  __syncthreads();
}

__device__ __forceinline__ void gdn_scan_loader(const Params& p, int sid2, int s_begin, int s_end) {
  const int tid = opaque_tid(), lane = tid & 63;
  const int wid = __builtin_amdgcn_readfirstlane(tid >> 6);
  const int vhalf = sid2 & 1, sid = sid2 >> 1, d = sid & 1, bh = sid >> 1, b = bh / 8, h = bh % 8;
  u16* obuf = d ? p.yb : p.yf;
  const int t = tid >> 2, seg = tid & 3;
  const int tau = d ? 63 - t : t;
  const char* base = (const char*)(p.prep + (long)sid * NCH * GD_ITEM);
  char* L = (char*)smem_raw;
  const unsigned lo16 = lane * 16u;
  auto chunk_of = [&](int step) { step = min(step, NCH - 1); return d == 0 ? step : (step < 4 ? 3 - step : 263 - step); };
  auto copy = [&](int step) {
    const u16* Yb = (const u16*)(smem_raw + 49152) + (step & 1) * 4608 + t * 72 + seg * 16;
    const uint4 v0 = *reinterpret_cast<const uint4*>(Yb), v1 = *reinterpret_cast<const uint4*>(Yb + 8);
    const int cc = d == 0 ? step : (step < 4 ? 3 - step : 263 - step);
    u16* dst = obuf + ((long)b * PB + cc * 64 + tau) * D + h * 128 + vhalf * 64 + seg * 16;
    *reinterpret_cast<uint4*>(dst) = v0; *reinterpret_cast<uint4*>(dst + 8) = v1;
  };
  const int PB0 = 2 * s_begin, PE = 2 * s_end;
  bf16x8 Ar[8][6];
#pragma unroll
  for (int u = 0; u < 8; ++u) {
    const char* pa = base + (long)chunk_of(s_begin + (u >> 1)) * (GD_ITEM * 2) + ((u & 1) * 24 + wid * 6) * 1024;
#pragma unroll
    for (int e = 0; e < 6; ++e) Ar[u][e] = *reinterpret_cast<const bf16x8*>(pa + e * 1024 + lo16);
  }
  __syncthreads();
#pragma unroll
  for (int e = 0; e < 6; ++e) *reinterpret_cast<bf16x8*>(L + (wid * 6 + e) * 1024 + lo16) = Ar[0][e];
  {
    const char* pa = base + (long)chunk_of(s_begin + 4) * (GD_ITEM * 2) + (0 * 24 + wid * 6) * 1024;
#pragma unroll
    for (int e = 0; e < 6; ++e) Ar[0][e] = *reinterpret_cast<const bf16x8*>(pa + e * 1024 + lo16);
  }
  asm volatile("s_waitcnt lgkmcnt(0)" ::: "memory");
  __builtin_amdgcn_s_barrier();
#pragma unroll 1
  for (int P0 = PB0; P0 < PE; P0 += 8) {
#pragma unroll
    for (int u = 0; u < 8; ++u) {
      const int Pw = P0 + u + 1;
      if (Pw < PE) {
        char* Lb = L + ((u + 1) & 1) * 24576;
#pragma unroll
        for (int e = 0; e < 6; ++e) *reinterpret_cast<bf16x8*>(Lb + (wid * 6 + e) * 1024 + lo16) = Ar[(u + 1) % 8][e];
      }
      {
        const int Pn = P0 + u + 9;
        const char* pa = base + (long)chunk_of(Pn >> 1) * (GD_ITEM * 2) + (((u + 1) & 1) * 24 + wid * 6) * 1024;
#pragma unroll
        for (int e = 0; e < 6; ++e) Ar[(u + 1) % 8][e] = *reinterpret_cast<const bf16x8*>(pa + e * 1024 + lo16);
      }
      if ((u & 1) == 0 && P0 + u >= PB0 + 2) copy(((P0 + u) >> 1) - 1);
      asm volatile("s_waitcnt lgkmcnt(0)" ::: "memory");
      __builtin_amdgcn_s_barrier();
      asm volatile("" ::: "memory");
    }
  }
  copy(s_end - 1);
  __syncthreads();
}

__device__ __forceinline__ void gdn_scan_compute(const Params& p, int sid2, int s_begin, int s_end) {
  const int tid = opaque_tid(), lane = tid & 63, fr = lane & 15, fq = lane >> 4;
  const int wid = __builtin_amdgcn_readfirstlane(tid >> 6);
  const int vhalf = sid2 & 1, sid = sid2 >> 1;
  const int d = sid & 1, bh = sid >> 1, b = bh / 8, h = bh % 8;
  const int wv = vhalf * 4 + wid;
  const char* base = (const char*)(p.prep + (long)sid * NCH * GD_ITEM);
  u16* obuf = d ? p.yb : p.yf;
  const char* L = (const char*)smem_raw;
  const unsigned lo16 = lane * 16u, lo8 = lane * 8u;
  const int PB0 = 2 * s_begin, PE = 2 * s_end;
  f32x4* stsave = (f32x4*)(smem_raw + 98304) + tid * 8;
  f32x4 st[8];
#pragma unroll
  for (int i = 0; i < 8; ++i) st[i] = s_begin > 0 ? stsave[i] : f32x4{0.f, 0.f, 0.f, 0.f};
  auto chunk_of = [&](int step) { step = min(step, NCH - 1); return d == 0 ? step : (step < 4 ? 3 - step : 263 - step); };
  uint2 Cr[4][6];
#pragma unroll
  for (int u = 0; u < 3; ++u) {
    const char* pc = base + (long)chunk_of(s_begin + (u >> 1)) * (GD_ITEM * 2) + 49152 + (((u & 1) * 6) * 8 + wv) * 512;
#pragma unroll
    for (int r = 0; r < 6; ++r) Cr[u][r] = *reinterpret_cast<const uint2*>(pc + r * 4096 + lo8);
  }
  __syncthreads();
  __builtin_amdgcn_s_barrier();
  asm volatile("" ::: "memory");
  bf16x8 bfr[4];
#pragma unroll 1
  for (int P0 = PB0; P0 < PE; P0 += 8) {
#pragma unroll
    for (int u = 0; u < 8; ++u) {
      const int step = (P0 >> 1) + (u >> 1);
      const int half = u & 1;
      {
        const int Pn = P0 + u + 3;
        const char* pc = base + (long)chunk_of(Pn >> 1) * (GD_ITEM * 2) + 49152 + ((((u + 1) & 1) * 6) * 8 + wv) * 512;
#pragma unroll
        for (int r = 0; r < 6; ++r) Cr[(u + 3) % 4][r] = *reinterpret_cast<const uint2*>(pc + r * 4096 + lo8);
      }
      const char* Lb = L + half * 24576;
      if (half == 0) {
#pragma unroll
        for (int ks = 0; ks < 4; ++ks) {
          union { bf16x8 v; unsigned w[4]; } cv;
          cv.w[0] = pack2(st[2 * ks][0], st[2 * ks][1]); cv.w[1] = pack2(st[2 * ks][2], st[2 * ks][3]);
          cv.w[2] = pack2(st[2 * ks + 1][0], st[2 * ks + 1][1]); cv.w[3] = pack2(st[2 * ks + 1][2], st[2 * ks + 1][3]);
          bfr[ks] = cv.v;
        }
      }
      const int c = chunk_of(step);
      u16* Yb = (u16*)(smem_raw + 49152) + (step & 1) * 4608;
      (void)c;
      bf16x8 fa[8], fb[8];
#pragma unroll
      for (int q = 0; q < 8; ++q) fa[q] = *reinterpret_cast<const bf16x8*>(Lb + q * 1024 + lo16);
#pragma unroll
      for (int k = 0; k < 3; ++k) {
        if (k == 0) {
#pragma unroll
          for (int q = 0; q < 8; ++q) fb[q] = *reinterpret_cast<const bf16x8*>(Lb + (8 + q) * 1024 + lo16);
        } else if (k == 1) {
#pragma unroll
          for (int q = 0; q < 8; ++q) fa[q] = *reinterpret_cast<const bf16x8*>(Lb + (16 + q) * 1024 + lo16);
        }
#pragma unroll
        for (int rr = 0; rr < 2; ++rr) {
          const int r = 2 * k + rr, rt = half * 6 + r;
          f32x4 acc;
          acc[0] = __uint_as_float(Cr[u % 4][r].x << 16); acc[1] = __uint_as_float(Cr[u % 4][r].x & 0xffff0000u);
          acc[2] = __uint_as_float(Cr[u % 4][r].y << 16); acc[3] = __uint_as_float(Cr[u % 4][r].y & 0xffff0000u);
#pragma unroll
          for (int ks = 0; ks < 4; ++ks) acc = MFMA16((k == 1 ? fb : fa)[rr * 4 + ks], bfr[ks], acc);
          if (rt < 8) st[rt] = acc;
          else {
#pragma unroll
            for (int j = 0; j < 4; ++j) {
              int t = 16 * (rt - 8) + 4 * fq + j;
              Yb[t * 72 + wid * 16 + fr] = f2bf(acc[j]);
            }
          }
        }
        __builtin_amdgcn_sched_barrier(0);
      }
      asm volatile("s_waitcnt lgkmcnt(0)" ::: "memory");
      __builtin_amdgcn_s_barrier();
      asm volatile("" ::: "memory");
    }
  }
  if (s_end < NCH) {
#pragma unroll
    for (int i = 0; i < 8; ++i) stsave[i] = st[i];
  }
  __syncthreads();
}

__device__ __forceinline__ void phase_gdn_out(const Params& p) {
  const int tid_ = opaque_tid(); const int lane = tid_ & 63, wid = tid_ >> 6;
  for (int row0 = VBID * 4 + wid; row0 < T; row0 += NVB * 8) {
    uint2 ra[2][4], rb[2][4], rz[2][4];
    int rows[2]; bool act[2];
#pragma unroll
    for (int q = 0; q < 2; ++q) {
      const int rq = row0 + q * NVB * 4;
      act[q] = rq < T; rows[q] = act[q] ? rq : row0;
#pragma unroll
      for (int i = 0; i < 4; ++i) {
        const int col = (i * 64 + lane) * 4;
        ra[q][i] = *reinterpret_cast<const uint2*>(p.yf + (long)rows[q] * D + col);
        rb[q][i] = *reinterpret_cast<const uint2*>(p.yb + (long)rows[q] * D + col);
        rz[q][i] = *reinterpret_cast<const uint2*>(p.zbuf + (long)rows[q] * GDN_IN + 3072 + col);
      }
    }
#pragma unroll
    for (int q = 0; q < 2; ++q) {
      if (!act[q]) continue;
      const int row = rows[q];
#pragma unroll
      for (int i = 0; i < 4; ++i) {
        int col = (i * 64 + lane) * 4;
        const uint2 a = ra[q][i], bq = rb[q][i], gz = rz[q][i];
        float o[4], gt[4];
        o[0] = __uint_as_float(a.x << 16) + __uint_as_float(bq.x << 16);
        o[1] = __uint_as_float(a.x & 0xffff0000u) + __uint_as_float(bq.x & 0xffff0000u);
        o[2] = __uint_as_float(a.y << 16) + __uint_as_float(bq.y << 16);
        o[3] = __uint_as_float(a.y & 0xffff0000u) + __uint_as_float(bq.y & 0xffff0000u);
        gt[0] = __uint_as_float(gz.x << 16); gt[1] = __uint_as_float(gz.x & 0xffff0000u);
        gt[2] = __uint_as_float(gz.y << 16); gt[3] = __uint_as_float(gz.y & 0xffff0000u);
        float ss = o[0] * o[0] + o[1] * o[1] + o[2] * o[2] + o[3] * o[3];
#pragma unroll
        for (int of = 16; of > 0; of >>= 1) ss += __shfl_xor(ss, of);
        float rstd = rsqrtf(ss * (1.f / 128.f) + 1e-6f);
        float r[4];
#pragma unroll
        for (int e = 0; e < 4; ++e) r[e] = o[e] * rstd * p.gdn_norm_g[(col & 127) + e] * siluf_(gt[e]);
        uint2 w; w.x = pack2(r[0], r[1]); w.y = pack2(r[2], r[3]);
        *reinterpret_cast<uint2*>(p.abuf + (long)row * D + col) = w;
      }
    }
  }
}

__device__ __forceinline__ void phase_post_mixer(const Params& p, int layer, bool dry = false) {
  constexpr int FS = 1026;
  u16* const xdst = dry ? p.yf : p.xs;
  float* frow = (float*)smem;
  float* part = frow + 16 * FS;
  int* hist = (int*)(part + 4 * 16 * 32);
  const int tid = opaque_tid(), lane = tid & 63, fr = lane & 15, fq = lane >> 4;
  const int wid = __builtin_amdgcn_readfirstlane(tid >> 6);
  if (tid < 32) hist[tid] = 0;
  __syncthreads();
  const float* rw = p.router_w + (long)layer * 1024 * 32;
  const float* g1 = p.norm_g + (long)(layer * 4 + 1) * 1024;
  const float* g2 = p.norm_g + (long)(layer * 4 + 2) * 1024;
  float wreg0[64], wreg1[64];
  {
    const float* wb = rw + (long)(wid * 256 + fq) * 32 + fr;
#pragma unroll
    for (int s_ = 0; s_ < 64; ++s_) { wreg0[s_] = wb[(long)(4 * s_) * 32]; wreg1[s_] = wb[(long)(4 * s_) * 32 + 16]; }
  }
  for (int trip = 0; trip < (layer == 0 ? 5 : 4); ++trip) {
    int row0, nvalid = 16;
    if (layer == 0) {
      if (trip < 4) row0 = (VBID + trip * NVB) * 16; else { row0 = 4 * NVB * 16 + VBID; nvalid = 1; }
    } else {
      const int g = VBID + trip * NVB;
      row0 = (g >> 10) * PB + CTXL + (g & 1023) * 16;
    }
    const int b = row0 / PB, pp0 = row0 % PB;
    const bool isctx = pp0 < CTXL;
    const int mrow = isctx ? 2 : b;
    const float* gate = modp(p, layer, mrow, 2);
    const float* sh = modp(p, layer, mrow, 3);
    const float* sc = modp(p, layer, mrow, 4);
#pragma unroll 1
    for (int rr = 0; rr < 4; ++rr) {
      const int lr = wid * 4 + rr, row = row0 + lr, pp = pp0 + lr;
      if (lr >= nvalid) continue;
      float ss = 0.f;
      float4 tv[4];
#pragma unroll
      for (int i = 0; i < 4; ++i) {
        tv[i] = ld4bf(p.tmp + (long)row * D + (i * 64 + lane) * 4);
        ss += tv[i].x * tv[i].x + tv[i].y * tv[i].y + tv[i].z * tv[i].z + tv[i].w * tv[i].w;
      }
      float4 lv[4];
#pragma unroll
      for (int i = 0; i < 4; ++i) {
        const int col = (i * 64 + lane) * 4;
        if (layer == 0) {
          const float* src0 = isctx ? p.ctx + ((long)b * CTXL + pp) * D : p.x + ((long)b * SEQ + (pp - CTXL)) * D;
          lv[i] = *reinterpret_cast<const float4*>(src0 + col);
        } else lv[i] = ld4bf(p.xs + (long)row * D + col);
      }
      ss = wave_sum(ss);
      const float rstd = rsqrtf(ss * (1.f / 1024.f) + 1e-6f);
      float ss2 = 0.f;
#pragma unroll
      for (int i = 0; i < 4; ++i) {
        const int col = (i * 64 + lane) * 4;
        const float4 gg = *reinterpret_cast<const float4*>(g1 + col);
        const float4 gt = *reinterpret_cast<const float4*>(gate + col);
        lv[i].x += gt.x * (tv[i].x * rstd * gg.x); lv[i].y += gt.y * (tv[i].y * rstd * gg.y);
        lv[i].z += gt.z * (tv[i].z * rstd * gg.z); lv[i].w += gt.w * (tv[i].w * rstd * gg.w);
        st4bf(xdst + (long)row * D + col, lv[i]);
        ss2 += lv[i].x * lv[i].x + lv[i].y * lv[i].y + lv[i].z * lv[i].z + lv[i].w * lv[i].w;
      }
      ss2 = wave_sum(ss2);
      const float rstd2 = rsqrtf(ss2 * (1.f / 1024.f) + 1e-6f);
#pragma unroll
      for (int i = 0; i < 4; ++i) {
        const int col = (i * 64 + lane) * 4;
        const float4 g2v = *reinterpret_cast<const float4*>(g2 + col);
        const float4 s4 = *reinterpret_cast<const float4*>(sh + col);
        const float4 c4 = *reinterpret_cast<const float4*>(sc + col);
        float4 f;
        f.x = lv[i].x * rstd2 * g2v.x * (1.f + c4.x) + s4.x; f.y = lv[i].y * rstd2 * g2v.y * (1.f + c4.y) + s4.y;
        f.z = lv[i].z * rstd2 * g2v.z * (1.f + c4.z) + s4.z; f.w = lv[i].w * rstd2 * g2v.w * (1.f + c4.w) + s4.w;
        st4bf(p.abuf + (long)row * D + col, f);
        float* fd = frow + lr * FS + col;
        fd[0] = f.x; fd[1] = f.y; fd[2] = f.z; fd[3] = f.w;
      }
    }
    __syncthreads();
    {
      f32x4 acc0 = f32x4{0.f, 0.f, 0.f, 0.f}, acc1 = acc0;
      const float* fa = frow + fr * FS + wid * 256 + fq;
#pragma unroll
      for (int s = 0; s < 64; ++s) {
        const float a = fa[4 * s];
        acc0 = __builtin_amdgcn_mfma_f32_16x16x4f32(a, wreg0[s], acc0, 0, 0, 0);
        acc1 = __builtin_amdgcn_mfma_f32_16x16x4f32(a, wreg1[s], acc1, 0, 0, 0);
      }
#pragma unroll
      for (int j = 0; j < 4; ++j) {
        part[(wid * 16 + 4 * fq + j) * 32 + fr] = acc0[j];
        part[(wid * 16 + 4 * fq + j) * 32 + 16 + fr] = acc1[j];
      }
    }
    __syncthreads();
#pragma unroll 1
    for (int rr = 0; rr < 4; ++rr) {
      const int lr = wid * 4 + rr, row = row0 + lr;
      if (lr >= nvalid) continue;
      float logit = -3.0e38f;
      if (lane < 32)
        logit = part[(0 * 16 + lr) * 32 + lane] + part[(1 * 16 + lr) * 32 + lane] + part[(2 * 16 + lr) * 32 + lane] +
                part[(3 * 16 + lr) * 32 + lane] + p.router_b[layer * 32 + lane];
      float tv4[4]; int ti4[4];
#pragma unroll
      for (int k = 0; k < 4; ++k) {
        float bv = logit; int bi = lane;
#pragma unroll
        for (int of = 32; of > 0; of >>= 1) {
          float ov = __shfl_xor(bv, of); int oi = __shfl_xor(bi, of);
          if (ov > bv || (ov == bv && oi < bi)) { bv = ov; bi = oi; }
        }
        tv4[k] = bv; ti4[k] = bi;
        if (lane == bi) logit = -3.0e38f;
      }
      if (lane == 0) {
        float m = tv4[0];
        float e0 = 1.f, e1 = __expf(tv4[1] - m), e2 = __expf(tv4[2] - m), e3 = __expf(tv4[3] - m);
        float inv = 1.f / (e0 + e1 + e2 + e3);
        *reinterpret_cast<int4*>(p.tok_e + (long)row * 4) = make_int4(ti4[0], ti4[1], ti4[2], ti4[3]);
        *reinterpret_cast<float4*>(p.tok_gw + (long)row * 4) = make_float4(e0 * inv, e1 * inv, e2 * inv, e3 * inv);
        if (!dry) { atomicAdd(hist + ti4[0], 1); atomicAdd(hist + ti4[1], 1); atomicAdd(hist + ti4[2], 1); atomicAdd(hist + ti4[3], 1); }
      }
    }
    __syncthreads();
  }
  __syncthreads();
  if (!dry && tid < 32 && hist[tid]) atomicAdd(p.cnt + CNTI(layer, 0, tid), hist[tid]);
}

__device__ __forceinline__ void phase_moe_scatter(const Params& p, int layer) {
  int* base = (int*)smem;
  int* lcnt = base + 32;
  int* lbase = base + 64;
  const int tid = opaque_tid();
  if (tid == 0) {
    int run = 0;
    for (int e = 0; e < NE; ++e) { base[e] = run; run += p.cnt[CNTI(layer, 0, e)]; }
  }
  if (tid < 32) lcnt[tid] = 0;
  __syncthreads();
  int e_[4], r_[4]; long id_[4];
#pragma unroll
  for (int k = 0; k < 4; ++k) {
    const long idx = (long)VBID * NTH + tid + (long)k * NVB * NTH;
    id_[k] = -1; e_[k] = 0; r_[k] = 0;
    if (idx < (long)T * 4) {
      const int tok = (int)(idx >> 2);
      if (!(layer == 1 && (tok % PB) < CTXL)) {
        id_[k] = idx;
        e_[k] = p.tok_e[idx];
        r_[k] = atomicAdd(lcnt + e_[k], 1);
      }
    }
  }
  __syncthreads();
  if (tid < 32) lbase[tid] = lcnt[tid] ? atomicAdd(p.cnt + CNTI(layer, 1, tid), lcnt[tid]) : 0;
  __syncthreads();
#pragma unroll
  for (int k = 0; k < 4; ++k) {
    if (id_[k] >= 0) {
      const int slot = base[e_[k]] + lbase[e_[k]] + r_[k];
      p.slot_tok[slot] = (int)(id_[k] >> 2);
      p.slot_gw[slot] = p.tok_gw[id_[k]];
      p.tok_slot[id_[k]] = slot;
    }
  }
  __syncthreads();
}

struct MoeTab { int tstart[33]; int base[33]; };

__device__ __forceinline__ void moe_build_tab(const Params& p, int layer, MoeTab* tab) {
  __syncthreads();
  if ((threadIdx.x & 255) == 0) {
    int run = 0, trun = 0;
    for (int e = 0; e < NE; ++e) {
      int cnt = p.cnt[CNTI(layer, 0, e)];
      tab->base[e] = run; tab->tstart[e] = trun;
      run += cnt; trun += (cnt + 127) >> 7;
    }
    tab->base[32] = run; tab->tstart[32] = trun;
  }
  __syncthreads();
}

__device__ __forceinline__ void phase_moe_gemm1(const Params& p, int layer) {
  MoeTab* tab = (MoeTab*)(smem + 73728);
  moe_build_tab(p, layer, tab);
  const int ntiles = tab->tstart[32];
  const int tid = opaque_tid(), wid = tid >> 6, lane = tid & 63, wr = wid >> 1, wc = wid & 1, fr = lane & 15, fq = lane >> 4;
  for (int item = VBID; item < ntiles * 8; item += NVB) {
    const int ti = item >> 3, nt = item & 7;
    int e = 0;
    for (int q = 1; q < NE; ++q) if (ti >= tab->tstart[q]) e = q;
    const int mt = ti - tab->tstart[e];
    const int cnt = tab->base[e + 1] - tab->base[e];
    const int valid = min(128, cnt - mt * 128);
    const int slot0 = tab->base[e] + mt * 128;
    const u16* Bt = p.MoeInT + (long)(layer * 32 + e) * 2048 * 1024;
    f32x4 acc[4][8];
    gemm_tile(p.abuf, D, Bt, D, D,
              [&](int r) { return p.slot_tok[slot0 + min(r, valid - 1)]; },
              [&](int r) { int wcc = r >> 7, n = (r >> 4) & 7, f = r & 15;
                           return (n < 4 ? 0 : 1024) + nt * 128 + wcc * 64 + (n & 3) * 16 + f; },
              acc);
    const float* bi = p.moe_b_in + (long)(layer * 32 + e) * 2048;
#pragma unroll
    for (int m = 0; m < 4; ++m) {
      const int r = wr * 64 + m * 16 + fr;
#pragma unroll
      for (int n = 0; n < 4; ++n) {
        const int ca = nt * 128 + wc * 64 + n * 16 + fq * 4;
        const float4 bg = *reinterpret_cast<const float4*>(bi + ca);
        const float4 bl = *reinterpret_cast<const float4*>(bi + 1024 + ca);
        const float bgv[4] = {bg.x, bg.y, bg.z, bg.w}, blv[4] = {bl.x, bl.y, bl.z, bl.w};
        float v[4];
#pragma unroll
        for (int j = 0; j < 4; ++j) {
          float glu = fminf(acc[m][n][j] + bgv[j], 7.0f);
          float lin = fminf(fmaxf(acc[m][n + 4][j] + blv[j], -7.0f), 7.0f);
          v[j] = glu * sigmoidf_(1.702f * glu) * (lin + 1.0f);
        }
        if (r < valid) {
          uint2 o; o.x = pack2(v[0], v[1]); o.y = pack2(v[2], v[3]);
          *reinterpret_cast<uint2*>(p.act + (long)(slot0 + r) * D + ca) = o;
        }
      }
    }
  }
}

__device__ __forceinline__ void phase_moe_gemm2(const Params& p, int layer) {
  MoeTab* tab = (MoeTab*)(smem + 73728);
  moe_build_tab(p, layer, tab);
  const int ntiles = tab->tstart[32];
  const int tid = opaque_tid(), wid = tid >> 6, lane = tid & 63, wr = wid >> 1, wc = wid & 1, fr = lane & 15, fq = lane >> 4;
  for (int item = VBID; item < ntiles * 4; item += NVB) {
    const int ti = item >> 2, nt = item & 3;
    int e = 0;
    for (int q = 1; q < NE; ++q) if (ti >= tab->tstart[q]) e = q;
    const int mt = ti - tab->tstart[e];
    const int cnt = tab->base[e + 1] - tab->base[e];
    const int valid = min(128, cnt - mt * 128);
    const int slot0 = tab->base[e] + mt * 128;
    const u16* Bt = p.MoeOutT + (long)(layer * 32 + e) * 1024 * 1024;
    f32x4 acc[4][8];
    gemm_tile(p.act, D, Bt, D, D,
              [&](int r) { return slot0 + min(r, valid - 1); },
              [&](int r) { return nt * 256 + r; },
              acc);
    const float* bo = p.moe_b_out + (long)(layer * 32 + e) * 1024;
#pragma unroll
    for (int m = 0; m < 4; ++m) {
      const int r = wr * 64 + m * 16 + fr;
      const float gw = r < valid ? p.slot_gw[slot0 + r] : 0.f;
#pragma unroll
      for (int n = 0; n < 8; ++n) {
        const int cc = nt * 256 + wc * 128 + n * 16 + fq * 4;
        const float4 bv = *reinterpret_cast<const float4*>(bo + cc);
        if (r < valid) {
          uint2 o;
          o.x = pack2((acc[m][n][0] + bv.x) * gw, (acc[m][n][1] + bv.y) * gw);
          o.y = pack2((acc[m][n][2] + bv.z) * gw, (acc[m][n][3] + bv.w) * gw);
          *reinterpret_cast<uint2*>(p.oslot + (long)(slot0 + r) * D + cc) = o;
        }
      }
    }
  }
}

__device__ __forceinline__ void phase_moe_combine(const Params& p, int layer, bool dry = false) {
  u16* const xdst = dry ? p.yf : p.xs;
  const int tid_ = opaque_tid(); const int lane = tid_ & 63, wid = tid_ >> 6;
  const float* g3 = p.norm_g + (long)(layer * 4 + 3) * 1024;
  const float* g0n = p.norm_g + (long)((layer + 1) * 4 + 0) * 1024;
  for (int row0 = VBID * 4 + wid; row0 < T; row0 += NVB * 8) {
    int rows[2]; bool act[2]; int bb[2], ppp[2], mrow[2];
#pragma unroll
    for (int q = 0; q < 2; ++q) {
      rows[q] = row0 + q * NVB * 4;
      act[q] = rows[q] < T;
      const int rr = act[q] ? rows[q] : row0;
      bb[q] = rr / PB; ppp[q] = rr % PB;
      if (layer == 1 && ppp[q] < CTXL) act[q] = false;
      mrow[q] = ppp[q] < CTXL ? 2 : bb[q];
      rows[q] = rr;
    }
    if (!act[0] && !act[1]) continue;
    int4 sl[2];
#pragma unroll
    for (int q = 0; q < 2; ++q) sl[q] = *reinterpret_cast<const int4*>(p.tok_slot + (long)rows[q] * 4);
    float y[2][16];
    float4 xv[2][4];
#pragma unroll
    for (int q = 0; q < 2; ++q) {
#pragma unroll
      for (int i = 0; i < 16; ++i) y[q][i] = 0.f;
      const int sls[4] = {sl[q].x, sl[q].y, sl[q].z, sl[q].w};
#pragma unroll
      for (int k = 0; k < 4; ++k) {
#pragma unroll
        for (int i = 0; i < 4; ++i) {
          uint2 a = *reinterpret_cast<const uint2*>(p.oslot + (long)sls[k] * D + (i * 64 + lane) * 4);
          y[q][i * 4 + 0] += __uint_as_float(a.x << 16); y[q][i * 4 + 1] += __uint_as_float(a.x & 0xffff0000u);
          y[q][i * 4 + 2] += __uint_as_float(a.y << 16); y[q][i * 4 + 3] += __uint_as_float(a.y & 0xffff0000u);
        }
      }
#pragma unroll
      for (int i = 0; i < 4; ++i) xv[q][i] = ld4bf(p.xs + (long)rows[q] * D + (i * 64 + lane) * 4);
    }
#pragma unroll
    for (int q = 0; q < 2; ++q) {
      if (!act[q]) continue;
      const int row = rows[q];
      float ss = 0.f;
#pragma unroll
      for (int i = 0; i < 16; ++i) ss += y[q][i] * y[q][i];
      ss = wave_sum(ss);
      const float rstd = rsqrtf(ss * (1.f / 1024.f) + 1e-6f);
      float lat[16];
      float ss2 = 0.f;
      const float* gate = modp(p, layer, mrow[q], 5);
#pragma unroll
      for (int i = 0; i < 4; ++i) {
        const int col = (i * 64 + lane) * 4;
        const float4 gg = *reinterpret_cast<const float4*>(g3 + col);
        const float4 gt = *reinterpret_cast<const float4*>(gate + col);
        lat[i * 4 + 0] = xv[q][i].x + gt.x * (y[q][i * 4 + 0] * rstd * gg.x);
        lat[i * 4 + 1] = xv[q][i].y + gt.y * (y[q][i * 4 + 1] * rstd * gg.y);
        lat[i * 4 + 2] = xv[q][i].z + gt.z * (y[q][i * 4 + 2] * rstd * gg.z);
        lat[i * 4 + 3] = xv[q][i].w + gt.w * (y[q][i * 4 + 3] * rstd * gg.w);
#pragma unroll
        for (int e = 0; e < 4; ++e) ss2 += lat[i * 4 + e] * lat[i * 4 + e];
        const float4 ov = make_float4(lat[i * 4 + 0], lat[i * 4 + 1], lat[i * 4 + 2], lat[i * 4 + 3]);
        if (layer == 0) st4bf(xdst + (long)row * D + col, ov);
        else *reinterpret_cast<float4*>(p.out + ((long)bb[q] * SEQ + (ppp[q] - CTXL)) * D + col) = ov;
      }
      if (layer == 0) {
        ss2 = wave_sum(ss2);
        const float rstd2 = rsqrtf(ss2 * (1.f / 1024.f) + 1e-6f);
        const float* sh = modp(p, 1, mrow[q], 0);
        const float* sc = modp(p, 1, mrow[q], 1);
#pragma unroll
        for (int i = 0; i < 4; ++i) {
          const int col = (i * 64 + lane) * 4;
          const float4 gg = *reinterpret_cast<const float4*>(g0n + col);
          const float4 s4 = *reinterpret_cast<const float4*>(sh + col);
          const float4 c4 = *reinterpret_cast<const float4*>(sc + col);
          const float h0 = lat[i * 4 + 0] * rstd2 * gg.x * (1.f + c4.x) + s4.x;
          const float h1 = lat[i * 4 + 1] * rstd2 * gg.y * (1.f + c4.y) + s4.y;
          const float h2 = lat[i * 4 + 2] * rstd2 * gg.z * (1.f + c4.z) + s4.z;
          const float h3 = lat[i * 4 + 3] * rstd2 * gg.w * (1.f + c4.w) + s4.w;
          uint2 o; o.x = pack2(h0, h1); o.y = pack2(h2, h3);
          *reinterpret_cast<uint2*>(p.abuf + (long)row * D + col) = o;
        }
      }
    }
  }
}
namespace g8 {
constexpr int BK = 64, HTB = 128 * BK * 2;
__device__ __forceinline__ int lds_byte(int r, int c) { const int st = (r >> 4) * 2 + (c >> 5), rr = r & 15, cc = c & 31, ob = rr * 64 + cc * 2; return st * 1024 + (ob ^ (((ob >> 9) & 1) << 5)); }
__device__ __forceinline__ int perm32(int rho) { const int n = rho >> 4, i = rho & 15; return 8 * (i >> 2) + 4 * n + (i & 3); }
__device__ __forceinline__ void stage_rc(int b, int& R, int& C) { const int st = b / 1024, sb = b % 1024, swz = sb ^ (((sb >> 9) & 1) << 5); R = (st >> 1) * 16 + swz / 64; C = (st & 1) * 32 + (swz % 64) / 2; }

__device__ __forceinline__ const char* uni(const char* p) { unsigned long long v = (unsigned long long)p; unsigned lo = __builtin_amdgcn_readfirstlane((unsigned)v), hi = __builtin_amdgcn_readfirstlane((unsigned)(v >> 32)); return (const char*)(((unsigned long long)hi << 32) | lo); }
struct Unit { const char* b0; int i0, i1, i2, i3; };

template <class Sched, class RowOf, class Epi>
__device__ __forceinline__ void gemm_phase(const u16* __restrict__ Aptr, int K, const Sched& S, const RowOf& rowof, const Epi& E) {
  LAS unsigned char* lds = (LAS unsigned char*)smem_raw;
  int tid_ = threadIdx.x; asm volatile("" : "+v"(tid_));
  const int tid = tid_, wid = __builtin_amdgcn_readfirstlane(tid >> 6), lane = tid & 63, wr = wid >> 2, wc = wid & 3, fr = lane & 15, fq = lane >> 4;
  const int nt = K / BK;
  unsigned voffB[2];
#pragma unroll
  for (int i = 0; i < 2; ++i) { int R_, C_; stage_rc(tid * 16 + i * 8192, R_, C_); const int Rb = (R_ & ~31) + perm32(R_ & 31); voffB[i] = (unsigned)(Rb * K + C_) * 2u; }
  const size_t kstep = (size_t)(BK * 2);
  const unsigned ldsw = (unsigned)wid * 1024u;
  const int aoff = lds_byte(wr * 64 + fr, fq * 8), boff = lds_byte(wc * 32 + fr, fq * 8);
#define G8_SA(b, h) (((b) * 2 + (h)) * HTB)
#define G8_SB(b, h) ((4 + (b) * 2 + (h)) * HTB)
#define G8_STAGE(bufoff, gbase, voff) do { _Pragma("unroll") for (int _i = 0; _i < 2; ++_i) \
    __builtin_amdgcn_global_load_lds((const unsigned*)(uni((const char*)(gbase)) + (voff)[_i]), (LAS unsigned*)(lds + (bufoff) + ldsw + _i * 8192), 16, 0, 0); } while (0)
#define G8_STAGEB(bufoff, gbase) do { _Pragma("unroll") for (int _i = 0; _i < 2; ++_i) \
    __builtin_amdgcn_global_load_lds((const unsigned*)(uni((const char*)(gbase)) + _i * bstep + voffB), (LAS unsigned*)(lds + (bufoff) + ldsw + _i * 8192), 16, 0, 0); } while (0)
#define G8_LDA(dst, b, h) do { _Pragma("unroll") for (int m = 0; m < 4; ++m) _Pragma("unroll") for (int k = 0; k < 2; ++k) dst[m][k] = *(const LAS bf16x8*)(lds + G8_SA(b, h) + aoff + m * 2048 + k * 1024); } while (0)
#define G8_LDB(dst, b, h) do { _Pragma("unroll") for (int n = 0; n < 2; ++n) _Pragma("unroll") for (int k = 0; k < 2; ++k) dst[n][k] = *(const LAS bf16x8*)(lds + G8_SB(b, h) + boff + n * 2048 + k * 1024); } while (0)
#define G8_MMA(ai, bj, At, Bt) do { __builtin_amdgcn_s_setprio(1); _Pragma("unroll") for (int m = 0; m < 4; ++m) _Pragma("unroll") for (int n = 0; n < 2; ++n) _Pragma("unroll") for (int k = 0; k < 2; ++k) \
    acc[ai][bj][m][n] = __builtin_amdgcn_mfma_f32_16x16x32_bf16(Bt[n][k], At[m][k], acc[ai][bj][m][n], 0, 0, 0); __builtin_amdgcn_s_setprio(0); } while (0)
#define G8_WAIT_V(n) asm volatile("s_waitcnt vmcnt(" #n ")" ::: "memory")
#define G8_WAIT_L(n) asm volatile("s_waitcnt lgkmcnt(" #n ")" ::: "memory")
#define G8_BAR __builtin_amdgcn_s_barrier()
#define G8_SCHED __builtin_amdgcn_sched_barrier(0)
  Unit cur, nxt, nn; int ui = 0;
  if (!S.next(0, cur)) return;
  f32x4 acc[2][2][4][2];
#pragma unroll
  for (int a = 0; a < 2; ++a)
#pragma unroll
    for (int b = 0; b < 2; ++b)
#pragma unroll
      for (int m = 0; m < 4; ++m)
#pragma unroll
        for (int n = 0; n < 2; ++n) acc[a][b][m][n] = f32x4{0.f, 0.f, 0.f, 0.f};
  bf16x8 At[4][2], B0[2][2], B1[2][2];
  const char* Ab = (const char*)Aptr;
  unsigned gc0[2], gc1[2], gn0[2], gn1[2];
  bool has_next = S.next(1, nxt);
#pragma unroll
  for (int i = 0; i < 2; ++i) {
    int R_, C_; stage_rc(tid * 16 + i * 8192, R_, C_);
    gc0[i] = (unsigned)(((long)rowof(cur, R_) * K + C_) * 2);
    gc1[i] = (unsigned)(((long)rowof(cur, 128 + R_) * K + C_) * 2);
    gn0[i] = gc0[i]; gn1[i] = gc1[i];
    if (has_next) {
      gn0[i] = (unsigned)(((long)rowof(nxt, R_) * K + C_) * 2);
      gn1[i] = (unsigned)(((long)rowof(nxt, 128 + R_) * K + C_) * 2);
    }
  }
  const long b1d = S.b1delta;
  const char* cB0 = cur.b0;
#define cB1 (cB0 + b1d)
#define nB1 (nB0 + b1d)
  __syncthreads();
  G8_STAGE(G8_SB(0, 0), cB0, voffB); G8_STAGE(G8_SA(0, 0), Ab, gc0); G8_STAGE(G8_SB(0, 1), cB1, voffB); G8_STAGE(G8_SA(0, 1), Ab, gc1);
  if (wr == 1) G8_BAR;
  G8_WAIT_V(4); G8_BAR;
  G8_STAGE(G8_SB(1, 0), cB0 + kstep, voffB); G8_STAGE(G8_SA(1, 0), Ab + kstep, gc0); G8_STAGE(G8_SB(1, 1), cB1 + kstep, voffB);
  G8_WAIT_V(6); G8_BAR;
  for (;;) {
    const char* nB0 = has_next ? nxt.b0 : cB0;
    for (int t = 0; t < nt; t += 2) {
      const bool last = (t == nt - 2);
      const bool first = (t == 0) && (ui > 0);
      const char* a1 = Ab + (size_t)(t + 1) * kstep;
      const char* a2 = last ? Ab : Ab + (size_t)(t + 2) * kstep;
      const char* b20 = last ? nB0 : cB0 + (size_t)(t + 2) * kstep; const char* b21 = last ? nB1 : cB1 + (size_t)(t + 2) * kstep;
      const char* a3 = a2 + kstep; const char* b30 = b20 + kstep; const char* b31 = b21 + kstep;
      G8_LDB(B0, 0, 0); G8_SCHED; G8_LDA(At, 0, 0); if (!first) G8_STAGE(G8_SA(1, 1), a1, gc1);
      G8_WAIT_L(8); G8_BAR; G8_WAIT_L(0); G8_MMA(0, 0, At, B0); G8_BAR; G8_SCHED;
      G8_LDB(B1, 0, 1); G8_STAGE(G8_SB(0, 0), b20, voffB);
      G8_BAR; G8_WAIT_L(0); G8_MMA(0, 1, At, B1); G8_BAR;
      G8_LDA(At, 0, 1); G8_STAGE(G8_SA(0, 0), a2, (last ? gn0 : gc0));
      G8_BAR; G8_WAIT_L(0); G8_MMA(1, 0, At, B0); G8_BAR; G8_SCHED;
      G8_STAGE(G8_SB(0, 1), b21, voffB);
      if (first) { if (Epi::NST == 16) G8_WAIT_V(22); else G8_WAIT_V(14); } else G8_WAIT_V(6);
      G8_BAR; G8_MMA(1, 1, At, B1); G8_BAR;
      G8_LDB(B0, 1, 0); G8_SCHED; G8_LDA(At, 1, 0); G8_STAGE(G8_SA(0, 1), a2, (last ? gn1 : gc1));
      G8_WAIT_L(8); G8_BAR; G8_WAIT_L(0); G8_MMA(0, 0, At, B0); G8_BAR; G8_SCHED;
      G8_LDB(B1, 1, 1); G8_STAGE(G8_SB(1, 0), b30, voffB);
      G8_BAR; G8_WAIT_L(0); G8_MMA(0, 1, At, B1); G8_BAR;
      G8_LDA(At, 1, 1); G8_STAGE(G8_SA(1, 0), a3, (last ? gn0 : gc0));
      G8_BAR; G8_WAIT_L(0); G8_MMA(1, 0, At, B0); G8_BAR; G8_SCHED;
      G8_STAGE(G8_SB(1, 1), b31, voffB);
      G8_WAIT_V(6); G8_BAR; G8_MMA(1, 1, At, B1); G8_BAR;
    }
    G8_SCHED;
    typename Epi::Pre epre;
    E.load(epre, cur, wr, wc, fr, fq);
    G8_SCHED;
    G8_STAGE(G8_SA(1, 1), Ab + kstep, gn1);
    bool has_nn = false;
    if (has_next) has_nn = S.next(ui + 2, nn);
    int rq[4] = {0, 0, 0, 0};
    if (RowOf::GATHER && has_nn) {
#pragma unroll
      for (int i = 0; i < 2; ++i) {
        int R_, C_; stage_rc(tid * 16 + i * 8192, R_, C_);
        const int* q0 = rowof.addr(nn, R_); const int* q1 = rowof.addr(nn, 128 + R_);
        asm volatile("global_load_dword %0, %1, off" : "=v"(rq[i]) : "v"(q0) : "memory");
        asm volatile("global_load_dword %0, %1, off" : "=v"(rq[2 + i]) : "v"(q1) : "memory");
      }
    }
    G8_SCHED;
    E(acc, cur, epre, wr, wc, fr, fq);
    G8_SCHED;
#ifdef G8_EPI2
    E(acc, cur, epre, wr, wc, fr, fq);
    G8_SCHED;
#endif
    if (!has_next) break;
#pragma unroll
    for (int a = 0; a < 2; ++a)
#pragma unroll
      for (int b = 0; b < 2; ++b)
#pragma unroll
        for (int m = 0; m < 4; ++m)
#pragma unroll
          for (int n = 0; n < 2; ++n) acc[a][b][m][n] = f32x4{0.f, 0.f, 0.f, 0.f};
    cur = nxt; cB0 = nB0; ++ui;
#pragma unroll
    for (int i = 0; i < 2; ++i) { gc0[i] = gn0[i]; gc1[i] = gn1[i]; }
    if (has_nn) {
      if (RowOf::GATHER) {
        if (Epi::NST == 16) asm volatile("s_waitcnt vmcnt(16)" : "+v"(rq[0]), "+v"(rq[1]), "+v"(rq[2]), "+v"(rq[3]) :: "memory");
        else asm volatile("s_waitcnt vmcnt(8)" : "+v"(rq[0]), "+v"(rq[1]), "+v"(rq[2]), "+v"(rq[3]) :: "memory");
      }
#pragma unroll
      for (int i = 0; i < 2; ++i) {
        int R_, C_; stage_rc(tid * 16 + i * 8192, R_, C_);
        const int r0 = RowOf::GATHER ? rq[i] : rowof(nn, R_), r1 = RowOf::GATHER ? rq[2 + i] : rowof(nn, 128 + R_);
        gn0[i] = (unsigned)(((long)r0 * K + C_) * 2);
        gn1[i] = (unsigned)(((long)r1 * K + C_) * 2);
      }
    }
    nxt = nn; has_next = has_nn;
  }
  G8_WAIT_V(0);
  if (wr == 0) G8_BAR;
  G8_BAR;
#undef cB1
#undef nB1
#undef G8_SA
#undef G8_SB
#undef G8_STAGE
#undef G8_STAGEB
#undef G8_LDA
#undef G8_LDB
#undef G8_MMA
#undef G8_WAIT_V
#undef G8_WAIT_L
#undef G8_BAR
#undef G8_SCHED
}
}
struct DenseSched {
  const u16* Bt; int ntn, nunits, G, c, K, lat_only;
  long b1delta;
  __device__ __forceinline__ bool next(int i, g8::Unit& u) const {
    const long L = (long)i * G + c;
    if (L >= nunits) return false;
    const int nM = lat_only ? T / 256 - 2 : T / 256, nN = ntn, nwg = nunits;
    int wgid = (int)L;
    { const int q = nwg / 8, r = nwg % 8, xcd = wgid % 8, off = wgid / 8; wgid = (xcd < r ? xcd * (q + 1) : r * (q + 1) + (xcd - r) * q) + off; }
    const int nig = 8 * nN, gid = wgid / nig, fm = gid * 8, gsz = (nM - fm) < 8 ? (nM - fm) : 8;
    int pm = fm + ((wgid % nig) % gsz); const int pn = (wgid % nig) / gsz;
    if (lat_only) pm = pm < 64 ? pm + 1 : pm + 2;
    u.b0 = (const char*)(Bt + (long)(pn * 256) * K);
    u.i0 = pm * 256; u.i1 = pn * 256; u.i2 = 0; u.i3 = 0;
    return true;
  }
};
struct DenseRow { static constexpr bool GATHER = false;
  __device__ __forceinline__ int operator()(const g8::Unit& u, int r) const { return u.i0 + r; }
  __device__ __forceinline__ const int* addr(const g8::Unit&, int) const { return nullptr; } };
struct DenseEpi {
  static constexpr int NST = 16;
  u16* z; u16* tmp; u16* trash; int N, mode;
  struct Pre {};
  __device__ __forceinline__ void load(Pre&, const g8::Unit&, int, int, int, int) const {}
  __device__ __forceinline__ void operator()(const f32x4 (&acc)[2][2][4][2], const g8::Unit& u, const Pre&, int wr, int wc, int fr, int fq) const {
#pragma unroll
    for (int ai = 0; ai < 2; ++ai)
#pragma unroll
      for (int m = 0; m < 4; ++m) {
        const long row = u.i0 + ai * 128 + wr * 64 + m * 16 + fr;
#pragma unroll
        for (int bj = 0; bj < 2; ++bj) {
          const int col = u.i1 + bj * 128 + wc * 32 + fq * 8;
          const f32x4 v0 = acc[ai][bj][m][0], v1 = acc[ai][bj][m][1];
          uint4 o; o.x = pack2(v0[0], v0[1]); o.y = pack2(v0[2], v0[3]); o.z = pack2(v1[0], v1[1]); o.w = pack2(v1[2], v1[3]);
          u16* dst = mode == 0 ? (col < N ? z + row * N + col : trash + ((row & 255) * 1024 + (col & 1023))) : tmp + row * D + col;
          *reinterpret_cast<uint4*>(dst) = o;
        }
      }
  }
};
__device__ __forceinline__ void phase_gemm_dense8(const Params& p, const u16* Bt, int Npad, int N, int mode, int lat_only = 0) {
  DenseSched S; S.Bt = Bt; S.ntn = Npad / 256; S.lat_only = lat_only; S.nunits = (lat_only ? T / 256 - 2 : T / 256) * S.ntn; S.G = gridDim.x; S.c = blockIdx.x; S.K = D; S.b1delta = (long)128 * D * 2;
  DenseEpi E; E.z = p.zbuf; E.tmp = p.tmp; E.trash = p.trash; E.N = N; E.mode = mode;
  g8::gemm_phase(p.abuf, D, S, DenseRow(), E);
}

struct MoeTab8 { int tstart[33]; int base[33]; };
__device__ __forceinline__ MoeTab8* moe_tab8(const Params& p, int layer) {
  MoeTab8* tab = (MoeTab8*)(smem_raw + 131072 + 1024);
  __syncthreads();
  if (threadIdx.x == 0) {
    int run = 0, trun = 0;
    for (int e = 0; e < NE; ++e) {
      int cnt = p.cnt[CNTI(layer, 0, e)];
      tab->base[e] = run; tab->tstart[e] = trun;
      run += cnt; trun += (cnt + 255) >> 8;
    }
    tab->base[32] = run; tab->tstart[32] = trun;
  }
  __syncthreads();
  return tab;
}
struct MoeSched {
  const MoeTab8* tab; const u16* W; int NU, G, c, which;
  long b1delta;
  __device__ __forceinline__ bool next(int i, g8::Unit& u) const {
    const long L = (long)i * G + c;
    const int ntiles = __builtin_amdgcn_readfirstlane(tab->tstart[32]);
    const int nun = ntiles * NU;
    if (L >= (long)nun) return false;
    int wg = (int)L;
    { const int q = nun / 8, r = nun % 8, xcd = wg % 8, off = wg / 8; wg = (xcd < r ? xcd * (q + 1) : r * (q + 1) + (xcd - r) * q) + off; }
    const int ti = wg / NU, nu = wg % NU;
    int e = min(NE - 1, (int)(((long)ti * NE) / max(ntiles, 1)));
#pragma unroll 1
    while (e > 0 && ti < __builtin_amdgcn_readfirstlane(tab->tstart[e])) --e;
#pragma unroll 1
    while (e < NE - 1 && ti >= __builtin_amdgcn_readfirstlane(tab->tstart[e + 1])) ++e;
    const int mt = ti - __builtin_amdgcn_readfirstlane(tab->tstart[e]);
    const int be = __builtin_amdgcn_readfirstlane(tab->base[e]);
    const int cnt = __builtin_amdgcn_readfirstlane(tab->base[e + 1]) - be;
    u.i0 = be + mt * 256;
    u.i1 = min(256, cnt - mt * 256);
    u.i2 = e; u.i3 = nu;
    if (which == 0) {
      const u16* We = W + (long)e * 2048 * 1024;
      u.b0 = (const char*)(We + (long)(nu * 128) * 1024);
    } else {
      const u16* We = W + (long)e * 1024 * 1024;
      u.b0 = (const char*)(We + (long)(nu * 256) * 1024);
    }
    return true;
  }
};
struct Moe1Row { const int* slot_tok; static constexpr bool GATHER = true;
  __device__ __forceinline__ int operator()(const g8::Unit& u, int r) const { return slot_tok[u.i0 + min(r, u.i1 - 1)]; }
  __device__ __forceinline__ const int* addr(const g8::Unit& u, int r) const { return slot_tok + (u.i0 + min(r, u.i1 - 1)); } };
struct Moe2Row { static constexpr bool GATHER = false;
  __device__ __forceinline__ int operator()(const g8::Unit& u, int r) const { return u.i0 + min(r, u.i1 - 1); }
  __device__ __forceinline__ const int* addr(const g8::Unit&, int) const { return nullptr; } };
struct Moe1Epi {
  static constexpr int NST = 8;
  u16* act; u16* trash; const float* b_in;
  struct Pre { float4 g0, g1, l0, l1; };
  __device__ __forceinline__ void load(Pre& q, const g8::Unit& u, int wr, int wc, int fr, int fq) const {
    const float* bi = b_in + (long)u.i2 * 2048;
    const int ca = u.i3 * 128 + wc * 32 + fq * 8;
    q.g0 = *reinterpret_cast<const float4*>(bi + ca); q.g1 = *reinterpret_cast<const float4*>(bi + ca + 4);
    q.l0 = *reinterpret_cast<const float4*>(bi + 1024 + ca); q.l1 = *reinterpret_cast<const float4*>(bi + 1024 + ca + 4);
  }
  __device__ __forceinline__ void operator()(const f32x4 (&acc)[2][2][4][2], const g8::Unit& u, const Pre& q, int wr, int wc, int fr, int fq) const {
    const int ca = u.i3 * 128 + wc * 32 + fq * 8;
    const fl2_t bg2[4] = {{q.g0.x, q.g0.y}, {q.g0.z, q.g0.w}, {q.g1.x, q.g1.y}, {q.g1.z, q.g1.w}};
    const fl2_t bl2[4] = {{q.l0.x, q.l0.y}, {q.l0.z, q.l0.w}, {q.l1.x, q.l1.y}, {q.l1.z, q.l1.w}};
    const fl2_t one2 = {1.0f, 1.0f}, sc2 = {-2.4554669595929157f, -2.4554669595929157f};
#pragma unroll
    for (int ai = 0; ai < 2; ++ai)
#pragma unroll
      for (int m = 0; m < 4; ++m) {
        const int r = ai * 128 + wr * 64 + m * 16 + fr;
        uint4 o;
        unsigned ow[4];
#pragma unroll
        for (int n = 0; n < 2; ++n)
#pragma unroll
          for (int jp = 0; jp < 2; ++jp) {
            fl2_t g = fl2_t{acc[ai][0][m][n][2 * jp], acc[ai][0][m][n][2 * jp + 1]} + bg2[n * 2 + jp];
            fl2_t l = fl2_t{acc[ai][1][m][n][2 * jp], acc[ai][1][m][n][2 * jp + 1]} + bl2[n * 2 + jp];
            g.x = fminf(g.x, 7.0f); g.y = fminf(g.y, 7.0f);
            l.x = fminf(fmaxf(l.x, -7.0f), 7.0f); l.y = fminf(fmaxf(l.y, -7.0f), 7.0f);
            fl2_t e = g * sc2;
            e.x = __builtin_amdgcn_exp2f(e.x); e.y = __builtin_amdgcn_exp2f(e.y);
            e = e + one2;
            fl2_t s = {__builtin_amdgcn_rcpf(e.x), __builtin_amdgcn_rcpf(e.y)};
            const fl2_t v = (g * s) * (l + one2);
            ow[n * 2 + jp] = __builtin_bit_cast(unsigned, __builtin_convertvector(v, bf2_t));
          }
        o.x = ow[0]; o.y = ow[1]; o.z = ow[2]; o.w = ow[3];
        *reinterpret_cast<uint4*>(r < u.i1 ? act + (long)(u.i0 + r) * D + ca : trash + (r * 1024 + (ca & 1023))) = o;
      }
  }
};
struct Moe2Epi {
  static constexpr int NST = 16;
  u16* oslot; u16* trash; const float* b_out; const float* slot_gw;
  struct Pre { float4 b[2][2]; float gw[8]; };
  __device__ __forceinline__ void load(Pre& q, const g8::Unit& u, int wr, int wc, int fr, int fq) const {
    const float* bo = b_out + (long)u.i2 * 1024;
#pragma unroll
    for (int bj = 0; bj < 2; ++bj) {
      const int cc = u.i3 * 256 + bj * 128 + wc * 32 + fq * 8;
      q.b[bj][0] = *reinterpret_cast<const float4*>(bo + cc); q.b[bj][1] = *reinterpret_cast<const float4*>(bo + cc + 4);
    }
#pragma unroll
    for (int ai = 0; ai < 2; ++ai)
#pragma unroll
      for (int m = 0; m < 4; ++m) q.gw[ai * 4 + m] = slot_gw[u.i0 + min(ai * 128 + wr * 64 + m * 16 + fr, u.i1 - 1)];
  }
  __device__ __forceinline__ void operator()(const f32x4 (&acc)[2][2][4][2], const g8::Unit& u, const Pre& q, int wr, int wc, int fr, int fq) const {
#pragma unroll
    for (int ai = 0; ai < 2; ++ai)
#pragma unroll
      for (int m = 0; m < 4; ++m) {
        const int r = ai * 128 + wr * 64 + m * 16 + fr;
        const bool ok = r < u.i1;
        const float gw = q.gw[ai * 4 + m];
#pragma unroll
        for (int bj = 0; bj < 2; ++bj) {
          const int cc = u.i3 * 256 + bj * 128 + wc * 32 + fq * 8;
          const float4 b0 = q.b[bj][0], b1 = q.b[bj][1];
          const f32x4 v0 = acc[ai][bj][m][0], v1 = acc[ai][bj][m][1];
          const fl2_t g2 = {gw, gw};
          const fl2_t o0 = (fl2_t{v0[0], v0[1]} + fl2_t{b0.x, b0.y}) * g2, o1 = (fl2_t{v0[2], v0[3]} + fl2_t{b0.z, b0.w}) * g2;
          const fl2_t o2 = (fl2_t{v1[0], v1[1]} + fl2_t{b1.x, b1.y}) * g2, o3 = (fl2_t{v1[2], v1[3]} + fl2_t{b1.z, b1.w}) * g2;
          uint4 o;
          o.x = __builtin_bit_cast(unsigned, __builtin_convertvector(o0, bf2_t)); o.y = __builtin_bit_cast(unsigned, __builtin_convertvector(o1, bf2_t));
          o.z = __builtin_bit_cast(unsigned, __builtin_convertvector(o2, bf2_t)); o.w = __builtin_bit_cast(unsigned, __builtin_convertvector(o3, bf2_t));
          *reinterpret_cast<uint4*>(ok ? oslot + (long)(u.i0 + r) * D + cc : trash + (r * 1024 + cc)) = o;
        }
      }
  }
};
__device__ __forceinline__ void phase_moe_gemm1_8(const Params& p, int layer) {
  const MoeTab8* tab = moe_tab8(p, layer);
  MoeSched S; S.tab = tab; S.W = p.MoeInT + (long)layer * 32 * 2048 * 1024; S.NU = 8; S.G = gridDim.x; S.c = blockIdx.x; S.which = 0; S.b1delta = (long)1024 * 1024 * 2;
  Moe1Row R; R.slot_tok = p.slot_tok;
  Moe1Epi E; E.act = p.act; E.trash = p.trash; E.b_in = p.moe_b_in + (long)layer * 32 * 2048;
  g8::gemm_phase(p.abuf, D, S, R, E);
}
__device__ __forceinline__ void phase_moe_gemm2_8(const Params& p, int layer) {
  const MoeTab8* tab = moe_tab8(p, layer);
  MoeSched S; S.tab = tab; S.W = p.MoeOutT + (long)layer * 32 * 1024 * 1024; S.NU = 4; S.G = gridDim.x; S.c = blockIdx.x; S.which = 1; S.b1delta = (long)128 * 1024 * 2;
  Moe2Epi E; E.oslot = p.oslot; E.trash = p.trash; E.b_out = p.moe_b_out + (long)layer * 32 * 1024; E.slot_gw = p.slot_gw;
  g8::gemm_phase(p.act, D, S, Moe2Row(), E);
}
__device__ __forceinline__ void phase_gemm_dense(const Params& p, const u16* Bt, int Npad, int N, int mode) {
  const int ntn = Npad / 256;
  const int tiles = (T / 128) * ntn;
  const int tid = opaque_tid(), wid = tid >> 6, lane = tid & 63, wr = wid >> 1, wc = wid & 1, fr = lane & 15, fq = lane >> 4;
  for (int t = VBID; t < tiles; t += NVB) {
    const int mt = t / ntn, nt = t % ntn;
    f32x4 acc[4][8];
    gemm_tile(p.abuf, D, Bt, D, D, [&](int r) { return mt * 128 + r; }, [&](int r) { return nt * 256 + r; }, acc);
#pragma unroll
    for (int m = 0; m < 4; ++m)
#pragma unroll
      for (int n = 0; n < 8; ++n) {
        const long row = mt * 128 + wr * 64 + m * 16 + fr;
        const int col = nt * 256 + wc * 128 + n * 16 + fq * 4;
        if (mode == 0) {
          if (col < N) {
            uint2 o; o.x = pack2(acc[m][n][0], acc[m][n][1]); o.y = pack2(acc[m][n][2], acc[m][n][3]);
            *reinterpret_cast<uint2*>(p.zbuf + row * N + col) = o;
          }
        } else {
          { uint2 o; o.x = pack2(acc[m][n][0], acc[m][n][1]); o.y = pack2(acc[m][n][2], acc[m][n][3]); *reinterpret_cast<uint2*>(p.tmp + row * D + col) = o; }
        }
      }
  }
}

#ifndef WSLP_G
#define WSLP_G 0
#endif
#ifndef WSLP_R
#define WSLP_R 0
#endif
#ifndef RW_LATE
#define RW_LATE 1
#endif
#ifndef RW_WF
#define RW_WF 4
#endif
#ifndef GDN_WF
#define GDN_WF 0
#endif
#ifndef GDN_LATE
#define GDN_LATE 100
#endif
#ifndef REP_MOE
#define REP_MOE 1
#endif
#ifndef REP_DENSE
#define REP_DENSE 1
#endif
#ifndef REP_PREP
#define REP_PREP 1
#endif
#ifndef REP_SCAN
#define REP_SCAN 1
#endif
#ifndef REP_W
#define REP_W 1
#endif
#ifndef PREP_SKEW
#define PREP_SKEW 0
#endif
#ifndef REP_PREP_R
#define REP_PREP_R 1
#endif
#ifndef REP_PREP_G
#define REP_PREP_G 1
#endif
#ifndef REP_POST
#define REP_POST 1
#endif
#ifndef REP_COMB
#define REP_COMB 1
#endif
#ifndef REP_ROW
#define REP_ROW 1
#endif
#ifndef REP_POOL
#define REP_POOL 1
#endif
__global__ void __launch_bounds__(512, 2) mega(Params p) {
  cg::grid_group grid = cg::this_grid();
  volatile LAS unsigned* xbst = (volatile LAS unsigned*)(smem_raw + LDS_BYTES - 16);
  if (threadIdx.x == 0) { xbst[0] = 0u; xbst[1] = 0u; xbst[2] = 0u; xbst[3] = 0u; }
  __syncthreads();
  const XcdBarrier xb = xcd_barrier_post(p.bar, xbst);
  for (int rep = 0; rep < REP_W; ++rep) phase_weights(p, 0, p.early_tiles, VBID, NVB);
  phase_mods_partial(p);
  if (p.total_tiles < 0) grid.sync();
  xcd_barrier(xb);
  phase_mods_reduce(p);
  xcd_barrier(xb);
  for (int rep = 0; rep < REP_ROW; ++rep) phase_norm_in(p, 0, true);
  xcd_barrier(xb);
  for (int rep = 0; rep < REP_DENSE; ++rep) phase_gemm_dense8(p, p.WabT, AB_PAD, AB_IN, 0);
  xcd_barrier(xb);
  constexpr int RW_S0 = RW_LATE ? RW_CUT : NCH;
  static_assert(RW_S0 * NB * 12 * 2 <= RW_N0_ && RW_S0 % 5 == 0, "every item of the scan's first part must be prepared in the prep phase");
  for (int rep = 0; rep < REP_PREP_R; ++rep) { if (half_id()) rwkv_prep_all<1, false>(p); else rwkv_prep_all<0, false>(p); }
  xcd_barrier(xb);
  {
#define RW_WSPLIT (p.early_tiles + ((int)(((long)(p.mid_tiles - p.early_tiles) * RW_WF) / 5) & ~15))
#pragma unroll 1
    for (int part = 0; part < (RW_LATE ? 2 : 1); ++part) {
      if (blockIdx.x < 48) {
        const int s_begin = part ? RW_S0 : 0, s_end = part ? NCH : RW_S0;
        if (half_id() == 0) rwkv_scan_block(p, blockIdx.x, s_begin, s_end); else rwkv_scan_copy(p, blockIdx.x, s_begin, s_end);
      } else if (part == 0) {
        if (RW_LATE) { if (half_id()) rwkv_prep_all<1, true>(p); else rwkv_prep_all<0, true>(p); }
        for (int rep = 0; rep < REP_POOL; ++rep)
        for (int it = VBID - 96; it < NB * 260 * 4; it += NVB - 96) {
          int g = it & 3, r = it >> 2;
          int rb = r % 260, b = r / 260;
          pool_item(p, b, rb, g);
        }
        phase_weights<WSLP_R>(p, p.early_tiles, RW_LATE ? RW_WSPLIT : p.mid_tiles, VBID - 96, NVB - 96);
      } else {
        phase_weights<WSLP_R>(p, RW_WSPLIT, p.mid_tiles, VBID - 96, NVB - 96);
      }
      xcd_barrier(xb);
    }
  }
  for (int rep = 0; rep < REP_ROW; ++rep)
  for (int it = VBID; it < NB * NCH * 12; it += NVB) {
    int h = it % 12, r = it / 12;
    int c = r % NCH, b = r / NCH;
    rwkv_out_item(p, b, c, h);
  }
  xcd_barrier(xb);
  for (int rep = 0; rep < REP_DENSE; ++rep) phase_gemm_dense8(p, p.WoutT, 1024, 1024, 1);
  xcd_barrier(xb);
  for (int rep = 1; rep < REP_POST; ++rep) phase_post_mixer(p, 0, true);
  phase_post_mixer(p, 0);
  xcd_barrier(xb);
  phase_moe_scatter(p, 0);
  xcd_barrier(xb);
  for (int rep = 0; rep < REP_MOE; ++rep) { phase_moe_gemm1_8(p, 0);
  xcd_barrier(xb);
  phase_moe_gemm2_8(p, 0); if (rep + 1 < REP_MOE) xcd_barrier(xb); }
  xcd_barrier(xb);
  for (int rep = 1; rep < REP_COMB; ++rep) phase_moe_combine(p, 0, true);
  phase_moe_combine(p, 0);
  xcd_barrier(xb);
  for (int rep = 0; rep < REP_DENSE; ++rep) phase_gemm_dense8(p, p.WgdnT, GDN_PAD, GDN_IN, 0);
  xcd_barrier(xb);
  constexpr int GDN_S0 = GDN_S0_;
  for (int rep = 0; rep < REP_PREP_G; ++rep) { if (half_id()) gdn_prep_all<1, false>(p); else gdn_prep_all<0, false>(p); }
  xcd_barrier(xb);
  {
    const int bx = blockIdx.x, sid2 = (((bx & 7) + 8 * (bx >> 4)) << 1) | ((bx >> 3) & 1);
#define GDN_WSPLIT (p.mid_tiles + ((int)(((long)(p.total_tiles - p.mid_tiles) * GDN_WF) / 5) & ~15))
#pragma unroll 1
    for (int part = 0; part < (GDN_LATE ? 2 : 1); ++part) {
      if (blockIdx.x < 64) {
        const int s_begin = part ? GDN_S0 : 0, s_end = part ? NCH : GDN_S0;
        if (half_id() == 0) gdn_scan_compute(p, sid2, s_begin, s_end); else gdn_scan_loader(p, sid2, s_begin, s_end);
      } else if (part == 0) {
        if (half_id()) gdn_prep_all<1, true>(p); else gdn_prep_all<0, true>(p);
        phase_weights<WSLP_G>(p, p.mid_tiles, GDN_LATE ? GDN_WSPLIT : p.total_tiles, VBID - 128, NVB - 128);
      } else {
        phase_weights<WSLP_G>(p, GDN_WSPLIT, p.total_tiles, VBID - 128, NVB - 128);
      }
      xcd_barrier(xb);
    }
  }
  for (int rep = 0; rep < REP_ROW; ++rep) phase_gdn_out(p);
  xcd_barrier(xb);
  for (int rep = 0; rep < REP_DENSE; ++rep) phase_gemm_dense8(p, p.WoutT + 1024 * 1024, 1024, 1024, 1, 1);
  xcd_barrier(xb);
  for (int rep = 1; rep < REP_POST; ++rep) phase_post_mixer(p, 1, true);
  phase_post_mixer(p, 1);
  xcd_barrier(xb);
  phase_moe_scatter(p, 1);
  xcd_barrier(xb);
  for (int rep = 0; rep < REP_MOE; ++rep) { phase_moe_gemm1_8(p, 1);
  xcd_barrier(xb);
  phase_moe_gemm2_8(p, 1); if (rep + 1 < REP_MOE) xcd_barrier(xb); }
  xcd_barrier(xb);
  for (int rep = 1; rep < REP_COMB; ++rep) phase_moe_combine(p, 1, true);
  phase_moe_combine(p, 1);
}

extern "C" void kernel_launch(void* const* d_in, const int* in_sizes, int n_in, void* d_out, int out_size, void* d_ws,
                              size_t ws_size, hipStream_t stream) {
  static int grid_blocks = 0;
  if (!grid_blocks) {
    int dev = 0, cus = 0, per_cu = 0;
    (void)hipGetDevice(&dev);
    (void)hipDeviceGetAttribute(&cus, hipDeviceAttributeMultiprocessorCount, dev);
    (void)hipFuncSetAttribute((const void*)mega, hipFuncAttributeMaxDynamicSharedMemorySize, (int)LDS_BYTES);
    (void)hipOccupancyMaxActiveBlocksPerMultiprocessor(&per_cu, mega, 512, LDS_BYTES);
    if (per_cu > 1) per_cu = 1;
    if (per_cu < 1) per_cu = 1;
    grid_blocks = cus * per_cu;
  }
  Params p;
  memset(&p, 0, sizeof(p));
  const float** fp = (const float**)&p.x;
  for (int i = 0; i < 33; ++i) fp[i] = (const float*)d_in[i];
  p.out = (float*)d_out;
  char* ws = (char*)d_ws;
  size_t off = 0;
  auto take = [&](size_t bytes) { char* r = ws + off; off += (bytes + 255) & ~(size_t)255; return r; };
  p.cnt = (int*)take(32768);
  p.bar = (unsigned*)take((size_t)XCD_BAR_WORDS * 4);
  p.modpart = (float*)take((size_t)8 * 2 * 3 * 6144 * 4);
  p.mods = (float*)take((size_t)2 * 3 * 6144 * 4);
  p.WabT = (u16*)take((size_t)AB_PAD * 1024 * 2);
  p.WoutT = (u16*)take((size_t)2 * 1024 * 1024 * 2);
  p.WgdnT = (u16*)take((size_t)GDN_PAD * 1024 * 2);
  p.MoeInT = (u16*)take((size_t)64 * 2048 * 1024 * 2);
  p.MoeOutT = (u16*)take((size_t)64 * 1024 * 1024 * 2);
  p.WupT = (u16*)take((size_t)2 * 768 * 64 * 2);
  p.AupT = (u16*)take((size_t)2 * 768 * 64 * 2);
  p.GupT = (u16*)take((size_t)768 * 128 * 2);
  p.PoolT = (u16*)take((size_t)4 * 64 * 64 * 2);
  p.xs = (u16*)take((size_t)T * D * 2);
  p.abuf = (u16*)take((size_t)T * D * 2);
  p.zbuf = (u16*)take((size_t)T * GDN_IN * 2);
  p.tmp = p.zbuf;
  p.oslot = p.zbuf;
  p.prep = (u16*)take((size_t)NB * 8 * 2 * NCH * GD_ITEM * 2);
  p.act = p.prep;
  p.yf = (u16*)take((size_t)T * D * 2);
  p.yb = (u16*)take((size_t)T * D * 2);
  p.tok_e = (int*)take((size_t)T * 4 * 4);
  p.tok_gw = (float*)take((size_t)T * 4 * 4);
  p.tok_slot = (int*)take((size_t)T * 4 * 4);
  p.slot_tok = (int*)take((size_t)T * 4 * 4);
  p.slot_gw = (float*)take((size_t)T * 4 * 4);
  p.trash = (u16*)take((size_t)256 * 1024 * 2);
  if (off > ws_size) { fprintf(stderr, "workspace too small: need %zu have %zu\n", off, ws_size); return; }
  int ts = 0;
  auto fam = [&](int i, const float* src, u16* dst, int nmat, int K, int N, int Npad) {
    TFam& F = p.fam[i];
    F.src = src; F.dst = dst; F.nmat = nmat; F.K = K; F.N = N; F.Npad = Npad;
    F.sstride = (long)K * N; F.dstride = (long)Npad * K;
    F.tiles_per_mat = (K / 64) * (Npad / 64); F.tile_start = ts;
    ts += nmat * F.tiles_per_mat;
  };
  fam(0, p.ab_w_in, p.WabT, 1, 1024, AB_IN, AB_PAD);
  fam(1, p.w_out, p.WoutT, 2, 1024, 1024, 1024);
  fam(2, p.gdn_w_in, p.WgdnT, 1, 1024, GDN_IN, GDN_PAD);
  fam(3, p.rwkv_w_up, p.WupT, 2, 64, 768, 768);
  fam(4, p.rwkv_a_up, p.AupT, 2, 64, 768, 768);
  fam(5, p.rwkv_g_up, p.GupT, 1, 128, 768, 768);
  fam(6, p.pool_w, p.PoolT, 4, 64, 64, 64);
  p.early_tiles = ts;
  fam(7, p.moe_w_in, p.MoeInT, 32, 1024, 2048, 2048);
  fam(8, p.moe_w_out, p.MoeOutT, 32, 1024, 1024, 1024);
  p.mid_tiles = ts;
  fam(9, p.moe_w_in + (size_t)32 * 1024 * 2048, p.MoeInT + (size_t)32 * 2048 * 1024, 32, 1024, 2048, 2048);
  fam(10, p.moe_w_out + (size_t)32 * 1024 * 1024, p.MoeOutT + (size_t)32 * 1024 * 1024, 32, 1024, 1024, 1024);
  p.total_tiles = ts;
  (void)hipMemsetAsync(p.cnt, 0, 32768 + ((XCD_BAR_WORDS * 4 + 255) & ~255), stream);
  void* args[] = {&p};
  hipError_t e = hipLaunchCooperativeKernel((void*)mega, dim3(grid_blocks), dim3(512), args, LDS_BYTES, stream);
  if (e != hipSuccess) fprintf(stderr, "coop launch failed: %s (grid %d)\n", hipGetErrorString(e), grid_blocks);
}
```
